# Optimizing an MI355X kernel written in HIP

```python
import math
import jax, jax.numpy as jnp
from jax import lax
import numpy as np

D_MODEL = 2048
BATCH = 8
SEQ = 2048
DEPTH = 1

HEAD_DIM = 64
ROPE_THETA = 10000.0
RMS_EPS = 1e-6
NEG_INF = -1e30
SWA_Q_HEADS = 16
SWA_KV_HEADS = 2
SWA_GROUP = SWA_Q_HEADS // SWA_KV_HEADS
WINDOW = 128
SWA_BLOCK = WINDOW
DIFF_HEADS = 8
DIFF_V_DIM = 2 * HEAD_DIM
Q_BLOCK = 128
SWA_Q_COLS = SWA_Q_HEADS * HEAD_DIM
SWA_KV_COLS = SWA_KV_HEADS * HEAD_DIM
DIFF_QK_COLS = DIFF_HEADS * 2 * HEAD_DIM
DIFF_V_COLS = DIFF_HEADS * DIFF_V_DIM
GATE_COLS = 2 * D_MODEL
IN_COLS = SWA_Q_COLS + 2 * SWA_KV_COLS + 2 * DIFF_QK_COLS + DIFF_V_COLS + GATE_COLS
N_GROUPS = 8
EXPERTS_PER_GROUP = 8
N_EXPERTS = N_GROUPS * EXPERTS_PER_GROUP
TOP_K = 2
D_EXPERT = D_MODEL // 2
MOE_BLOCK = 128

kernel_name = "hybrid_swa_sink_diffattn_hiermoe_adaln"


def rmsnorm(x, g):
    xf = x.astype(jnp.float32)
    y = xf * lax.rsqrt(jnp.mean(xf * xf, axis=-1, keepdims=True) + RMS_EPS)
    return (y * g.astype(jnp.float32)).astype(x.dtype)


def rope_tables(positions):
    inv_freq = ROPE_THETA ** (-jnp.arange(0, HEAD_DIM, 2, dtype=jnp.float32) / HEAD_DIM)
    ang = positions.astype(jnp.float32)[..., None] * inv_freq
    return jnp.cos(ang), jnp.sin(ang)


def apply_rope(x, cos, sin):
    shp = cos.shape[:2] + (1,) * (x.ndim - 3) + cos.shape[-1:]
    cos, sin = cos.reshape(shp), sin.reshape(shp)
    xf = x.astype(jnp.float32)
    x1, x2 = jnp.split(xf, 2, axis=-1)
    return jnp.concatenate([x1 * cos - x2 * sin, x2 * cos + x1 * sin], axis=-1).astype(x.dtype)


def swa_sink_attention(q, k, v, sinks):
    B, S = q.shape[:2]
    nb = S // SWA_BLOCK
    qb = q.reshape(B, nb, SWA_BLOCK, SWA_KV_HEADS, SWA_GROUP, HEAD_DIM)

    def band(t):
        tb = t.reshape(B, nb, SWA_BLOCK, SWA_KV_HEADS, HEAD_DIM)
        prev = jnp.concatenate([jnp.zeros_like(tb[:, :1]), tb[:, :-1]], axis=1)
        return jnp.concatenate([prev, tb], axis=2)

    kk, vv = band(k), band(v)
    s = jnp.einsum('bnqhgd,bnkhd->bnhgqk', qb, kk).astype(jnp.float32) / math.sqrt(HEAD_DIM)
    qi = jnp.arange(SWA_BLOCK)[:, None]
    kj = jnp.arange(2 * SWA_BLOCK)[None, :]
    rel = qi + SWA_BLOCK - kj
    local = (rel >= 0) & (rel < WINDOW)
    kpos = jnp.arange(nb)[:, None] * SWA_BLOCK - SWA_BLOCK + kj
    mask = local[None, None, None] & (kpos >= 0)[:, None, None, None, :]
    s = jnp.where(mask, s, NEG_INF)
    sink = jnp.broadcast_to(sinks.astype(jnp.float32).reshape(1, 1, SWA_KV_HEADS, SWA_GROUP, 1, 1),
                            s.shape[:-1] + (1,))
    p = jax.nn.softmax(jnp.concatenate([s, sink], axis=-1), axis=-1)[..., :-1]
    o = jnp.einsum('bnhgqk,bnkhd->bnqhgd', p.astype(v.dtype), vv)
    return o.reshape(B, S, SWA_Q_HEADS * HEAD_DIM)


def diff_attention(q, k, v, lam, lambda_init, subln_g):
    B, S = q.shape[:2]
    nb = S // Q_BLOCK
    qb = jnp.moveaxis(q.reshape(B, nb, Q_BLOCK, DIFF_HEADS, 2, HEAD_DIM), 1, 0)
    kpos = jnp.arange(S)

    def block(args):
        qblk, n = args
        s = jnp.einsum('bqhcd,bkhcd->bhcqk', qblk, k).astype(jnp.float32) / math.sqrt(HEAD_DIM)
        qpos = n * Q_BLOCK + jnp.arange(Q_BLOCK)
        s = jnp.where(kpos[None, :] <= qpos[:, None], s, NEG_INF)
        p = jax.nn.softmax(s, axis=-1)
        a = p[:, :, 0] - lam * p[:, :, 1]
        return jnp.einsum('bhqk,bkhe->bqhe', a.astype(v.dtype), v)

    o = lax.map(block, (qb, jnp.arange(nb)))
    o = jnp.moveaxis(o, 0, 1).reshape(B, S, DIFF_HEADS, DIFF_V_DIM)
    o = rmsnorm(o, subln_g) * (1.0 - lambda_init)
    return o.reshape(B, S, DIFF_HEADS * DIFF_V_DIM)


def hier_moe(h, w_rg, b_rg, w_re, b_re, w_gu, w_dn):
    N = h.shape[0]
    glog = (h @ w_rg).astype(jnp.float32) + b_rg.astype(jnp.float32)
    gprob = jax.nn.softmax(glog, axis=-1)
    gsel = jnp.argmax(glog, axis=-1)
    gweight = jnp.take_along_axis(gprob, gsel[:, None], axis=1)[:, 0]
    elog = ((h @ w_re).astype(jnp.float32) + b_re.astype(jnp.float32)).reshape(N, N_GROUPS, EXPERTS_PER_GROUP)
    elog_sel = jnp.take_along_axis(elog, gsel[:, None, None], axis=1)[:, 0]
    top_v, top_i = lax.top_k(elog_sel, TOP_K)
    weights = gweight[:, None] * jax.nn.softmax(top_v, axis=-1)
    expert_ids = (gsel[:, None] * EXPERTS_PER_GROUP + top_i).astype(jnp.int32)

    A = N * TOP_K
    flat_e = expert_ids.reshape(-1)
    flat_tok = jnp.repeat(jnp.arange(N, dtype=jnp.int32), TOP_K)
    flat_w = weights.reshape(-1)
    order = jnp.argsort(flat_e)
    sorted_e = flat_e[order]
    counts = jnp.bincount(flat_e, length=N_EXPERTS)
    padded = ((counts + MOE_BLOCK - 1) // MOE_BLOCK) * MOE_BLOCK
    pend = jnp.cumsum(padded)
    pstart = pend - padded
    start = jnp.cumsum(counts) - counts
    dest = pstart[sorted_e] + jnp.arange(A) - start[sorted_e]
    P = A + N_EXPERTS * MOE_BLOCK
    n_blocks = P // MOE_BLOCK
    row_tok = jnp.full((P,), N, dtype=jnp.int32).at[dest].set(flat_tok[order])
    row_w = jnp.zeros((P,), jnp.float32).at[dest].set(flat_w[order])
    block_e = jnp.minimum(jnp.searchsorted(pend, jnp.arange(n_blocks) * MOE_BLOCK, side='right'),
                          N_EXPERTS - 1).astype(jnp.int32)
    h_pad = jnp.concatenate([h, jnp.zeros((1, h.shape[1]), h.dtype)], axis=0)
    xs = h_pad[row_tok].reshape(n_blocks, MOE_BLOCK, h.shape[1])

    def run_block(args):
        xb, e = args
        g, u = jnp.split(xb @ w_gu[e], 2, axis=-1)
        return (jax.nn.silu(g) * u) @ w_dn[e]

    yb = lax.map(run_block, (xs, block_e)).reshape(P, h.shape[1])
    yb = (yb.astype(jnp.float32) * row_w[:, None]).astype(h.dtype)
    return jnp.zeros((N + 1, h.shape[1]), h.dtype).at[row_tok].add(yb)[:N]


def setup_inputs(seed: int = 0) -> dict:
    key = jax.random.key(seed)
    ks = jax.random.split(key, 24)
    D, L = D_MODEL, DEPTH
    nrm = lambda k, shp, s: jax.random.normal(k, shp, jnp.float32) * s
    return {
        "x": nrm(ks[0], (BATCH, SEQ, D), 1.0),
        "c": nrm(ks[1], (BATCH, D), 1.0),
        "positions": jnp.broadcast_to(jnp.arange(SEQ, dtype=jnp.int32)[None, :], (BATCH, SEQ)),
        "w_ada": nrm(ks[2], (L, D, 6 * D), 0.5 * D ** -0.5),
        "b_ada": nrm(ks[3], (L, 6 * D), 0.02),
        "g_mix": 1.0 + nrm(ks[4], (L, D), 0.02),
        "w_in": nrm(ks[5], (L, D, IN_COLS), D ** -0.5),
        "swa_sinks": nrm(ks[6], (L, SWA_Q_HEADS), 0.5),
        "diff_lambda_q1": nrm(ks[7], (L, HEAD_DIM), 0.1),
        "diff_lambda_k1": nrm(ks[8], (L, HEAD_DIM), 0.1),
        "diff_lambda_q2": nrm(ks[9], (L, HEAD_DIM), 0.1),
        "diff_lambda_k2": nrm(ks[10], (L, HEAD_DIM), 0.1),
        "diff_subln_g": 1.0 + nrm(ks[11], (L, DIFF_V_DIM), 0.02),
        "w_branch_a": nrm(ks[12], (L, SWA_Q_COLS, D), SWA_Q_COLS ** -0.5),
        "w_branch_b": nrm(ks[13], (L, DIFF_V_COLS, D), DIFF_V_COLS ** -0.5),
        "w_out": nrm(ks[14], (L, D, D), D ** -0.5),
        "g_ffn": 1.0 + nrm(ks[15], (L, D), 0.02),
        "w_router_group": nrm(ks[16], (L, D, N_GROUPS), D ** -0.5),
        "b_router_group": nrm(ks[17], (L, N_GROUPS), 0.01),
        "w_router_expert": nrm(ks[18], (L, D, N_EXPERTS), D ** -0.5),
        "b_router_expert": nrm(ks[19], (L, N_EXPERTS), 0.01),
        "w_exp_gate_up": nrm(ks[20], (L, N_EXPERTS, D, 2 * D_EXPERT), D ** -0.5),
        "w_exp_down": nrm(ks[21], (L, N_EXPERTS, D_EXPERT, D), D_EXPERT ** -0.5),
        "g_final": 1.0 + nrm(ks[22], (D,), 0.02),
    }


def reference(x, c, positions, w_ada, b_ada, g_mix, w_in, swa_sinks, diff_lambda_q1, diff_lambda_k1,
              diff_lambda_q2, diff_lambda_k2, diff_subln_g, w_branch_a, w_branch_b, w_out, g_ffn,
              w_router_group, b_router_group, w_router_expert, b_router_expert, w_exp_gate_up,
              w_exp_down, g_final):
    B, S, D = x.shape
    cos, sin = rope_tables(positions)
    c_act = jax.nn.silu(c)
    splits = np.cumsum([SWA_Q_COLS, SWA_KV_COLS, SWA_KV_COLS, DIFF_QK_COLS, DIFF_QK_COLS, DIFF_V_COLS, D_MODEL])
    for layer in range(DEPTH):
        lambda_init = 0.8 - 0.6 * math.exp(-0.3 * layer)
        mod = c_act @ w_ada[layer] + b_ada[layer]
        sh_m, sc_m, gt_m, sh_f, sc_f, gt_f = [m[:, None, :] for m in jnp.split(mod, 6, axis=-1)]

        h = rmsnorm(x, g_mix[layer]) * (1.0 + sc_m) + sh_m
        proj = h @ w_in[layer]
        qa, ka, va, qd, kd, vd, ga, gb = jnp.split(proj, splits, axis=-1)
        qa = apply_rope(qa.reshape(B, S, SWA_Q_HEADS, HEAD_DIM), cos, sin)
        ka = apply_rope(ka.reshape(B, S, SWA_KV_HEADS, HEAD_DIM), cos, sin)
        va = va.reshape(B, S, SWA_KV_HEADS, HEAD_DIM)
        qd = apply_rope(qd.reshape(B, S, DIFF_HEADS, 2, HEAD_DIM), cos, sin)
        kd = apply_rope(kd.reshape(B, S, DIFF_HEADS, 2, HEAD_DIM), cos, sin)
        vd = vd.reshape(B, S, DIFF_HEADS, DIFF_V_DIM)
        lam = (jnp.exp(jnp.sum(diff_lambda_q1[layer].astype(jnp.float32) * diff_lambda_k1[layer].astype(jnp.float32)))
               - jnp.exp(jnp.sum(diff_lambda_q2[layer].astype(jnp.float32) * diff_lambda_k2[layer].astype(jnp.float32)))
               + lambda_init)
        o_a = swa_sink_attention(qa, ka, va, swa_sinks[layer])
        o_b = diff_attention(qd, kd, vd, lam, lambda_init, diff_subln_g[layer])
        merged = jax.nn.sigmoid(ga) * (o_a @ w_branch_a[layer]) + jax.nn.sigmoid(gb) * (o_b @ w_branch_b[layer])
        x = x + gt_m * (merged @ w_out[layer])

        h2 = rmsnorm(x, g_ffn[layer]) * (1.0 + sc_f) + sh_f
        ffn = hier_moe(h2.reshape(B * S, D), w_router_group[layer], b_router_group[layer],
                       w_router_expert[layer], b_router_expert[layer],
                       w_exp_gate_up[layer], w_exp_down[layer]).reshape(B, S, D)
        x = x + gt_f * ffn
    return rmsnorm(x, g_final)
```

```cpp
#include <hip/hip_runtime.h>
#include <cstdio>
#include <cstdint>

#ifndef LATE_COPIES
#define LATE_COPIES 1
#endif
#ifndef DIFF128
#define DIFF128 1
#endif
#ifndef MOE_STREAM
#define MOE_STREAM 1
#endif
#define LAS __attribute__((address_space(3)))
#define GAS __attribute__((address_space(1)))
typedef unsigned short bf16_t;
typedef float f32x4 __attribute__((ext_vector_type(4)));
typedef float f32x2 __attribute__((ext_vector_type(2)));
typedef unsigned u32x4 __attribute__((ext_vector_type(4)));
typedef unsigned u32x2 __attribute__((ext_vector_type(2)));

constexpr int NB = 8, NS = 2048, ND = 2048, NM = NB * NS;
constexpr int IN_COLS = 8448;
constexpr int C_KA = 1024, C_VA = 1152, C_QD = 1280, C_KD = 2304, C_VD = 3328, C_GA = 4352;
constexpr int NE = 64, DE = 1024;
constexpr int ECAP = 16384;
constexpr int PADR = 256;
constexpr int PMAX = 49152;
constexpr int KS_ADA = 32, KCH_ADA = ND / KS_ADA;
constexpr float RMS_EPS = 1e-6f;
constexpr float LOG2E = 1.4426950408889634f;
constexpr float C2 = 0.125f * LOG2E;
constexpr int NTHR = 512, NWAVES = 8;

constexpr size_t MiB = 1u << 20;
constexpr size_t WS_CTL = 0, CTL_ZERO_BYTES = 1 * MiB;
constexpr size_t WS_MOD = 1 * MiB;
constexpr size_t WS_MODP = 2 * MiB;
constexpr size_t WS_COS = 16 * MiB, WS_SIN = 18 * MiB;
constexpr size_t WS_TOKE = 20 * MiB;
constexpr size_t WS_TOKR = 21 * MiB;
constexpr size_t WS_LIST = 22 * MiB;
constexpr size_t WS_SLW = 26 * MiB;
constexpr size_t WS_WRT = 30 * MiB;
constexpr size_t WS_SSQ = 14 * MiB;
constexpr size_t WS_WINT = 32 * MiB;
constexpr size_t WS_WAT = 66 * MiB;
constexpr size_t WS_WBT = 70 * MiB;
constexpr size_t WS_WOUTT = 74 * MiB;
constexpr size_t WS_H = 96 * MiB;
constexpr size_t WS_QA = 160 * MiB;
constexpr size_t WS_KA = 192 * MiB;
constexpr size_t WS_VA = 196 * MiB;
constexpr size_t WS_QD = 200 * MiB, WS_KD = 232 * MiB, WS_VD = 264 * MiB;
constexpr size_t WS_G = 296 * MiB;
constexpr size_t WS_TMP = 424 * MiB;
constexpr size_t WS_OA = 488 * MiB, WS_OB = 520 * MiB;
constexpr size_t WS_MERGED = 552 * MiB;
constexpr size_t WS_XMID = 616 * MiB;
constexpr size_t WS_ACT = 744 * MiB;
constexpr size_t WS_Y = 840 * MiB;
constexpr size_t WS_WGUT = 1032 * MiB;
constexpr size_t WS_WDNT = 1544 * MiB;
constexpr size_t WS_END = 1800 * MiB;
constexpr int CW_CNT = 1024;
constexpr int CW_BAR = 4096;

constexpr int LDS_BYTES = 163840;
constexpr int MISC_OFF = 159744 + 64;

__device__ __forceinline__ float bf2f(unsigned v) { return __uint_as_float(v << 16); }
__device__ __forceinline__ unsigned f2bf(float f) { unsigned u = __float_as_uint(f); return (u + 0x7fffu + ((u >> 16) & 1u)) >> 16; }
__device__ __forceinline__ unsigned pk2(float lo, float hi) { return f2bf(lo) | (f2bf(hi) << 16); }
__device__ __forceinline__ float wave_sum(float v) {
#pragma unroll
    for (int o = 1; o < 64; o <<= 1) v += __shfl_xor(v, o);
    return v;
}
#define LDS_WAIT() asm volatile("s_waitcnt lgkmcnt(0)" ::: "memory")

__device__ const float INVF[32] = {
    1.000000000e+00f, 7.498942614e-01f, 5.623413324e-01f, 4.216965139e-01f, 3.162277639e-01f, 2.371373773e-01f, 1.778279394e-01f, 1.333521307e-01f,
    1.000000015e-01f, 7.498941571e-02f, 5.623413250e-02f, 4.216965288e-02f, 3.162277490e-02f, 2.371373773e-02f, 1.778279431e-02f, 1.333521493e-02f,
    9.999999776e-03f, 7.498941850e-03f, 5.623413250e-03f, 4.216964822e-03f, 3.162277630e-03f, 2.371373586e-03f, 1.778279431e-03f, 1.333521446e-03f,
    1.000000047e-03f, 7.498942432e-04f, 5.623413017e-04f, 4.216965172e-04f, 3.162277571e-04f, 2.371373703e-04f, 1.778279402e-04f, 1.333521504e-04f};

__device__ __forceinline__ void sincos_d(double a, double& s, double& c) {
    const double n = __builtin_rint(a * 0.63661977236758134308);
    double r = __builtin_fma(-n, 1.5707963267948966, a);
    r = __builtin_fma(-n, 6.123233995736766e-17, r);
    const double r2 = r * r;
    double ps = -1.0 / 1307674368000.0;
    ps = ps * r2 + 1.0 / 6227020800.0; ps = ps * r2 - 1.0 / 39916800.0; ps = ps * r2 + 1.0 / 362880.0; ps = ps * r2 - 1.0 / 5040.0; ps = ps * r2 + 1.0 / 120.0; ps = ps * r2 - 1.0 / 6.0;
    const double sr = r + r * r2 * ps;
    double pc = 1.0 / 87178291200.0;
    pc = pc * r2 - 1.0 / 479001600.0; pc = pc * r2 + 1.0 / 3628800.0; pc = pc * r2 - 1.0 / 40320.0; pc = pc * r2 + 1.0 / 720.0; pc = pc * r2 - 1.0 / 24.0; pc = pc * r2 + 0.5;
    const double cr = 1.0 - r2 * pc;
    const int q = ((int)n) & 3;
    s = (q == 0) ? sr : (q == 1) ? cr : (q == 2) ? -sr : -cr;
    c = (q == 0) ? cr : (q == 1) ? -sr : (q == 2) ? -cr : sr;
}

#define XB_TMO      128
#define XB_XCNT(j)  (256  + 64 * (j))
#define XB_XSUB(j)  (1280 + 64 * (j))
#define XB_XGEN(j)  (2304 + 64 * (j))
#define XB_TOP      3328
#define XB_TOPGEN   3392
#define XCD_BAR_WORDS 3456
#define XB_SPIN_CAP (1u << 18)

__device__ __forceinline__ unsigned xb_ld(unsigned* p)              { return __hip_atomic_load(p, __ATOMIC_RELAXED, __HIP_MEMORY_SCOPE_AGENT); }
__device__ __forceinline__ unsigned xb_add(unsigned* p, unsigned v) { return __hip_atomic_fetch_add(p, v, __ATOMIC_RELAXED, __HIP_MEMORY_SCOPE_AGENT); }
__device__ __forceinline__ unsigned xb_xcc_id() { return (unsigned)__builtin_amdgcn_s_getreg((3 << 11) | 20) & 0xFu; }
#define XB_SPIN(cond, bar) do { unsigned _sp = 0; while (cond) { __builtin_amdgcn_s_sleep(1); \
    if ((++_sp & 255u) == 0u) { if (xb_ld(&(bar)[XB_TMO])) break; if (_sp > XB_SPIN_CAP) { atomicAdd(&(bar)[XB_TMO], 1u); break; } } } } while (0)

struct XcdBarrier {
    unsigned* bar; unsigned x;
    volatile LAS unsigned* st;
};
__device__ __forceinline__ XcdBarrier xcd_barrier_post(unsigned* bar, volatile LAS unsigned* st) {
    XcdBarrier b; b.bar = bar; b.x = xb_xcc_id(); b.st = st;
    if (threadIdx.x == 0) (void)xb_add(&bar[XB_XCNT(b.x)], 1u);
    return b;
}
__device__ __forceinline__ void xcd_barrier_complete(unsigned* bar, unsigned x, unsigned& nloc, unsigned& nx) {
    const unsigned G = gridDim.x * gridDim.y * gridDim.z;
    unsigned sum, cnt, mine, sp = 0u;
    for (;;) {
        sum = 0u; cnt = 0u; mine = 0u;
#pragma unroll
        for (unsigned j = 0; j < 16; ++j) { const unsigned c = xb_ld(&bar[XB_XCNT(j)]); sum += c; cnt += (c > 0u) ? 1u : 0u; mine = (j == x) ? c : mine; }
        if (sum == G) break;
        __builtin_amdgcn_s_sleep(1);
        if ((++sp & 255u) == 0u) { if (xb_ld(&bar[XB_TMO])) break; if (sp > XB_SPIN_CAP) { atomicAdd(&bar[XB_TMO], 1u); break; } }
    }
    nloc = mine > 0u ? mine : 1u; nx = cnt > 0u ? cnt : 1u;
}
__device__ __forceinline__ void xcd_barrier(const XcdBarrier& b) {
    asm volatile("s_waitcnt vmcnt(0)" ::: "memory");
    __syncthreads();
    if (threadIdx.x == 0) {
        unsigned* bar = b.bar;
        __builtin_amdgcn_s_waitcnt(0);
        unsigned nloc = b.st[0], nx = b.st[1];
        if (nloc == 0u) { xcd_barrier_complete(bar, b.x, nloc, nx); b.st[0] = nloc; b.st[1] = nx; }
        const unsigned old = xb_add(&bar[XB_XSUB(b.x)], 1u);
        const unsigned gen = old / nloc;
        if (old + 1u == (gen + 1u) * nloc) {
            __builtin_amdgcn_fence(__ATOMIC_RELEASE, "agent");
            asm volatile("s_waitcnt vmcnt(0)" ::: "memory");
            const unsigned og = xb_add(&bar[XB_TOP], 1u);
            const unsigned tg = og / nx;
            if (og + 1u == (tg + 1u) * nx) xb_add(&bar[XB_TOPGEN], 1u);
            else XB_SPIN(xb_ld(&bar[XB_TOPGEN]) == tg, bar);
            __builtin_amdgcn_fence(__ATOMIC_ACQUIRE, "agent");
            xb_add(&bar[XB_XGEN(b.x)], 1u);
            asm volatile("s_waitcnt vmcnt(0)" ::: "memory");
        } else {
            XB_SPIN(xb_ld(&bar[XB_XGEN(b.x)]) == gen, bar);
            __builtin_amdgcn_fence(__ATOMIC_ACQUIRE, "agent");
            asm volatile("s_waitcnt vmcnt(0)" ::: "memory");
        }
    }
    __syncthreads();
}

struct Params {
    const float* x; const float* c; const int* pos; const float* w_ada; const float* b_ada; const float* g_mix; const float* w_in;
    const float* sinks; const float* lq1; const float* lk1; const float* lq2; const float* lk2; const float* subln;
    const float* w_a; const float* w_b; const float* w_out; const float* g_ffn; const float* w_rg; const float* b_rg;
    const float* w_re; const float* b_re; const float* w_gu; const float* w_dn; const float* g_final;
    float* out; unsigned char* ws;
};

struct Ctx { int tid, lane, wave, gw, ngw, gtid, ngt; };
__device__ __forceinline__ Ctx make_ctx() {
    Ctx cx; int t = threadIdx.x; asm volatile("" : "+v"(t));
    cx.tid = t; cx.lane = t & 63; cx.wave = __builtin_amdgcn_readfirstlane(t >> 6);
    cx.gw = blockIdx.x * NWAVES + cx.wave; cx.ngw = gridDim.x * NWAVES; cx.gtid = blockIdx.x * NTHR + t; cx.ngt = gridDim.x * NTHR;
    return cx;
}

template <int MODE> __device__ __forceinline__ int dest_row(int n) {
    if (MODE == 1) {
        const bool rope = (n < C_VA) || (n >= C_QD && n < C_VD);
        if (!rope) return n;
        const int hb = n & ~63, d = n & 63;
        return hb + ((d < 32) ? 2 * d : 2 * (d - 32) + 1);
    }
    if (MODE == 2) {
        const int j = n & 1023, isu = n >> 10;
        return (j >> 7) * 256 + isu * 128 + (j & 127);
    }
    return n;
}
template <int MODE>
__device__ __forceinline__ void transpose_item(const float* W, int K, int N, bf16_t* WT, LAS float* scr, int item, int lane) {
    const int nblk = N / 32, kb = item / nblk, nb = item % nblk, k0 = 64 * kb, n0 = 32 * nb;
    {
        f32x4 v[8];
#pragma unroll
        for (int i = 0; i < 8; ++i) v[i] = *(const f32x4*)(W + (size_t)(k0 + 8 * i + (lane >> 3)) * N + n0 + 4 * (lane & 7));
        __builtin_amdgcn_sched_barrier(0);
#pragma unroll
        for (int i = 0; i < 8; ++i) { LAS float* d = scr + (8 * i + (lane >> 3)) * 33 + 4 * (lane & 7); d[0] = v[i].x; d[1] = v[i].y; d[2] = v[i].z; d[3] = v[i].w; }
    }
    LDS_WAIT(); asm volatile("" ::: "memory");
    const int c = lane & 7;
#pragma unroll
    for (int j = 0; j < 4; ++j) { const int n = (lane >> 3) + 8 * j; const LAS float* s = scr + (8 * c) * 33 + n;
        u32x4 o; o.x = pk2(s[0 * 33], s[1 * 33]); o.y = pk2(s[2 * 33], s[3 * 33]); o.z = pk2(s[4 * 33], s[5 * 33]); o.w = pk2(s[6 * 33], s[7 * 33]);
        *(u32x4*)(WT + (size_t)dest_row<MODE>(n0 + n) * K + k0 + 8 * c) = o; }
    LDS_WAIT(); asm volatile("" ::: "memory");
}

__device__ __forceinline__ void phase_prologue(const Params& p, LAS unsigned char* lds, const Ctx& cx) {
    unsigned char* ws = p.ws;
    LAS float* cact = (LAS float*)lds;
    for (int i = cx.tid; i < NB * ND; i += NTHR) { const float v = p.c[i]; cact[i] = v / (1.f + __expf(-v)); }
    __syncthreads();
    {
        float* mod = (float*)(ws + WS_MOD);
        LAS float* part = (LAS float*)(lds + 65536);
        for (int cb = blockIdx.x; cb < 12288 / 48; cb += gridDim.x) {
            const int cq = cx.lane % 12, kr = cx.lane / 12;
            f32x4 acc[8];
#pragma unroll
            for (int b = 0; b < 8; ++b) acc[b] = (f32x4){0.f, 0.f, 0.f, 0.f};
            if (kr < 5) {
                const float* wp = p.w_ada + 48 * cb + 4 * cq;
#pragma unroll 13
                for (int i = 0; i < 52; ++i) {
                    const int kl = 5 * i + kr;
                    if (kl < 256) {
                        const int k = cx.wave * 256 + kl;
                        const f32x4 wv = *(const f32x4*)(wp + (size_t)k * 12288);
#pragma unroll
                        for (int b = 0; b < 8; ++b) acc[b] += cact[b * ND + k] * wv;
                    }
                }
#pragma unroll
                for (int b = 0; b < 8; ++b) *(LAS f32x4*)(part + ((cx.wave * 5 + kr) * 8 + b) * 48 + 4 * cq) = acc[b];
            }
            __syncthreads();
            if (cx.tid < 384) {
                const int b = cx.tid / 48, j = cx.tid % 48;
                float s = p.b_ada[48 * cb + j];
                for (int q = 0; q < 40; ++q) s += part[(q * 8 + b) * 48 + j];
                mod[(size_t)b * 12288 + 48 * cb + j] = s;
            }
            __syncthreads();
        }
    }
    __syncthreads();
    LAS float* scr = (LAS float*)(lds + cx.wave * 8448);
    constexpr int I_IN = (ND / 64) * (IN_COLS / 32), I_AB = (1024 / 64) * (ND / 32), I_OUT = (ND / 64) * (ND / 32), I_GU = (ND / 64) * (2048 / 32), I_DN = (DE / 64) * (ND / 32);
#if LATE_COPIES
    for (int it = cx.gw; it < I_IN; it += cx.ngw) transpose_item<1>(p.w_in, ND, IN_COLS, (bf16_t*)(ws + WS_WINT), scr, it, cx.lane);
#else
    constexpr int NITEMS = MOE_STREAM ? (I_IN + 2 * I_AB + I_OUT) : (I_IN + 2 * I_AB + I_OUT + NE * I_GU + NE * I_DN);
    for (int it = cx.gw; it < NITEMS; it += cx.ngw) {
        int r = it;
        if (r < I_IN) { transpose_item<1>(p.w_in, ND, IN_COLS, (bf16_t*)(ws + WS_WINT), scr, r, cx.lane); continue; } r -= I_IN;
        if (r < I_AB) { transpose_item<0>(p.w_a, 1024, ND, (bf16_t*)(ws + WS_WAT), scr, r, cx.lane); continue; } r -= I_AB;
        if (r < I_AB) { transpose_item<0>(p.w_b, 1024, ND, (bf16_t*)(ws + WS_WBT), scr, r, cx.lane); continue; } r -= I_AB;
        if (r < I_OUT) { transpose_item<0>(p.w_out, ND, ND, (bf16_t*)(ws + WS_WOUTT), scr, r, cx.lane); continue; } r -= I_OUT;
#if !MOE_STREAM
        if (r < NE * I_GU) { const int e = r / I_GU; transpose_item<2>(p.w_gu + (size_t)e * ND * 2048, ND, 2048, (bf16_t*)(ws + WS_WGUT) + (size_t)e * 2048 * ND, scr, r % I_GU, cx.lane); continue; } r -= NE * I_GU;
        { const int e = r / I_DN; transpose_item<0>(p.w_dn + (size_t)e * DE * ND, DE, ND, (bf16_t*)(ws + WS_WDNT) + (size_t)e * ND * DE, scr, r % I_DN, cx.lane); }
#endif
    }
    { float* wrt = (float*)(ws + WS_WRT);
      for (int i = cx.gtid; i < 80 * ND; i += cx.ngt) { const int j = i >> 11, k = i & (ND - 1); wrt[i] = (j < 64) ? p.w_re[(size_t)k * 64 + j] : (j < 72) ? p.w_rg[(size_t)k * 8 + (j - 64)] : 0.f; } }
#endif
    float* cosT = (float*)(ws + WS_COS); float* sinT = (float*)(ws + WS_SIN);
    for (int i = cx.gtid; i < NM * 32; i += cx.ngt) {
        const int row = i >> 5, fi = i & 31;
        const float ang = (float)p.pos[row] * INVF[fi];
        double s, c; sincos_d((double)ang, s, c);
        cosT[i] = (float)c; sinT[i] = (float)s;
    }
}

__device__ __forceinline__ void late_weight_copies(const Params& p, LAS unsigned char* lds, const Ctx& cx, int first, int nhelp) {
    unsigned char* ws = p.ws;
    LAS float* scr = (LAS float*)(lds + cx.wave * 8448);
    constexpr int I_AB = (1024 / 64) * (ND / 32), I_OUT = (ND / 64) * (ND / 32);
    const int hw = ((int)blockIdx.x - first) * NWAVES + cx.wave, nhw = nhelp * NWAVES;
    for (int it = hw; it < 2 * I_AB + I_OUT; it += nhw) {
        int r = it;
        if (r < I_AB) { transpose_item<0>(p.w_a, 1024, ND, (bf16_t*)(ws + WS_WAT), scr, r, cx.lane); continue; } r -= I_AB;
        if (r < I_AB) { transpose_item<0>(p.w_b, 1024, ND, (bf16_t*)(ws + WS_WBT), scr, r, cx.lane); continue; } r -= I_AB;
        transpose_item<0>(p.w_out, ND, ND, (bf16_t*)(ws + WS_WOUTT), scr, r, cx.lane);
    }
    float* wrt = (float*)(ws + WS_WRT);
    for (int i = ((int)blockIdx.x - first) * NTHR + cx.tid; i < 80 * ND; i += nhelp * NTHR) { const int j = i >> 11, k = i & (ND - 1); wrt[i] = (j < 64) ? p.w_re[(size_t)k * 64 + j] : (j < 72) ? p.w_rg[(size_t)k * 8 + (j - 64)] : 0.f; }
}

__device__ __forceinline__ void phase_h(const Params& p, LAS unsigned char* lds, const Ctx& cx) {
    const float* mod = (const float*)(p.ws + WS_MOD);
    LAS float* shsc = (LAS float*)lds;
    bf16_t* H = (bf16_t*)(p.ws + WS_H);
    f32x4 gmix[8];
#pragma unroll
    for (int j = 0; j < 8; ++j) gmix[j] = *(const f32x4*)(p.g_mix + 4 * cx.lane + 256 * j);
    for (int rb = blockIdx.x; rb < NM / 64; rb += gridDim.x) {
        const int b = rb / (NS / 64);
        __syncthreads();
        for (int j = cx.tid; j < 4096; j += NTHR) shsc[j] = mod[(size_t)b * 12288 + j];
        __syncthreads();
        for (int rr = cx.wave; rr < 64; rr += 2 * NWAVES) {
            const int rowa = rb * 64 + rr, rowb = rowa + NWAVES;
            const f32x4* xa = (const f32x4*)(p.x + (size_t)rowa * ND) + cx.lane; const f32x4* xb = (const f32x4*)(p.x + (size_t)rowb * ND) + cx.lane;
            f32x4 va[8], vb[8]; float sa = 0.f, sb = 0.f;
#pragma unroll
            for (int j = 0; j < 8; ++j) { va[j] = __builtin_nontemporal_load(xa + 64 * j); vb[j] = __builtin_nontemporal_load(xb + 64 * j); }
#pragma unroll
            for (int j = 0; j < 8; ++j) { sa += (va[j].x * va[j].x + va[j].y * va[j].y) + (va[j].z * va[j].z + va[j].w * va[j].w); sb += (vb[j].x * vb[j].x + vb[j].y * vb[j].y) + (vb[j].z * vb[j].z + vb[j].w * vb[j].w); }
            const float ra = 1.f / sqrtf(wave_sum(sa) * (1.f / ND) + RMS_EPS), rbv = 1.f / sqrtf(wave_sum(sb) * (1.f / ND) + RMS_EPS);
            u32x2* oa = (u32x2*)(H + (size_t)rowa * ND) + cx.lane; u32x2* ob = (u32x2*)(H + (size_t)rowb * ND) + cx.lane;
#pragma unroll
            for (int j = 0; j < 8; ++j) {
                const int col = 4 * cx.lane + 256 * j;
                const f32x4 sh = *(const LAS f32x4*)(shsc + col), gs = gmix[j] * (*(const LAS f32x4*)(shsc + 2048 + col) + 1.f);
                const f32x4 ya = va[j] * ra * gs + sh, yb = vb[j] * rbv * gs + sh;
                u32x2 w; w.x = pk2(ya.x, ya.y); w.y = pk2(ya.z, ya.w); oa[64 * j] = w;
                w.x = pk2(yb.x, yb.y); w.y = pk2(yb.z, yb.w); ob[64 * j] = w;
            }
        }
    }
}

template <class AF, class BF, class MF, class EF>
__device__ __forceinline__ void ngemm_tile(LAS unsigned char* lds, int K, int midk, const AF& af, const BF& bf, const MF& mf, const EF& ef, int tid) {
    LAS float* As = (LAS float*)lds; LAS float* Bs = As + 32 * 68;
    const int ty = tid >> 4, tx = tid & 15, lr = tid >> 3, lk = (tid & 7) * 4;
    f32x4 acc0 = (f32x4){0.f, 0.f, 0.f, 0.f}, acc1 = acc0;
    for (int k0 = 0; k0 < K; k0 += 32) {
        if (k0 == midk) { mf(2 * ty, 4 * tx, acc0); mf(2 * ty + 1, 4 * tx, acc1); }
        const bf16_t* pa = af(lr, k0); const bf16_t* pb = bf(lr, k0);
        u32x2 ra = (u32x2){0u, 0u}, rb = ra;
        if (pa) ra = *(const u32x2*)(pa + lk);
        if (pb) rb = *(const u32x2*)(pb + lk);
        __syncthreads();
        As[(lk + 0) * 68 + lr] = bf2f(ra.x & 0xffffu); As[(lk + 1) * 68 + lr] = bf2f(ra.x >> 16); As[(lk + 2) * 68 + lr] = bf2f(ra.y & 0xffffu); As[(lk + 3) * 68 + lr] = bf2f(ra.y >> 16);
        Bs[(lk + 0) * 68 + lr] = bf2f(rb.x & 0xffffu); Bs[(lk + 1) * 68 + lr] = bf2f(rb.x >> 16); Bs[(lk + 2) * 68 + lr] = bf2f(rb.y & 0xffffu); Bs[(lk + 3) * 68 + lr] = bf2f(rb.y >> 16);
        __syncthreads();
#pragma unroll 8
        for (int kk = 0; kk < 32; ++kk) {
            const f32x2 a = *(const LAS f32x2*)(As + kk * 68 + 2 * ty);
            const f32x4 b = *(const LAS f32x4*)(Bs + kk * 68 + 4 * tx);
            acc0 += a.x * b; acc1 += a.y * b;
        }
    }
    ef(2 * ty, 4 * tx, acc0); ef(2 * ty + 1, 4 * tx, acc1);
    __syncthreads();
}
struct NoMid { __device__ __forceinline__ void operator()(int, int, f32x4&) const {} };

struct InA { const bf16_t* H; int row0; __device__ __forceinline__ const bf16_t* operator()(int r, int k0) const { return H + (size_t)(row0 + r) * ND + k0; } };
struct InB { const bf16_t* W; int col0; __device__ __forceinline__ const bf16_t* operator()(int n, int k0) const { return W + (size_t)(col0 + n) * ND + k0; } };
struct InEpi {
    unsigned char* ws; int row0, col0;
    __device__ __forceinline__ void operator()(int r, int c, f32x4& v) const {
        const int row = row0 + r, col = col0 + c;
        const bool rope = (col < C_VA) || (col >= C_QD && col < C_VD);
        if (rope) {
            const int i0 = (col & 63) >> 1;
            const float* cosT = (const float*)(ws + WS_COS) + (size_t)row * 32 + i0; const float* sinT = (const float*)(ws + WS_SIN) + (size_t)row * 32 + i0;
            const float c0 = cosT[0], c1 = cosT[1], s0 = sinT[0], s1 = sinT[1];
            float o0 = v.x * c0 - v.y * s0, o1 = v.y * c0 + v.x * s0, o2 = v.z * c1 - v.w * s1, o3 = v.w * c1 + v.z * s1;
            const bool isq = (col < C_KA) || (col >= C_QD && col < C_KD);
            if (isq) { o0 *= C2; o1 *= C2; o2 *= C2; o3 *= C2; }
            bf16_t* dst;
            if (col < C_KA) dst = (bf16_t*)(ws + WS_QA) + (size_t)row * 1024 + col;
            else if (col < C_VA) dst = (bf16_t*)(ws + WS_KA) + (size_t)row * 128 + (col - C_KA);
            else if (col < C_KD) dst = (bf16_t*)(ws + WS_QD) + (size_t)row * 1024 + (col - C_QD);
            else dst = (bf16_t*)(ws + WS_KD) + (size_t)row * 1024 + (col - C_KD);
            u32x2 w; w.x = pk2(o0, o1); w.y = pk2(o2, o3); *(u32x2*)dst = w;
        } else if (col < C_GA) {
            bf16_t* dst = (col < C_QD) ? (bf16_t*)(ws + WS_VA) + (size_t)row * 128 + (col - C_VA) : (bf16_t*)(ws + WS_VD) + (size_t)row * 1024 + (col - C_VD);
            u32x2 w; w.x = pk2(v.x, v.y); w.y = pk2(v.z, v.w); *(u32x2*)dst = w;
        } else {
            bf16_t* dst = (bf16_t*)(ws + WS_G) + (size_t)row * 4096 + (col - C_GA);
            u32x2 w; w.x = pk2(1.f / (1.f + __expf(-v.x)), 1.f / (1.f + __expf(-v.y))); w.y = pk2(1.f / (1.f + __expf(-v.z)), 1.f / (1.f + __expf(-v.w))); *(u32x2*)dst = w;
        }
    }
};
__device__ __forceinline__ void phase_inproj_naive(const Params& p, LAS unsigned char* lds, const Ctx& cx) {
    constexpr int NTN = IN_COLS / 64, NT = (NM / 64) * NTN;
    for (int t = blockIdx.x; t < NT; t += gridDim.x) {
        const int tm = t / NTN, tn = t % NTN;
        InA af{(const bf16_t*)(p.ws + WS_H), tm * 64}; InB bf{(const bf16_t*)(p.ws + WS_WINT), tn * 64}; InEpi ef{p.ws, tm * 64, tn * 64};
        ngemm_tile(lds, ND, -1, af, bf, NoMid(), ef, cx.tid);
    }
}

__device__ __forceinline__ void load8(const bf16_t* p, float* d) {
    const u32x4 w = *(const u32x4*)p;
    d[0] = bf2f(w.x & 0xffffu); d[1] = bf2f(w.x >> 16); d[2] = bf2f(w.y & 0xffffu); d[3] = bf2f(w.y >> 16);
    d[4] = bf2f(w.z & 0xffffu); d[5] = bf2f(w.z >> 16); d[6] = bf2f(w.w & 0xffffu); d[7] = bf2f(w.w >> 16);
}
__device__ __forceinline__ void phase_swa_naive(const Params& p, const Ctx& cx) {
    const bf16_t* QA = (const bf16_t*)(p.ws + WS_QA); const bf16_t* KA = (const bf16_t*)(p.ws + WS_KA); const bf16_t* VA = (const bf16_t*)(p.ws + WS_VA);
    bf16_t* OA = (bf16_t*)(p.ws + WS_OA);
    for (int it = cx.gtid; it < NB * 16 * NS; it += cx.ngt) {
        const int s = it & (NS - 1), qh = (it >> 11) & 15, b = it >> 15, kvh = qh >> 3;
        const int row = b * NS + s, s0 = s - cx.lane;
        float q[64], acc[64];
#pragma unroll
        for (int d = 0; d < 64; d += 8) load8(QA + (size_t)row * 1024 + qh * 64 + d, q + d);
#pragma unroll
        for (int d = 0; d < 64; ++d) acc[d] = 0.f;
        float m = p.sinks[qh] * LOG2E, l = 1.f;
        const int klo = (s0 - 127 < 0) ? 0 : s0 - 127, khi = s0 + 63;
        for (int kp = klo; kp <= khi; ++kp) {
            const bf16_t* kr = KA + (size_t)(b * NS + kp) * 128 + kvh * 64;
            float sc = 0.f;
#pragma unroll
            for (int d = 0; d < 64; d += 8) { float kk[8]; load8(kr + d, kk);
#pragma unroll
                for (int j = 0; j < 8; ++j) sc += q[d + j] * kk[j]; }
            const bool valid = (kp <= s) && (s - kp < 128);
            if (valid) {
                const float mn = fmaxf(m, sc), alpha = exp2f(m - mn), pe = exp2f(sc - mn);
                l = l * alpha + pe; m = mn;
                const bf16_t* vr = VA + (size_t)(b * NS + kp) * 128 + kvh * 64;
#pragma unroll
                for (int d = 0; d < 64; d += 8) { float vv[8]; load8(vr + d, vv);
#pragma unroll
                    for (int j = 0; j < 8; ++j) acc[d + j] = acc[d + j] * alpha + pe * vv[j]; }
            }
        }
        const float il = 1.f / l;
        bf16_t* o = OA + (size_t)row * 1024 + qh * 64;
#pragma unroll
        for (int d = 0; d < 64; d += 8) { u32x4 w; w.x = pk2(acc[d] * il, acc[d + 1] * il); w.y = pk2(acc[d + 2] * il, acc[d + 3] * il); w.z = pk2(acc[d + 4] * il, acc[d + 5] * il); w.w = pk2(acc[d + 6] * il, acc[d + 7] * il); *(u32x4*)(o + d) = w; }
    }
}
__device__ __forceinline__ float diff_lambda(const Params& p) {
    float s1 = 0.f, s2 = 0.f;
    for (int i = 0; i < 64; ++i) { s1 += p.lq1[i] * p.lk1[i]; s2 += p.lq2[i] * p.lk2[i]; }
    return expf(s1) - expf(s2) + 0.2f;
}
__device__ __forceinline__ void phase_diff_naive(const Params& p, const Ctx& cx) {
    const bf16_t* QD = (const bf16_t*)(p.ws + WS_QD); const bf16_t* KD = (const bf16_t*)(p.ws + WS_KD); const bf16_t* VD = (const bf16_t*)(p.ws + WS_VD);
    bf16_t* OB = (bf16_t*)(p.ws + WS_OB); float* TMP = (float*)(p.ws + WS_TMP);
    const float lam = diff_lambda(p);
    for (int it = cx.gtid; it < NB * 8 * NS; it += cx.ngt) {
        const int s = it & (NS - 1), h = (it >> 11) & 7, b = it >> 14;
        const int row = b * NS + s, smax = s - cx.lane + 63;
        float* tr = TMP + (size_t)row * 1024 + h * 128;
        float ssq = 0.f;
        for (int vh = 0; vh < 2; ++vh) {
            for (int c = 0; c < 2; ++c) {
                float q[64], acc[64];
#pragma unroll
                for (int d = 0; d < 64; d += 8) load8(QD + (size_t)row * 1024 + (2 * h + c) * 64 + d, q + d);
#pragma unroll
                for (int d = 0; d < 64; ++d) acc[d] = 0.f;
                float m = -1e30f, l = 0.f;
                for (int kp = 0; kp <= smax; ++kp) {
                    const bf16_t* kr = KD + (size_t)(b * NS + kp) * 1024 + (2 * h + c) * 64;
                    float sc = 0.f;
#pragma unroll
                    for (int d = 0; d < 64; d += 8) { float kk[8]; load8(kr + d, kk);
#pragma unroll
                        for (int j = 0; j < 8; ++j) sc += q[d + j] * kk[j]; }
                    if (kp <= s) {
                        const float mn = fmaxf(m, sc), alpha = exp2f(m - mn), pe = exp2f(sc - mn);
                        l = l * alpha + pe; m = mn;
                        const bf16_t* vr = VD + (size_t)(b * NS + kp) * 1024 + h * 128 + vh * 64;
#pragma unroll
                        for (int d = 0; d < 64; d += 8) { float vv[8]; load8(vr + d, vv);
#pragma unroll
                            for (int j = 0; j < 8; ++j) acc[d + j] = acc[d + j] * alpha + pe * vv[j]; }
                    }
                }
                const float il = 1.f / l;
                if (c == 0) {
#pragma unroll
                    for (int d = 0; d < 64; d += 4) *(f32x4*)(tr + vh * 64 + d) = (f32x4){acc[d] * il, acc[d + 1] * il, acc[d + 2] * il, acc[d + 3] * il};
                } else {
#pragma unroll
                    for (int d = 0; d < 64; d += 4) { f32x4 t = *(const f32x4*)(tr + vh * 64 + d);
                        t.x -= lam * acc[d] * il; t.y -= lam * acc[d + 1] * il; t.z -= lam * acc[d + 2] * il; t.w -= lam * acc[d + 3] * il;
                        ssq += (t.x * t.x + t.y * t.y) + (t.z * t.z + t.w * t.w); *(f32x4*)(tr + vh * 64 + d) = t; }
                }
            }
        }
        const float rstd = 0.8f / sqrtf(ssq * (1.f / 128.f) + RMS_EPS);
        bf16_t* o = OB + (size_t)row * 1024 + h * 128;
        for (int d = 0; d < 128; d += 4) { const f32x4 t = *(const f32x4*)(tr + d); const f32x4 g = *(const f32x4*)(p.subln + d);
            u32x2 w; w.x = pk2(t.x * rstd * g.x, t.y * rstd * g.y); w.y = pk2(t.z * rstd * g.z, t.w * rstd * g.w); *(u32x2*)(o + d) = w; }
    }
}

namespace att {
using bf16=unsigned short;
using bf16x8=__attribute__((ext_vector_type(8)))short;
using s16x4=__attribute__((ext_vector_type(4)))short;
using f32x16=__attribute__((ext_vector_type(16)))float;
using u32x4=__attribute__((ext_vector_type(4)))unsigned;
constexpr int D=64;
constexpr int NW=8,QBLK=32,QB=QBLK*NW,KVBLK=64;
__device__ __forceinline__ int crow(int r,int hi){return (r&3)+8*(r>>2)+4*hi;}
#define SBAR() __builtin_amdgcn_sched_barrier(0)
__device__ __forceinline__ void cmask(f32x16&p0,f32x16&p1,int jb,int qrel,int hi){
  const float NEG=-INFINITY; int kb=64*jb+4*hi;
  #pragma unroll
  for(int r=0;r<16;++r){int kv=kb+(r&3)+8*(r>>2); if(kv>qrel)p0[r]=NEG; if(kv+32>qrel)p1[r]=NEG;}
}
__device__ __forceinline__ void wmask(f32x16&p0,f32x16&p1,int kv0,int qrel,int hi){
  const float NEG=-1000.f; const int kb=kv0+4*hi;
  #pragma unroll
  for(int r=0;r<16;++r){const int kv=kb+(r&3)+8*(r>>2); if(kv>qrel||qrel-kv>=128)p0[r]=NEG; if(kv+32>qrel||qrel-(kv+32)>=128)p1[r]=NEG;}
}

constexpr int NSLOT=3, SLOTB=8192;
constexpr int LDS_K=0, LDS_V=NSLOT*SLOTB, LDS_WS=2*NSLOT*SLOTB, LDS_OST=LDS_WS+NW*64*4, LDS_BYTES=LDS_OST+NW*4096;
constexpr float C2=0.125f*1.4426950408889634f;
__device__ __forceinline__ void glds16(const void*gsrc,unsigned lds_dst){unsigned keep;
  asm volatile("s_mov_b32 %0, m0\n\ts_mov_b32 m0, %2\n\ts_nop 0\n\tglobal_load_lds_dwordx4 %1, off\n\ts_mov_b32 m0, %0":"=&s"(keep):"v"(gsrc),"s"(lds_dst):"memory");}
__device__ __forceinline__ float max3f(float a,float b,float c){float r;asm("v_max3_f32 %0, %1, %2, %3":"=v"(r):"v"(a),"v"(b),"v"(c));return r;}
__device__ __forceinline__ float max2f(float a,float b){float r;asm("v_max_f32_e32 %0, %1, %2":"=v"(r):"v"(a),"v"(b));return r;}
__device__ __forceinline__ float fadd_s(float a,float b){float r;asm("v_add_f32_e32 %0, %1, %2":"=v"(r):"v"(a),"v"(b));return r;}
__device__ __forceinline__ float fsub_s(float a,float b){float r;asm("v_sub_f32_e32 %0, %1, %2":"=v"(r):"v"(a),"v"(b));return r;}
typedef float f32x2_t __attribute__((ext_vector_type(2))); typedef __bf16 bf16x2_t __attribute__((ext_vector_type(2)));
__device__ __forceinline__ unsigned cvtpk_s(float lo,float hi){f32x2_t v={lo,hi};bf16x2_t b=__builtin_convertvector(v,bf16x2_t);return __builtin_bit_cast(unsigned,b);}
#define WAIT_BAR(N) asm volatile("s_waitcnt vmcnt(" #N ") lgkmcnt(0)\n\ts_barrier":::"memory")

__device__ __forceinline__ void qkt(f32x16&p0,f32x16&p1,const char*Kslot,const bf16x8*qr,const f32x16&negm,int r32,int hi){
  const char*kb=Kslot+hi*1024+r32*16;
  #pragma unroll
  for(int d0=0;d0<4;++d0){
    const bf16x8 b0=*reinterpret_cast<const bf16x8*>(kb+d0*2048);
    const bf16x8 b1=*reinterpret_cast<const bf16x8*>(kb+d0*2048+512);
    if(d0==0){p0=__builtin_amdgcn_mfma_f32_32x32x16_bf16(b0,qr[0],negm,0,0,0);p1=__builtin_amdgcn_mfma_f32_32x32x16_bf16(b1,qr[0],negm,0,0,0);}
    else{p0=__builtin_amdgcn_mfma_f32_32x32x16_bf16(b0,qr[d0],p0,0,0,0);p1=__builtin_amdgcn_mfma_f32_32x32x16_bf16(b1,qr[d0],p1,0,0,0);}}
}
typedef __attribute__((address_space(3))) const char* lds_cptr;
typedef short v4i16_t __attribute__((ext_vector_type(4)));
__device__ __forceinline__ void kload8(bf16x8*kf,lds_cptr kp){
  kf[0]=*(const __attribute__((address_space(3))) bf16x8*)(kp);      kf[1]=*(const __attribute__((address_space(3))) bf16x8*)(kp+512);
  kf[2]=*(const __attribute__((address_space(3))) bf16x8*)(kp+2048); kf[3]=*(const __attribute__((address_space(3))) bf16x8*)(kp+2560);
  kf[4]=*(const __attribute__((address_space(3))) bf16x8*)(kp+4096); kf[5]=*(const __attribute__((address_space(3))) bf16x8*)(kp+4608);
  kf[6]=*(const __attribute__((address_space(3))) bf16x8*)(kp+6144); kf[7]=*(const __attribute__((address_space(3))) bf16x8*)(kp+6656);
}
__device__ __forceinline__ void kload2(bf16x8*kf,lds_cptr kp,int j){ kf[2*j]=*(const __attribute__((address_space(3))) bf16x8*)(kp+j*2048); kf[2*j+1]=*(const __attribute__((address_space(3))) bf16x8*)(kp+j*2048+512); }
__device__ __forceinline__ s16x4 vtr(lds_cptr p){ return __builtin_bit_cast(s16x4,__builtin_amdgcn_ds_read_tr16_b64_v4i16((__attribute__((address_space(3))) v4i16_t*)p)); }
__device__ __forceinline__ float rowmax(const f32x16&p0,const f32x16&p1){
  float a=max3f(p0[0],p0[1],p1[0]),b=max3f(p0[2],p0[3],p1[1]);a=max3f(a,p1[2],p1[3]);
  #pragma unroll
  for(int r=4;r<16;r+=4){a=max3f(a,p0[r],p0[r+1]);b=max3f(b,p0[r+2],p0[r+3]);a=max3f(a,p1[r],p1[r+1]);b=max3f(b,p1[r+2],p1[r+3]);}
  const float m=max2f(a,b);
  auto rr=__builtin_amdgcn_permlane32_swap(__float_as_uint(m),__float_as_uint(m),false,false);
  return max2f(__uint_as_float(rr[0]),__uint_as_float(rr[1]));
}
__device__ __forceinline__ void pv(f32x16*o,int vb,bf16x8 pa0,bf16x8 pa1,bf16x8 pa2,bf16x8 pa3){
  #pragma unroll
  for(int d0=0;d0<2;++d0){s16x4 lo[4],hi[4];
    #pragma unroll
    for(int ks=0;ks<4;++ks){
      asm volatile("ds_read_b64_tr_b16 %0,%1 offset:%c2":"=&v"(lo[ks]):"v"(vb),"i"(d0*4096+ks*1024):"memory");
      asm volatile("ds_read_b64_tr_b16 %0,%1 offset:%c2":"=&v"(hi[ks]):"v"(vb),"i"(d0*4096+ks*1024+512):"memory");}
    asm volatile("s_waitcnt lgkmcnt(0)":::"memory");SBAR();
    #define PK(k) (bf16x8){lo[k][0],lo[k][1],lo[k][2],lo[k][3],hi[k][0],hi[k][1],hi[k][2],hi[k][3]}
    o[d0]=__builtin_amdgcn_mfma_f32_32x32x16_bf16(pa0,PK(0),o[d0],0,0,0);
    o[d0]=__builtin_amdgcn_mfma_f32_32x32x16_bf16(pa1,PK(1),o[d0],0,0,0);
    o[d0]=__builtin_amdgcn_mfma_f32_32x32x16_bf16(pa2,PK(2),o[d0],0,0,0);
    o[d0]=__builtin_amdgcn_mfma_f32_32x32x16_bf16(pa3,PK(3),o[d0],0,0,0);
    #undef PK
  }
}

#ifndef ATTN_STORE16
#define ATTN_STORE16(p,v) (*(u32x4*)(p)=(v))
#endif
struct EpiArgs { int mode; float lam; float sink2; float sink2b; float* stash; const float* subln; bf16* O; };
template<int KIND,int QP,int KP,int THRL> __device__ __forceinline__ void attn_unit(const bf16*Qu,const bf16*__restrict__ Kh,const bf16*__restrict__ Vh,const int NT,const int koff,const EpiArgs ep,char*shm){
  constexpr int DM=KP;
  int tid_=threadIdx.x; asm volatile("":"+v"(tid_));
  const int tid=tid_,lane=tid&63,r32=lane&31,hi=lane>>5; const int wid=__builtin_amdgcn_readfirstlane(tid>>6);
  const int wq=(KIND==1)?(wid&3):wid, wh=(KIND==1)?(wid>>2):0;
  const bf16*Qw=Qu+(long)(wq*QBLK)*QP+wh*64;
  const unsigned lds0=(unsigned)(uintptr_t)shm;
  float*wsf=(float*)(shm+LDS_WS)+wid*64;
  const bf16*ksrc=Kh+(long)lane*DM+wid*8;
  const bf16*vsrc=Vh+(long)(16*(wid&3)+(lane>>2))*DM+(wid>>2)*32+(lane&3)*8;
  const unsigned kdst=lds0+LDS_K+wid*1024, vdst=lds0+LDS_V+wid*1024;
  #define DMA_K(t,slot) glds16(ksrc+(long)(t)*KVBLK*DM,(unsigned)__builtin_amdgcn_readfirstlane(kdst+(slot)))
  #define DMA_V(t,slot) glds16(vsrc+(long)(t)*KVBLK*DM,(unsigned)__builtin_amdgcn_readfirstlane(vdst+(slot)))
  const int vb0=(int)(lds0+LDS_V)+((lane>>4)&1)*32+(lane&3)*8+(4*hi+((lane&15)>>2))*64;
  const char*Kbase=shm+LDS_K; bf16x8 kf[8];
  const lds_cptr shm3=(lds_cptr)shm; const lds_cptr kp0=shm3+LDS_K+hi*1024+r32*16; const lds_cptr vp0=shm3+LDS_V+((lane>>4)&1)*32+(lane&3)*8+(4*hi+((lane&15)>>2))*64;
  DMA_K(0,0);DMA_V(0,0);DMA_K(1,SLOTB);
  bf16x8 qr[4];
  #pragma unroll
  for(int d0=0;d0<4;++d0)qr[d0]=*reinterpret_cast<const bf16x8*>(&Qw[(long)r32*QP+d0*16+hi*8]);
  float mhat=0.f,l_reg=0.f;f32x16 o[2];o[0]=f32x16{};o[1]=f32x16{};f32x16 negm=f32x16{};asm volatile("":"+v"(negm));
  const int qrel=wq*QBLK+r32;
  #define CMASK(P0,P1,t) do{ if(KIND==1){ wmask(P0,P1,64*(t)+koff,qrel,hi); } else { int jb_=(t)-(NT-4); if(jb_>=0)cmask(P0,P1,jb_,qrel,hi); } }while(0)
  bool resc=false;
  #define START(P0,P1) do{ const float rm=rowmax(P0,P1); resc=false; \
    { const float dl=rm; mhat=fadd_s(mhat,dl); \
      _Pragma("unroll") for(int r=0;r<16;++r){P0[r]=fsub_s(P0[r],dl);P1[r]=fsub_s(P1[r],dl);} \
      _Pragma("unroll") for(int r=0;r<16;++r)negm[r]=-mhat; asm volatile("":"+v"(negm)); } \
    _Pragma("unroll") for(int r=0;r<16;++r)P0[r]=__builtin_amdgcn_exp2f(P0[r]); }while(0)
  #define RESC() do{ if(resc){ asm volatile("s_waitcnt lgkmcnt(0)":::"memory"); \
      _Pragma("unroll") for(int d_=0;d_<2;++d_) _Pragma("unroll") for(int r=0;r<16;++r)o[d_][r]*=wsf[crow(r,hi)]; } }while(0)
  f32x16 pA0,pA1,pB0,pB1;
  int sl_prev=0,sl_cur=0,sl_next=SLOTB;
  #define ROT() do{sl_prev=sl_cur;sl_cur=sl_next;sl_next=(sl_next==(NSLOT-1)*SLOTB)?0:sl_next+SLOTB;}while(0)
  DMA_K(2,2*SLOTB);
  WAIT_BAR(3);
  qkt(pA0,pA1,Kbase,qr,negm,r32,hi);asm volatile("s_nop 15\n\ts_nop 7":"+v"(pA0),"+v"(pA1));CMASK(pA0,pA1,0);
  START(pA0,pA1);
  _Pragma("unroll") for(int r=0;r<16;++r)pA1[r]=__builtin_amdgcn_exp2f(pA1[r]);
  WAIT_BAR(0);
  DMA_K(3,0);DMA_V(1,SLOTB);
  ROT();
  kload8(kf,kp0+sl_cur);
  WAIT_BAR(2);
  s16x4 vlo[8],vhi[8]; u32x4 pw0,pw1,pw2,pw3;
  #define PKW(P,B) cvtpk_s(P[B],P[B+1])
  #define PAF(k) __builtin_bit_cast(bf16x8,pw##k)
  #define VFR(i) (bf16x8){vlo[i][0],vlo[i][1],vlo[i][2],vlo[i][3],vhi[i][0],vhi[i][1],vhi[i][2],vhi[i][3]}
  #define PIN(x) asm volatile("":"+v"(x))
  #define MX3(a,b,c) __builtin_fmaxf(__builtin_fmaxf((a),(b)),(c))
  #define GAPA(MF,A0,A1,A2,A3,W0,W1,PW) do{ MF; sacc+=A0; sacc+=A1; sacc+=A2; sacc+=A3; PIN(sacc); W0; W1; PIN(PW); SBAR(); }while(0)
  #define EX(v) __builtin_amdgcn_exp2f(v)
  #define GAPB(MF,X,B) do{ MF; X[B]=EX(X[B]); X[B+1]=EX(X[B+1]); X[B+2]=EX(X[B+2]); X[B+3]=EX(X[B+3]); PIN(X); SBAR(); }while(0)
  #define VRD(i) do{ vlo[i]=vtr(vp_+(((i)>>2)*4096+((i)&3)*1024)); vhi[i]=vtr(vp_+(((i)>>2)*4096+((i)&3)*1024+512)); }while(0)
  #define KRD(G,j) do{ if(G){ kload2(kf,kp0+sl_next,j); SBAR(); } }while(0)
  #define STEP(C0,C1,P0,P1,t,GK,GV,GL) do{ SBAR(); \
    const lds_cptr vp_=vp0+sl_prev; \
    VRD(0); SBAR(); float sacc=(P0[0]+P0[1]); \
    GAPA(C0=__builtin_amdgcn_mfma_f32_32x32x16_bf16(kf[0],qr[0],negm,0,0,0), P0[2],P0[3],P0[4],P0[5],     pw0[0]=PKW(P0,0), pw0[1]=PKW(P0,2), pw0); \
    VRD(4); SBAR(); GAPA(C1=__builtin_amdgcn_mfma_f32_32x32x16_bf16(kf[1],qr[0],negm,0,0,0), P0[6],P0[7],P0[8],P0[9],     pw0[2]=PKW(P0,4), pw0[3]=PKW(P0,6), pw0); \
    VRD(1); SBAR(); GAPA(C0=__builtin_amdgcn_mfma_f32_32x32x16_bf16(kf[2],qr[1],C0,0,0,0),   P0[10],P0[11],P0[12],P0[13], pw1[0]=PKW(P0,8), pw1[1]=PKW(P0,10), pw1); \
    VRD(5); SBAR(); GAPA(C1=__builtin_amdgcn_mfma_f32_32x32x16_bf16(kf[3],qr[1],C1,0,0,0),   P0[14],P0[15],P1[0],P1[1],   pw1[2]=PKW(P0,12),pw1[3]=PKW(P0,14), pw1); \
    VRD(2); SBAR(); GAPA(C0=__builtin_amdgcn_mfma_f32_32x32x16_bf16(kf[4],qr[2],C0,0,0,0),   P1[2],P1[3],P1[4],P1[5],     pw2[0]=PKW(P1,0), pw2[1]=PKW(P1,2), pw2); \
    VRD(6); SBAR(); GAPA(C1=__builtin_amdgcn_mfma_f32_32x32x16_bf16(kf[5],qr[2],C1,0,0,0),   P1[6],P1[7],P1[8],P1[9],     pw2[2]=PKW(P1,4), pw2[3]=PKW(P1,6), pw2); \
    VRD(3); SBAR(); GAPA(C0=__builtin_amdgcn_mfma_f32_32x32x16_bf16(kf[6],qr[3],C0,0,0,0),   P1[10],P1[11],P1[12],P1[13], pw3[0]=PKW(P1,8), pw3[1]=PKW(P1,10), pw3); \
    VRD(7); SBAR(); GAPA(C1=__builtin_amdgcn_mfma_f32_32x32x16_bf16(kf[7],qr[3],C1,0,0,0),   P1[14],P1[15],0.f,0.f,       pw3[2]=PKW(P1,12),pw3[3]=PKW(P1,14), pw3); \
    l_reg+=sacc; \
    if(GK){DMA_K((t)+3,sl_cur);} if(GV){DMA_V((t)+1,sl_next);} \
    CMASK(C0,C1,t); \
    { float a=MX3(C0[0],C0[1],C1[0]),b=MX3(C0[2],C0[3],C1[1]); a=MX3(a,C1[2],C1[3]); \
      _Pragma("unroll") for(int r=4;r<16;r+=4){a=MX3(a,C0[r],C0[r+1]);b=MX3(b,C0[r+2],C0[r+3]);a=MX3(a,C1[r],C1[r+1]);b=MX3(b,C1[r+2],C1[r+3]);} \
      float rm=__builtin_fmaxf(a,b); { auto rr=__builtin_amdgcn_permlane32_swap(__float_as_uint(rm),__float_as_uint(rm),false,false); rm=__builtin_fmaxf(__uint_as_float(rr[0]),__uint_as_float(rr[1])); } \
      resc=false; \
      if(__builtin_expect(__any(rm>(float)THRL),0)){ const float dl=__builtin_fmaxf(rm,0.f); mhat+=dl; \
        _Pragma("unroll") for(int r=0;r<16;++r){C0[r]-=dl;C1[r]-=dl;} \
        _Pragma("unroll") for(int r=0;r<16;++r)negm[r]=-mhat; asm volatile("":"+v"(negm)); \
        const float f=__builtin_amdgcn_exp2f(-dl); l_reg*=f; if(hi==0)wsf[r32]=f; resc=true; } } \
    SBAR(); \
    GAPB(o[0]=__builtin_amdgcn_mfma_f32_32x32x16_bf16(PAF(0),VFR(0),o[0],0,0,0), C0,0); \
    GAPB(o[1]=__builtin_amdgcn_mfma_f32_32x32x16_bf16(PAF(0),VFR(4),o[1],0,0,0), C0,4); \
    KRD(GL,0); GAPB(o[0]=__builtin_amdgcn_mfma_f32_32x32x16_bf16(PAF(1),VFR(1),o[0],0,0,0), C0,8); \
    KRD(GL,1); GAPB(o[1]=__builtin_amdgcn_mfma_f32_32x32x16_bf16(PAF(1),VFR(5),o[1],0,0,0), C0,12); \
    KRD(GL,2); GAPB(o[0]=__builtin_amdgcn_mfma_f32_32x32x16_bf16(PAF(2),VFR(2),o[0],0,0,0), C1,0); \
    KRD(GL,3); GAPB(o[1]=__builtin_amdgcn_mfma_f32_32x32x16_bf16(PAF(2),VFR(6),o[1],0,0,0), C1,4); \
    GAPB(o[0]=__builtin_amdgcn_mfma_f32_32x32x16_bf16(PAF(3),VFR(3),o[0],0,0,0), C1,8); \
    GAPB(o[1]=__builtin_amdgcn_mfma_f32_32x32x16_bf16(PAF(3),VFR(7),o[1],0,0,0), C1,12); \
    }while(0)
  int t=1;
  #undef CMASK
  #define CMASK(P0,P1,t) do{}while(0)
  for(;t+5<NT;t+=2){
    STEP(pB0,pB1,pA0,pA1,t,true,true,true);     WAIT_BAR(2); RESC(); ROT();
    STEP(pA0,pA1,pB0,pB1,t+1,true,true,true);   WAIT_BAR(2); RESC(); ROT();
  }
  #undef CMASK
  #define CMASK(P0,P1,t) do{ if(KIND==1){ wmask(P0,P1,64*(t)+koff,qrel,hi); } else { int jb_=(t)-(NT-4); if(jb_>=0)cmask(P0,P1,jb_,qrel,hi); } }while(0)
  #define ENDW(tt) do{ if((tt)+3<NT){WAIT_BAR(2);} else if((tt)+2<NT){WAIT_BAR(1);} else {WAIT_BAR(0);} }while(0)
  for(;t+1<NT;t+=2){
    STEP(pB0,pB1,pA0,pA1,t,(t+3<NT),(t+1<NT),(t+1<NT));       ENDW(t);   RESC(); ROT();
    STEP(pA0,pA1,pB0,pB1,t+1,(t+4<NT),(t+2<NT),(t+2<NT));     ENDW(t+1); RESC(); ROT();
  }
  STEP(pB0,pB1,pA0,pA1,NT-1,false,false,false); RESC();
  { float sacc=pB0[0]+pB0[1]; _Pragma("unroll") for(int r=2;r<16;++r)sacc+=pB0[r]; _Pragma("unroll") for(int r=0;r<16;++r)sacc+=pB1[r]; l_reg+=sacc;
    pw0=(u32x4){PKW(pB0,0),PKW(pB0,2),PKW(pB0,4),PKW(pB0,6)};pw1=(u32x4){PKW(pB0,8),PKW(pB0,10),PKW(pB0,12),PKW(pB0,14)};pw2=(u32x4){PKW(pB1,0),PKW(pB1,2),PKW(pB1,4),PKW(pB1,6)};pw3=(u32x4){PKW(pB1,8),PKW(pB1,10),PKW(pB1,12),PKW(pB1,14)};
    SBAR(); pv(o,vb0+sl_cur,PAF(0),PAF(1),PAF(2),PAF(3)); }
  #undef PKW
  #undef PAF
  #undef VFR
  #undef PIN
  #undef MX3
  #undef GAPA
  #undef GAPB
  #undef EX
  #undef VRD
  #undef KRD
  #undef STEP
  #undef ENDW
  {auto rr=__builtin_amdgcn_permlane32_swap(__float_as_uint(l_reg),__float_as_uint(l_reg),false,false);l_reg=__uint_as_float(rr[0])+__uint_as_float(rr[1]);}
  if(KIND==1)l_reg+=__builtin_amdgcn_exp2f((wh?ep.sink2b:ep.sink2)-mhat);
  if(hi==0)wsf[32+r32]=l_reg;asm volatile("s_waitcnt lgkmcnt(0)":::"memory");
  float rli[16];
  #pragma unroll
  for(int r=0;r<16;++r)rli[r]=__builtin_amdgcn_rcpf(wsf[32+crow(r,hi)]);
  bf16*stg=(bf16*)(shm+LDS_OST)+wid*2048;
  #define STAGE_OUT(EXPR,OPTR) do{ \
    _Pragma("unroll") for(int r=0;r<16;++r){const int orow=crow(r,hi); _Pragma("unroll") for(int d0=0;d0<2;++d0){ const float val_=(EXPR); stg[orow*64+d0*32+r32]=(bf16)f2bf(val_);} } \
    asm volatile("s_waitcnt lgkmcnt(0)":::"memory"); \
    _Pragma("unroll") for(int i=0;i<4;++i){const int row=i*8+(lane>>3),ch=lane&7; const u32x4 v=*(const u32x4*)(stg+row*64+ch*8); *(u32x4*)((OPTR)+(long)(wq*QBLK+row)*1024+wh*64+ch*8)=v;} \
    asm volatile("s_waitcnt lgkmcnt(0)":::"memory"); }while(0)
  if(KIND==1){
    STAGE_OUT(o[d0][r]*rli[r],ep.O);
  } else {
    float*st=ep.stash+(size_t)(blockIdx.x*NW+wid)*6144+lane;
    const int mode=ep.mode;
    if(mode==0||mode==2){
      #pragma unroll
      for(int d0=0;d0<2;++d0)
        #pragma unroll
        for(int r=0;r<16;++r)st[(d0*16+r)*64]=o[d0][r]*rli[r];
    } else if(mode==1){
      float ssq[16];
      #pragma unroll
      for(int r=0;r<16;++r)ssq[r]=0.f;
      #pragma unroll
      for(int d0=0;d0<2;++d0)
        #pragma unroll
        for(int r=0;r<16;++r){const float rv=st[(d0*16+r)*64]-ep.lam*(o[d0][r]*rli[r]); st[2048+(d0*16+r)*64]=rv; ssq[r]+=rv*rv;}
      #pragma unroll
      for(int r=0;r<16;++r)st[4096+r*64]=ssq[r];
    } else {
      float ssq[16];
      #pragma unroll
      for(int r=0;r<16;++r)ssq[r]=st[4096+r*64];
      #pragma unroll
      for(int d0=0;d0<2;++d0)
        #pragma unroll
        for(int r=0;r<16;++r){const float rv=st[(d0*16+r)*64]-ep.lam*(o[d0][r]*rli[r]); o[d0][r]=rv; ssq[r]+=rv*rv;}
      #pragma unroll
      for(int r=0;r<16;++r){
        #pragma unroll
        for(int k=1;k<32;k<<=1)ssq[r]+=__shfl_xor(ssq[r],k);
        ssq[r]=0.8f/sqrtf(ssq[r]*(1.f/128.f)+1e-6f);
      }
      float g0[2],g1[2];
      #pragma unroll
      for(int d0=0;d0<2;++d0){g0[d0]=ep.subln[d0*32+r32];g1[d0]=ep.subln[64+d0*32+r32];}
      STAGE_OUT(st[2048+(d0*16+r)*64]*ssq[r]*g0[d0],ep.O);
      STAGE_OUT(o[d0][r]*ssq[r]*g1[d0],ep.O+64);
    }
  }
  #undef STAGE_OUT
  asm volatile("s_waitcnt lgkmcnt(0)\n\ts_barrier":::"memory");
  #undef DMA_K
  #undef DMA_V
  #undef CMASK
  #undef START
  #undef RESC
  #undef ROT
}
constexpr int V2SLOT=2*SLOTB, L2_K=0, L2_V=NSLOT*SLOTB, L2_WS=L2_V+NSLOT*V2SLOT, L2_OST=L2_WS+NW*64*4, L2_BYTES=L2_OST+NW*4096;
template<int THRL> __device__ __forceinline__ void attn_unit128(const bf16*Qu,const bf16*__restrict__ Kh,const bf16*__restrict__ Vh,const int NT,const EpiArgs ep,char*shm){
  constexpr int DM=1024, QP=1024;
  int tid_=threadIdx.x; asm volatile("":"+v"(tid_));
  const int tid=tid_,lane=tid&63,r32=lane&31,hi=lane>>5; const int wid=__builtin_amdgcn_readfirstlane(tid>>6);
  const bf16*Qw=Qu+(long)(wid*QBLK)*QP;
  const unsigned lds0=(unsigned)(uintptr_t)shm;
  float*wsf=(float*)(shm+L2_WS)+wid*64;
  const bf16*ksrc=Kh+(long)lane*DM+wid*8;
  const bf16*vsrc=Vh+(long)(16*(wid&3)+(lane>>2))*DM+(wid>>2)*32+(lane&3)*8;
  const unsigned kdst=lds0+L2_K+wid*1024, vdst=lds0+L2_V+wid*1024;
  #define DMA_K(t,slot) glds16(ksrc+(long)(t)*KVBLK*DM,(unsigned)__builtin_amdgcn_readfirstlane(kdst+(slot)))
  #define DMA_V(t,slot) do{ glds16(vsrc+(long)(t)*KVBLK*DM,(unsigned)__builtin_amdgcn_readfirstlane(vdst+2*(slot))); glds16(vsrc+(long)(t)*KVBLK*DM+64,(unsigned)__builtin_amdgcn_readfirstlane(vdst+2*(slot)+8192)); }while(0)
  const int vb0=(int)(lds0+L2_V)+((lane>>4)&1)*32+(lane&3)*8+(4*hi+((lane&15)>>2))*64;
  const char*Kbase=shm+L2_K; bf16x8 kf[8];
  const lds_cptr shm3=(lds_cptr)shm; const lds_cptr kp0=shm3+L2_K+hi*1024+r32*16; const lds_cptr vp0=shm3+L2_V+((lane>>4)&1)*32+(lane&3)*8+(4*hi+((lane&15)>>2))*64;
  DMA_K(0,0);DMA_V(0,0);DMA_K(1,SLOTB);
  bf16x8 qr[4];
  #pragma unroll
  for(int d0=0;d0<4;++d0)qr[d0]=*reinterpret_cast<const bf16x8*>(&Qw[(long)r32*QP+d0*16+hi*8]);
  float mhat=0.f,l_reg=0.f;f32x16 o[4];o[0]=f32x16{};o[1]=f32x16{};o[2]=f32x16{};o[3]=f32x16{};
  const f32x16 zero16=f32x16{};
  const int qrel=wid*QBLK+r32;
  #define CMASK(P0,P1,t) do{ int jb_=(t)-(NT-4); if(jb_>=0)cmask(P0,P1,jb_,qrel,hi); }while(0)
  bool resc=false;
  #define RESC() do{ if(resc){ asm volatile("s_waitcnt lgkmcnt(0)":::"memory"); \
      _Pragma("unroll") for(int d_=0;d_<4;++d_) _Pragma("unroll") for(int r=0;r<16;++r)o[d_][r]*=wsf[crow(r,hi)]; } }while(0)
  f32x16 pA0,pA1,pB0,pB1;
  int sl_prev=0,sl_cur=0,sl_next=SLOTB;
  #define ROT() do{sl_prev=sl_cur;sl_cur=sl_next;sl_next=(sl_next==(NSLOT-1)*SLOTB)?0:sl_next+SLOTB;}while(0)
  DMA_K(2,2*SLOTB);
  WAIT_BAR(4);
  qkt(pA0,pA1,Kbase,qr,zero16,r32,hi);asm volatile("s_nop 15\n\ts_nop 7":"+v"(pA0),"+v"(pA1));CMASK(pA0,pA1,0);
  { const float rm=rowmax(pA0,pA1); mhat=rm;
    _Pragma("unroll") for(int r=0;r<16;++r)pA0[r]=__builtin_amdgcn_exp2f(pA0[r]-mhat);
    _Pragma("unroll") for(int r=0;r<16;++r)pA1[r]=__builtin_amdgcn_exp2f(pA1[r]-mhat); }
  WAIT_BAR(0);
  DMA_K(3,0);DMA_V(1,SLOTB);
  ROT();
  kload8(kf,kp0+sl_cur);
  WAIT_BAR(3);
  s16x4 vlo[8],vhi[8]; u32x4 pw0,pw1,pw2,pw3;
  #define PKW(P,B) cvtpk_s(P[B],P[B+1])
  #define PAF(k) __builtin_bit_cast(bf16x8,pw##k)
  #define VFR(i) (bf16x8){vlo[i][0],vlo[i][1],vlo[i][2],vlo[i][3],vhi[i][0],vhi[i][1],vhi[i][2],vhi[i][3]}
  #define PIN(x) asm volatile("":"+v"(x))
  #define MX3(a,b,c) __builtin_fmaxf(__builtin_fmaxf((a),(b)),(c))
  #define GAPA(MF,A0,A1,A2,A3,W0,W1,PW) do{ MF; sacc+=A0; sacc+=A1; sacc+=A2; sacc+=A3; PIN(sacc); W0; W1; PIN(PW); SBAR(); }while(0)
  #define EX(v) __builtin_amdgcn_exp2f((v)-mh_)
  #define GAPB(MF,X,B) do{ MF; X[B]=EX(X[B]); X[B+1]=EX(X[B+1]); PIN(X); SBAR(); }while(0)
  #define VRD(i) do{ vlo[i]=vtr(vp_+(((i)>>2)*4096+((i)&3)*1024)); vhi[i]=vtr(vp_+(((i)>>2)*4096+((i)&3)*1024+512)); }while(0)
  #define VRD2(i) do{ vlo[i]=vtr(vp_+(8192+((i)>>2)*4096+((i)&3)*1024)); vhi[i]=vtr(vp_+(8192+((i)>>2)*4096+((i)&3)*1024+512)); SBAR(); }while(0)
  #define KRD(G,j) do{ if(G){ kload2(kf,kp0+sl_next,j); SBAR(); } }while(0)
  #define STEP(C0,C1,P0,P1,t,GK,GV,GL) do{ SBAR(); \
    const lds_cptr vp_=vp0+2*sl_prev; \
    VRD(0); SBAR(); float sacc=(P0[0]+P0[1]); \
    GAPA(C0=__builtin_amdgcn_mfma_f32_32x32x16_bf16(kf[0],qr[0],zero16,0,0,0), P0[2],P0[3],P0[4],P0[5],     pw0[0]=PKW(P0,0), pw0[1]=PKW(P0,2), pw0); \
    VRD(4); SBAR(); GAPA(C1=__builtin_amdgcn_mfma_f32_32x32x16_bf16(kf[1],qr[0],zero16,0,0,0), P0[6],P0[7],P0[8],P0[9],     pw0[2]=PKW(P0,4), pw0[3]=PKW(P0,6), pw0); \
    VRD(1); SBAR(); GAPA(C0=__builtin_amdgcn_mfma_f32_32x32x16_bf16(kf[2],qr[1],C0,0,0,0),   P0[10],P0[11],P0[12],P0[13], pw1[0]=PKW(P0,8), pw1[1]=PKW(P0,10), pw1); \
    VRD(5); SBAR(); GAPA(C1=__builtin_amdgcn_mfma_f32_32x32x16_bf16(kf[3],qr[1],C1,0,0,0),   P0[14],P0[15],P1[0],P1[1],   pw1[2]=PKW(P0,12),pw1[3]=PKW(P0,14), pw1); \
    VRD(2); SBAR(); GAPA(C0=__builtin_amdgcn_mfma_f32_32x32x16_bf16(kf[4],qr[2],C0,0,0,0),   P1[2],P1[3],P1[4],P1[5],     pw2[0]=PKW(P1,0), pw2[1]=PKW(P1,2), pw2); \
    VRD(6); SBAR(); GAPA(C1=__builtin_amdgcn_mfma_f32_32x32x16_bf16(kf[5],qr[2],C1,0,0,0),   P1[6],P1[7],P1[8],P1[9],     pw2[2]=PKW(P1,4), pw2[3]=PKW(P1,6), pw2); \
    VRD(3); SBAR(); GAPA(C0=__builtin_amdgcn_mfma_f32_32x32x16_bf16(kf[6],qr[3],C0,0,0,0),   P1[10],P1[11],P1[12],P1[13], pw3[0]=PKW(P1,8), pw3[1]=PKW(P1,10), pw3); \
    VRD(7); SBAR(); GAPA(C1=__builtin_amdgcn_mfma_f32_32x32x16_bf16(kf[7],qr[3],C1,0,0,0),   P1[14],P1[15],0.f,0.f,       pw3[2]=PKW(P1,12),pw3[3]=PKW(P1,14), pw3); \
    l_reg+=sacc; \
    if(GK){DMA_K((t)+3,sl_cur);} if(GV){DMA_V((t)+1,sl_next);} \
    CMASK(C0,C1,t); \
    { float a=MX3(C0[0],C0[1],C1[0]),b=MX3(C0[2],C0[3],C1[1]); a=MX3(a,C1[2],C1[3]); \
      _Pragma("unroll") for(int r=4;r<16;r+=4){a=MX3(a,C0[r],C0[r+1]);b=MX3(b,C0[r+2],C0[r+3]);a=MX3(a,C1[r],C1[r+1]);b=MX3(b,C1[r+2],C1[r+3]);} \
      float rm=__builtin_fmaxf(a,b); { auto rr=__builtin_amdgcn_permlane32_swap(__float_as_uint(rm),__float_as_uint(rm),false,false); rm=__builtin_fmaxf(__uint_as_float(rr[0]),__uint_as_float(rr[1])); } \
      resc=false; \
      if(__builtin_expect(__any(rm-mhat>(float)THRL),0)){ const float dl=__builtin_fmaxf(rm-mhat,0.f); mhat+=dl; \
        const float f=__builtin_amdgcn_exp2f(-dl); l_reg*=f; if(hi==0)wsf[r32]=f; resc=true; } } \
    const float mh_=mhat; \
    SBAR(); \
    GAPB(o[0]=__builtin_amdgcn_mfma_f32_32x32x16_bf16(PAF(0),VFR(0),o[0],0,0,0), C0,0);  VRD2(0); \
    GAPB(o[1]=__builtin_amdgcn_mfma_f32_32x32x16_bf16(PAF(0),VFR(4),o[1],0,0,0), C0,2);  VRD2(4); \
    GAPB(o[0]=__builtin_amdgcn_mfma_f32_32x32x16_bf16(PAF(1),VFR(1),o[0],0,0,0), C0,4);  VRD2(1); \
    GAPB(o[1]=__builtin_amdgcn_mfma_f32_32x32x16_bf16(PAF(1),VFR(5),o[1],0,0,0), C0,6);  VRD2(5); \
    GAPB(o[0]=__builtin_amdgcn_mfma_f32_32x32x16_bf16(PAF(2),VFR(2),o[0],0,0,0), C0,8);  VRD2(2); \
    GAPB(o[1]=__builtin_amdgcn_mfma_f32_32x32x16_bf16(PAF(2),VFR(6),o[1],0,0,0), C0,10); VRD2(6); \
    GAPB(o[0]=__builtin_amdgcn_mfma_f32_32x32x16_bf16(PAF(3),VFR(3),o[0],0,0,0), C0,12); VRD2(3); \
    GAPB(o[1]=__builtin_amdgcn_mfma_f32_32x32x16_bf16(PAF(3),VFR(7),o[1],0,0,0), C0,14); VRD2(7); \
    GAPB(o[2]=__builtin_amdgcn_mfma_f32_32x32x16_bf16(PAF(0),VFR(0),o[2],0,0,0), C1,0); \
    GAPB(o[3]=__builtin_amdgcn_mfma_f32_32x32x16_bf16(PAF(0),VFR(4),o[3],0,0,0), C1,2); \
    KRD(GL,0); GAPB(o[2]=__builtin_amdgcn_mfma_f32_32x32x16_bf16(PAF(1),VFR(1),o[2],0,0,0), C1,4); \
    KRD(GL,1); GAPB(o[3]=__builtin_amdgcn_mfma_f32_32x32x16_bf16(PAF(1),VFR(5),o[3],0,0,0), C1,6); \
    KRD(GL,2); GAPB(o[2]=__builtin_amdgcn_mfma_f32_32x32x16_bf16(PAF(2),VFR(2),o[2],0,0,0), C1,8); \
    KRD(GL,3); GAPB(o[3]=__builtin_amdgcn_mfma_f32_32x32x16_bf16(PAF(2),VFR(6),o[3],0,0,0), C1,10); \
    GAPB(o[2]=__builtin_amdgcn_mfma_f32_32x32x16_bf16(PAF(3),VFR(3),o[2],0,0,0), C1,12); \
    GAPB(o[3]=__builtin_amdgcn_mfma_f32_32x32x16_bf16(PAF(3),VFR(7),o[3],0,0,0), C1,14); \
    }while(0)
  int t=1;
  #undef CMASK
  #define CMASK(P0,P1,t) do{}while(0)
  for(;t+5<NT;t+=2){
    STEP(pB0,pB1,pA0,pA1,t,true,true,true);     WAIT_BAR(3); RESC(); ROT();
    STEP(pA0,pA1,pB0,pB1,t+1,true,true,true);   WAIT_BAR(3); RESC(); ROT();
  }
  #undef CMASK
  #define CMASK(P0,P1,t) do{ int jb_=(t)-(NT-4); if(jb_>=0)cmask(P0,P1,jb_,qrel,hi); }while(0)
  #define ENDW(tt) do{ if((tt)+3<NT){WAIT_BAR(3);} else if((tt)+2<NT){WAIT_BAR(2);} else {WAIT_BAR(0);} }while(0)
  for(;t+1<NT;t+=2){
    STEP(pB0,pB1,pA0,pA1,t,(t+3<NT),(t+1<NT),(t+1<NT));       ENDW(t);   RESC(); ROT();
    STEP(pA0,pA1,pB0,pB1,t+1,(t+4<NT),(t+2<NT),(t+2<NT));     ENDW(t+1); RESC(); ROT();
  }
  STEP(pB0,pB1,pA0,pA1,NT-1,false,false,false); RESC();
  { float sacc=pB0[0]+pB0[1]; _Pragma("unroll") for(int r=2;r<16;++r)sacc+=pB0[r]; _Pragma("unroll") for(int r=0;r<16;++r)sacc+=pB1[r]; l_reg+=sacc;
    pw0=(u32x4){PKW(pB0,0),PKW(pB0,2),PKW(pB0,4),PKW(pB0,6)};pw1=(u32x4){PKW(pB0,8),PKW(pB0,10),PKW(pB0,12),PKW(pB0,14)};pw2=(u32x4){PKW(pB1,0),PKW(pB1,2),PKW(pB1,4),PKW(pB1,6)};pw3=(u32x4){PKW(pB1,8),PKW(pB1,10),PKW(pB1,12),PKW(pB1,14)};
    SBAR(); pv(o,vb0+2*sl_cur,PAF(0),PAF(1),PAF(2),PAF(3)); pv(o+2,vb0+2*sl_cur+8192,PAF(0),PAF(1),PAF(2),PAF(3)); }
  #undef PKW
  #undef PAF
  #undef VFR
  #undef PIN
  #undef MX3
  #undef GAPA
  #undef GAPB
  #undef EX
  #undef VRD
  #undef VRD2
  #undef KRD
  #undef STEP
  #undef ENDW
  {auto rr=__builtin_amdgcn_permlane32_swap(__float_as_uint(l_reg),__float_as_uint(l_reg),false,false);l_reg=__uint_as_float(rr[0])+__uint_as_float(rr[1]);}
  if(hi==0)wsf[32+r32]=l_reg;asm volatile("s_waitcnt lgkmcnt(0)":::"memory");
  float rli[16];
  #pragma unroll
  for(int r=0;r<16;++r)rli[r]=__builtin_amdgcn_rcpf(wsf[32+crow(r,hi)]);
  bf16*stg=(bf16*)(shm+L2_OST)+wid*2048;
  #define STAGE_OUT(EXPR,OPTR) do{ \
    _Pragma("unroll") for(int r=0;r<16;++r){const int orow=crow(r,hi); _Pragma("unroll") for(int d0=0;d0<2;++d0){ const float val_=(EXPR); stg[orow*64+d0*32+r32]=(bf16)f2bf(val_);} } \
    asm volatile("s_waitcnt lgkmcnt(0)":::"memory"); \
    _Pragma("unroll") for(int i=0;i<4;++i){const int row=i*8+(lane>>3),ch=lane&7; const u32x4 v=*(const u32x4*)(stg+row*64+ch*8); *(u32x4*)((OPTR)+(long)(wid*QBLK+row)*1024+ch*8)=v;} \
    asm volatile("s_waitcnt lgkmcnt(0)":::"memory"); }while(0)
  float*st=ep.stash+(size_t)(blockIdx.x*NW+wid)*6144+lane;
  if(ep.mode==0){
    #pragma unroll
    for(int dq=0;dq<4;++dq)
      #pragma unroll
      for(int r=0;r<16;++r)st[(dq*16+r)*64]=o[dq][r]*rli[r];
  } else {
    float ssq[16];
    #pragma unroll
    for(int r=0;r<16;++r)ssq[r]=0.f;
    #pragma unroll
    for(int dq=0;dq<4;++dq)
      #pragma unroll
      for(int r=0;r<16;++r){const float rv=st[(dq*16+r)*64]-ep.lam*(o[dq][r]*rli[r]); o[dq][r]=rv; ssq[r]+=rv*rv;}
    #pragma unroll
    for(int r=0;r<16;++r){
      #pragma unroll
      for(int k=1;k<32;k<<=1)ssq[r]+=__shfl_xor(ssq[r],k);
      ssq[r]=0.8f/sqrtf(ssq[r]*(1.f/128.f)+1e-6f);
    }
    float g0[2],g1[2];
    #pragma unroll
    for(int d0=0;d0<2;++d0){g0[d0]=ep.subln[d0*32+r32];g1[d0]=ep.subln[64+d0*32+r32];}
    STAGE_OUT(o[d0][r]*ssq[r]*g0[d0],ep.O);
    STAGE_OUT(o[2+d0][r]*ssq[r]*g1[d0],ep.O+64);
  }
  #undef STAGE_OUT
  asm volatile("s_waitcnt lgkmcnt(0)\n\ts_barrier":::"memory");
  #undef DMA_K
  #undef DMA_V
  #undef CMASK
  #undef RESC
  #undef ROT
}
constexpr int ATTN_LDS_BYTES=LDS_BYTES;
#undef SBAR
#undef WAIT_BAR
}


__device__ __forceinline__ void phase_attn_fast(const Params& p, char* ldsg) {
    const int G = gridDim.x, bx = blockIdx.x, vcu = (G % 8 == 0) ? (bx % 8) * (G / 8) + bx / 8 : bx;
    const att::bf16* QA = (const att::bf16*)(p.ws + WS_QA); const att::bf16* KA = (const att::bf16*)(p.ws + WS_KA); const att::bf16* VA = (const att::bf16*)(p.ws + WS_VA);
    const att::bf16* QD = (const att::bf16*)(p.ws + WS_QD); const att::bf16* KD = (const att::bf16*)(p.ws + WS_KD); const att::bf16* VD = (const att::bf16*)(p.ws + WS_VD);
    att::bf16* OA = (att::bf16*)(p.ws + WS_OA); att::bf16* OB = (att::bf16*)(p.ws + WS_OB);
    const int UPW = (1024 + G - 1) / G;
    for (int uid = vcu * UPW; uid < (vcu + 1) * UPW && uid < 1024; ++uid) {
        const int grp = uid >> 6, uidx = uid & 63, b = grp >> 1, kvh = grp & 1, qh = kvh * 8 + 2 * (uidx >> 4), qb = uidx & 15;
        const int q0 = 128 * qb, t0 = (2 * qb - 2 < 0) ? 0 : 2 * qb - 2, koff = 64 * t0 - q0;
        att::EpiArgs ep; ep.mode = 0; ep.lam = 0.f; ep.sink2 = p.sinks[qh] * LOG2E; ep.sink2b = p.sinks[qh + 1] * LOG2E; ep.stash = nullptr; ep.subln = nullptr; ep.O = OA + (size_t)(b * NS + q0) * 1024 + qh * 64;
        att::attn_unit<1, 1024, 128, 8>(QA + (size_t)(b * NS + q0) * 1024 + qh * 64, KA + (size_t)(b * NS + 64 * t0) * 128 + kvh * 64, VA + (size_t)(b * NS + 64 * t0) * 128 + kvh * 64, 4, koff, ep, ldsg);
    }
    const float lam = diff_lambda(p);
#ifndef REP_DIFF
#define REP_DIFF 1
#endif
#if DIFF128
    for (int rep_ = 0; rep_ < REP_DIFF; ++rep_)
    for (int slot = vcu; slot < 256; slot += G) {
        const int bh = slot >> 2, s = slot & 3, b = bh >> 3, h = bh & 7;
        for (int i = 0; i < 4; ++i) {
            const int qb = (i < 2) ? 7 - s : s, c = i & 1, q0 = 256 * qb;
            att::EpiArgs ep; ep.mode = c; ep.lam = lam; ep.sink2 = 0.f; ep.sink2b = 0.f; ep.stash = (float*)(p.ws + WS_TMP); ep.subln = p.subln; ep.O = OB + (size_t)(b * NS + q0) * 1024 + h * 128;
            att::attn_unit128<8>(QD + (size_t)(b * NS + q0) * 1024 + (2 * h + c) * 64, KD + (size_t)(b * NS) * 1024 + (2 * h + c) * 64, VD + (size_t)(b * NS) * 1024 + h * 128, 4 * qb + 4, ep, ldsg);
        }
    }
#else
    for (int rep_ = 0; rep_ < REP_DIFF; ++rep_)
    for (int slot = vcu; slot < 256; slot += G) {
        const int bh = slot >> 2, s = slot & 3, b = bh >> 3, h = bh & 7;
        for (int i = 0; i < 8; ++i) {
            const int qb = (i < 4) ? 7 - s : s, piece = i & 3, c = piece & 1, vh = piece >> 1, q0 = 256 * qb;
            att::EpiArgs ep; ep.mode = piece; ep.lam = lam; ep.sink2 = 0.f; ep.sink2b = 0.f; ep.stash = (float*)(p.ws + WS_TMP); ep.subln = p.subln; ep.O = OB + (size_t)(b * NS + q0) * 1024 + h * 128;
            att::attn_unit<0, 1024, 1024, 8>(QD + (size_t)(b * NS + q0) * 1024 + (2 * h + c) * 64, KD + (size_t)(b * NS) * 1024 + (2 * h + c) * 64, VD + (size_t)(b * NS) * 1024 + h * 128 + vh * 64, 4 * qb + 4, -q0, ep, ldsg);
        }
    }
#endif
}

struct BrA { const bf16_t* OA; const bf16_t* OB; int row0; __device__ __forceinline__ const bf16_t* operator()(int r, int k0) const { return (k0 < 1024 ? OA + k0 : OB + (k0 - 1024)) + (size_t)(row0 + r) * 1024; } };
struct BrB { const bf16_t* WA; const bf16_t* WB; int col0; __device__ __forceinline__ const bf16_t* operator()(int n, int k0) const { return (k0 < 1024 ? WA + k0 : WB + (k0 - 1024)) + (size_t)(col0 + n) * 1024; } };
__device__ __forceinline__ void load4bf(const bf16_t* p, f32x4& v) { const u32x2 w = *(const u32x2*)p; v.x = bf2f(w.x & 0xffffu); v.y = bf2f(w.x >> 16); v.z = bf2f(w.y & 0xffffu); v.w = bf2f(w.y >> 16); }
struct BrMid { const bf16_t* G; int row0, col0;
    __device__ __forceinline__ void operator()(int r, int c, f32x4& v) const { f32x4 sa, sb; const bf16_t* g = G + (size_t)(row0 + r) * 4096 + col0 + c; load4bf(g, sa); load4bf(g + 2048, sb);
        v.x *= sa.x / sb.x; v.y *= sa.y / sb.y; v.z *= sa.z / sb.z; v.w *= sa.w / sb.w; } };
struct BrEpi { const bf16_t* G; bf16_t* MG; int row0, col0;
    __device__ __forceinline__ void operator()(int r, int c, f32x4& v) const { f32x4 sb; load4bf(G + (size_t)(row0 + r) * 4096 + 2048 + col0 + c, sb);
        u32x2 w; w.x = pk2(v.x * sb.x, v.y * sb.y); w.y = pk2(v.z * sb.z, v.w * sb.w); *(u32x2*)(MG + (size_t)(row0 + r) * ND + col0 + c) = w; } };
__device__ __forceinline__ void phase_branch_naive(const Params& p, LAS unsigned char* lds, const Ctx& cx) {
    constexpr int NTN = ND / 64, NT = (NM / 64) * NTN;
    for (int t = blockIdx.x; t < NT; t += gridDim.x) {
        const int tm = t / NTN, tn = t % NTN;
        BrA af{(const bf16_t*)(p.ws + WS_OA), (const bf16_t*)(p.ws + WS_OB), tm * 64}; BrB bf{(const bf16_t*)(p.ws + WS_WAT), (const bf16_t*)(p.ws + WS_WBT), tn * 64};
        BrMid mf{(const bf16_t*)(p.ws + WS_G), tm * 64, tn * 64}; BrEpi ef{(const bf16_t*)(p.ws + WS_G), (bf16_t*)(p.ws + WS_MERGED), tm * 64, tn * 64};
        ngemm_tile(lds, 2048, 1024, af, bf, mf, ef, cx.tid);
    }
}
struct OutB { const bf16_t* W; int col0; __device__ __forceinline__ const bf16_t* operator()(int n, int k0) const { return W + (size_t)(col0 + n) * ND + k0; } };
struct OutEpi { const float* x; const float* mod; float* xmid; int row0, col0;
    __device__ __forceinline__ void operator()(int r, int c, f32x4& v) const { const int row = row0 + r, col = col0 + c, b = row / NS;
        const f32x4 xv = *(const f32x4*)(x + (size_t)row * ND + col), gt = *(const f32x4*)(mod + (size_t)b * 12288 + 4096 + col);
        *(f32x4*)(xmid + (size_t)row * ND + col) = xv + gt * v; } };
__device__ __forceinline__ void phase_out_naive(const Params& p, LAS unsigned char* lds, const Ctx& cx) {
    constexpr int NTN = ND / 64, NT = (NM / 64) * NTN;
    for (int t = blockIdx.x; t < NT; t += gridDim.x) {
        const int tm = t / NTN, tn = t % NTN;
        InA af{(const bf16_t*)(p.ws + WS_MERGED), tm * 64}; OutB bf{(const bf16_t*)(p.ws + WS_WOUTT), tn * 64};
        OutEpi ef{p.x, (const float*)(p.ws + WS_MOD), (float*)(p.ws + WS_XMID), tm * 64, tn * 64};
        ngemm_tile(lds, ND, -1, af, bf, NoMid(), ef, cx.tid);
    }
}


namespace pg8 {
typedef short bf16x8 __attribute__((ext_vector_type(8)));
constexpr int BM = 256, BK = 64, HALF = 128, HTB = HALF * BK * 2, STAGE_BYTES = 8 * HTB, NXCD = 8, WGM = 8;
__host__ __device__ __forceinline__ int lds_byte(int r, int c) { const int st = (r >> 4) * 2 + (c >> 5), rr = r & 15, cc = c & 31, ob = rr * 64 + cc * 2; return st * 1024 + (ob ^ (((ob >> 9) & 1) << 5)); }
__host__ __device__ __forceinline__ void stage_rc(int b, int& R, int& C) { const int st = b / 1024, sb = b % 1024, swz = sb ^ (((sb >> 9) & 1) << 5); R = (st >> 1) * 16 + swz / 64; C = (st & 1) * 32 + (swz % 64) / 2; }
__host__ __device__ __forceinline__ int perm32(int rho) { const int n = rho >> 4, i = rho & 15; return 8 * (i >> 2) + 4 * n + (i & 3); }
__device__ __forceinline__ unsigned cvt_pk_bf16(float lo, float hi) { unsigned r; asm volatile("v_cvt_pk_bf16_f32 %0, %1, %2" : "=v"(r) : "v"(lo), "v"(hi)); return r; }

struct Unit { int pm, pn, e, a, b; };

struct GridOrder {
    int nM, nN, nwg, G, c;
    __device__ __forceinline__ void init(int nM_, int nN_, int G_, int c_) { nM = nM_; nN = nN_; nwg = nM * nN; G = G_; c = c_; }
    __device__ __forceinline__ bool tile(int i, int& pm, int& pn) const {
        const long L = (long)i * G + c; if (L >= nwg) return false;
        int wgid = (int)L; { const int q = nwg / NXCD, r = nwg % NXCD, xcd = wgid % NXCD, off = wgid / NXCD; wgid = (xcd < r ? xcd * (q + 1) : r * (q + 1) + (xcd - r) * q) + off; }
        const int nig = WGM * nN, gid = wgid / nig, fm = gid * WGM, gsz = (nM - fm) < WGM ? (nM - fm) : WGM;
        pm = fm + ((wgid % nig) % gsz); pn = (wgid % nig) / gsz; return true;
    }
};

template <class Epi, class Sched, bool ALIGN_EPI>
__device__ __forceinline__ void gemm_phase(LAS unsigned char* lds, const int K, const Sched& S, const Epi& E) {
    int tid_ = threadIdx.x; asm volatile("" : "+v"(tid_));
    const int tid = tid_, wid = __builtin_amdgcn_readfirstlane(tid >> 6), lane = tid & 63, wr = wid >> 2, wc = wid & 3, fr = lane & 15, fq = lane >> 4;
    const int nt = K / BK;
    int sR[2], sC[2]; unsigned voffB[2];
#pragma unroll
    for (int i = 0; i < 2; ++i) { int R, C; stage_rc(tid * 16 + i * 8192, R, C); sR[i] = R; sC[i] = C; const int Rb = Epi::PERM ? ((R & ~31) + perm32(R & 31)) : R; voffB[i] = (unsigned)(Rb * K + C) * 2u; }
    const size_t kstep = (size_t)(BK * 2);
    const size_t hstep = (size_t)HALF * K * 2;
    const unsigned ldsw = (unsigned)wid * 1024u;
    const int aoff = lds_byte(wr * 64 + fr, fq * 8), boff = lds_byte(wc * 32 + fr, fq * 8);
#define PG8_SA(b, h) (((b) * 2 + (h)) * HTB)
#define PG8_SB(b, h) ((4 + (b) * 2 + (h)) * HTB)
#define PG8_STAGE(bufoff, gbase, voff) do { _Pragma("unroll") for (int _i = 0; _i < 2; ++_i) \
        __builtin_amdgcn_global_load_lds((const unsigned*)((const char*)(gbase) + (voff)[_i]), (LAS unsigned*)(lds + (bufoff) + ldsw + _i * 8192), 16, 0, 0); } while (0)
#define PG8_LDA(dst, b, h) do { _Pragma("unroll") for (int m = 0; m < 4; ++m) _Pragma("unroll") for (int k = 0; k < 2; ++k) dst[m][k] = *(const LAS bf16x8*)(lds + PG8_SA(b, h) + aoff + m * 2048 + k * 1024); } while (0)
#define PG8_LDB(dst, b, h) do { _Pragma("unroll") for (int n = 0; n < 2; ++n) _Pragma("unroll") for (int k = 0; k < 2; ++k) dst[n][k] = *(const LAS bf16x8*)(lds + PG8_SB(b, h) + boff + n * 2048 + k * 1024); } while (0)
#define PG8_MMA(ai, bj, At, Bt) do { __builtin_amdgcn_s_setprio(1); _Pragma("unroll") for (int m = 0; m < 4; ++m) _Pragma("unroll") for (int n = 0; n < 2; ++n) _Pragma("unroll") for (int k = 0; k < 2; ++k) \
        acc[ai][bj][m][n] = __builtin_amdgcn_mfma_f32_16x16x32_bf16(Bt[n][k], At[m][k], acc[ai][bj][m][n], 0, 0, 0); __builtin_amdgcn_s_setprio(0); } while (0)
#define PG8_WAIT_V(n) asm volatile("s_waitcnt vmcnt(" #n ")" ::: "memory")
#define PG8_WAIT_L(n) asm volatile("s_waitcnt lgkmcnt(" #n ")" ::: "memory")
#define PG8_BAR __builtin_amdgcn_s_barrier()
#define PG8_SCHED __builtin_amdgcn_sched_barrier(0)
    Unit cur, nxt; int ui = 0;
    if (!S.next(0, cur)) return;
    f32x4 acc[2][2][4][2];
#pragma unroll
    for (int a = 0; a < 2; ++a)
#pragma unroll
        for (int b = 0; b < 2; ++b)
#pragma unroll
            for (int m = 0; m < 4; ++m)
#pragma unroll
                for (int n = 0; n < 2; ++n) acc[a][b][m][n] = (f32x4){0.f, 0.f, 0.f, 0.f};
    bf16x8 At[4][2], B0[2][2], B1[2][2];
    const char* cA; const char* cB; S.ptrs(cur, cA, cB);
    unsigned voffA[2][2], voffX[2][2];
    S.voff(cur, sR, sC, voffA);
#pragma unroll
    for (int h = 0; h < 2; ++h)
#pragma unroll
        for (int i = 0; i < 2; ++i) voffX[h][i] = voffA[h][i];
    PG8_STAGE(PG8_SB(0, 0), cB, voffB); PG8_STAGE(PG8_SB(0, 1), cB + hstep, voffB); PG8_STAGE(PG8_SA(0, 0), cA, voffA[0]); PG8_STAGE(PG8_SA(0, 1), cA, voffA[1]);
    if (wr == 1) PG8_BAR;
    PG8_WAIT_V(2); PG8_BAR;
    PG8_STAGE(PG8_SB(1, 0), cB + kstep, voffB); PG8_STAGE(PG8_SA(1, 0), cA + kstep, voffA[0]); PG8_STAGE(PG8_SB(1, 1), cB + hstep + kstep, voffB);
    PG8_WAIT_V(6); PG8_BAR;
    for (;;) {
        const bool has_next = S.next(ui + 1, nxt);
        const char* nA = cA; const char* nB = cB; if (has_next) S.ptrs(nxt, nA, nB);
        for (int t = 0; t < nt; t += 2) {
            const bool last = (t == nt - 2);
            const char* a1 = cA + (size_t)(t + 1) * kstep;
            const char* a2 = last ? nA : cA + (size_t)(t + 2) * kstep; const char* b2 = last ? nB : cB + (size_t)(t + 2) * kstep;
            const char* a3 = a2 + kstep; const char* b3 = b2 + kstep;
            if (Sched::GATHER) { if (last && has_next) S.voff(nxt, sR, sC, voffX); }
            PG8_LDB(B0, 0, 0); PG8_LDB(B1, 0, 1); PG8_SCHED; PG8_LDA(At, 0, 0); PG8_STAGE(PG8_SA(1, 1), a1, voffA[1]);
            PG8_WAIT_V(8); PG8_WAIT_L(0); PG8_BAR; PG8_MMA(0, 0, At, B0); PG8_MMA(0, 1, At, B1); PG8_BAR; PG8_SCHED;
            PG8_LDA(At, 0, 1); PG8_STAGE(PG8_SB(0, 0), b2, voffB); PG8_STAGE(PG8_SB(0, 1), b2 + hstep, voffB); PG8_STAGE(PG8_SA(0, 0), a2, voffX[0]);
            PG8_WAIT_V(8); PG8_WAIT_L(0); PG8_BAR; PG8_MMA(1, 0, At, B0); PG8_MMA(1, 1, At, B1); PG8_BAR; PG8_SCHED;
            PG8_LDB(B0, 1, 0); PG8_LDB(B1, 1, 1); PG8_SCHED; PG8_LDA(At, 1, 0); PG8_STAGE(PG8_SA(0, 1), a2, voffX[1]);
            PG8_WAIT_V(8); PG8_WAIT_L(0); PG8_BAR; PG8_MMA(0, 0, At, B0); PG8_MMA(0, 1, At, B1); PG8_BAR; PG8_SCHED;
            PG8_LDA(At, 1, 1); PG8_STAGE(PG8_SB(1, 0), b3, voffB); PG8_STAGE(PG8_SB(1, 1), b3 + hstep, voffB); PG8_STAGE(PG8_SA(1, 0), a3, voffX[0]);
            PG8_WAIT_V(8); PG8_WAIT_L(0); PG8_BAR; PG8_MMA(1, 0, At, B0); PG8_MMA(1, 1, At, B1); PG8_BAR; PG8_SCHED;
        }
        if constexpr (ALIGN_EPI) { if (wr == 0) PG8_BAR; }
        E(acc, cur, wr, wc, fr, fq);
        if (!has_next) break;
        if (!E.keep(cur)) {
#pragma unroll
            for (int a = 0; a < 2; ++a)
#pragma unroll
                for (int b = 0; b < 2; ++b)
#pragma unroll
                    for (int m = 0; m < 4; ++m)
#pragma unroll
                        for (int n = 0; n < 2; ++n) acc[a][b][m][n] = (f32x4){0.f, 0.f, 0.f, 0.f};
        }
        cur = nxt; cA = nA; cB = nB; ++ui;
        if (Sched::GATHER) {
#pragma unroll
            for (int h = 0; h < 2; ++h)
#pragma unroll
                for (int i = 0; i < 2; ++i) voffA[h][i] = voffX[h][i];
        }
        if constexpr (ALIGN_EPI) { if (wr == 1) PG8_BAR; }
    }
    PG8_WAIT_V(0);
    if constexpr (!ALIGN_EPI) { if (wr == 0) PG8_BAR; }
    PG8_BAR;
#undef PG8_SA
#undef PG8_SB
#undef PG8_STAGE
#undef PG8_LDA
#undef PG8_LDB
#undef PG8_MMA
#undef PG8_WAIT_V
#undef PG8_WAIT_L
#undef PG8_BAR
#undef PG8_SCHED
}

struct SchedGrid {
    static constexpr bool GATHER = false;
    GridOrder go; const char* A; const char* Bt; int K;
    __device__ __forceinline__ bool next(int i, Unit& u) const { u.e = 0; u.a = 0; u.b = 0; return go.tile(i, u.pm, u.pn); }
    __device__ __forceinline__ void ptrs(const Unit& u, const char*& cA, const char*& cB) const { cA = A + (size_t)u.pm * 256 * K * 2; cB = Bt + (size_t)u.pn * 256 * K * 2; }
    __device__ __forceinline__ void voff(const Unit&, const int (&sR)[2], const int (&sC)[2], unsigned (&vo)[2][2]) const {
#pragma unroll
        for (int h = 0; h < 2; ++h)
#pragma unroll
            for (int i = 0; i < 2; ++i) vo[h][i] = (unsigned)((sR[i] + 128 * h) * K + sC[i]) * 2u;
    }
};
struct SchedBranch {
    static constexpr bool GATHER = false;
    GridOrder go; const char* A0; const char* A1; const char* B0; const char* B1;
    __device__ __forceinline__ bool next(int i, Unit& u) const { u.e = 0; u.b = 0; u.a = i & 1; return go.tile(i >> 1, u.pm, u.pn); }
    __device__ __forceinline__ void ptrs(const Unit& u, const char*& cA, const char*& cB) const { cA = (u.a ? A1 : A0) + (size_t)u.pm * 256 * 1024 * 2; cB = (u.a ? B1 : B0) + (size_t)u.pn * 256 * 1024 * 2; }
    __device__ __forceinline__ void voff(const Unit&, const int (&sR)[2], const int (&sC)[2], unsigned (&vo)[2][2]) const {
#pragma unroll
        for (int h = 0; h < 2; ++h)
#pragma unroll
            for (int i = 0; i < 2; ++i) vo[h][i] = (unsigned)((sR[i] + 128 * h) * 1024 + sC[i]) * 2u;
    }
};
template <bool FIRST> struct SchedMoe {
    static constexpr bool GATHER = FIRST;
    const LAS int* tb; int xcls, rank, nranks; const char* A; const char* W; const int* list;
    __device__ __forceinline__ bool next(int i, Unit& u) const {
        const int L = i * nranks + rank; if (L >= tb[24]) return false;
        int q = 0; while (tb[16 + q + 1] <= L) ++q;
        const int loc = L - tb[16 + q]; u.pm = loc >> 3; u.pn = loc & 7; u.e = xcls + 8 * q; u.a = tb[q]; u.b = tb[8 + q]; return true;
    }
    __device__ __forceinline__ void ptrs(const Unit& u, const char*& cA, const char*& cB) const {
        if (FIRST) { cA = A; cB = W + ((size_t)u.e * 2048 + (size_t)u.pn * 256) * ND * 2; }
        else { cA = A + (size_t)(u.b + u.pm * 256) * DE * 2; cB = W + ((size_t)u.e * 2048 + (size_t)u.pn * 256) * DE * 2; }
    }
    __device__ __forceinline__ void voff(const Unit& u, const int (&sR)[2], const int (&sC)[2], unsigned (&vo)[2][2]) const {
#pragma unroll
        for (int h = 0; h < 2; ++h)
#pragma unroll
            for (int i = 0; i < 2; ++i) {
                if (FIRST) { const int lr = u.pm * 256 + 128 * h + sR[i]; const int tok = (lr < u.a) ? list[(size_t)u.e * ECAP + lr] : 0; vo[h][i] = (unsigned)(tok * ND + sC[i]) * 2u; }
                else vo[h][i] = (unsigned)((sR[i] + 128 * h) * DE + sC[i]) * 2u;
            }
    }
};

__device__ __forceinline__ float sigm(float v) { return __builtin_amdgcn_rcpf(1.f + __builtin_amdgcn_exp2f(-LOG2E * v)); }
__device__ __forceinline__ void unpack8(const u32x4 w, float (&f)[8]) { f[0] = bf2f(w.x & 0xffffu); f[1] = bf2f(w.x >> 16); f[2] = bf2f(w.y & 0xffffu); f[3] = bf2f(w.y >> 16); f[4] = bf2f(w.z & 0xffffu); f[5] = bf2f(w.z >> 16); f[6] = bf2f(w.w & 0xffffu); f[7] = bf2f(w.w >> 16); }

struct EpiIn {
    static constexpr bool PERM = true;
    unsigned char* ws;
    __device__ __forceinline__ bool keep(const Unit&) const { return false; }
    __device__ __forceinline__ void operator()(f32x4 (&acc)[2][2][4][2], const Unit& u, int wr, int wc, int fr, int fq) const {
        const int rowb = u.pm * BM + wr * 64 + fr, lc = wc * 32 + 8 * fq, i0 = (lc & 63) >> 1;
        const float* cosT = (const float*)(ws + WS_COS); const float* sinT = (const float*)(ws + WS_SIN);
        bf16_t* dst[2]; int ldd[2], kind[2];
#pragma unroll
        for (int bj = 0; bj < 2; ++bj) {
            const int cb = u.pn * BM + bj * HALF;
            if (cb < C_KA) { dst[bj] = (bf16_t*)(ws + WS_QA) + cb; ldd[bj] = 1024; kind[bj] = 2; }
            else if (cb < C_VA) { dst[bj] = (bf16_t*)(ws + WS_KA) + (cb - C_KA); ldd[bj] = 128; kind[bj] = 1; }
            else if (cb < C_QD) { dst[bj] = (bf16_t*)(ws + WS_VA) + (cb - C_VA); ldd[bj] = 128; kind[bj] = 0; }
            else if (cb < C_KD) { dst[bj] = (bf16_t*)(ws + WS_QD) + (cb - C_QD); ldd[bj] = 1024; kind[bj] = 2; }
            else if (cb < C_VD) { dst[bj] = (bf16_t*)(ws + WS_KD) + (cb - C_KD); ldd[bj] = 1024; kind[bj] = 1; }
            else if (cb < C_GA) { dst[bj] = (bf16_t*)(ws + WS_VD) + (cb - C_VD); ldd[bj] = 1024; kind[bj] = 0; }
            else { dst[bj] = (bf16_t*)(ws + WS_G) + (cb - C_GA); ldd[bj] = 4096; kind[bj] = 3; }
            dst[bj] += lc;
        }
        const bool any_rope = (kind[0] == 1 || kind[0] == 2 || kind[1] == 1 || kind[1] == 2);
#pragma unroll
        for (int ai = 0; ai < 2; ++ai) {
            f32x4 cs[4], sn[4];
#pragma unroll
            for (int m = 0; m < 4; ++m) { cs[m] = (f32x4){1.f, 1.f, 1.f, 1.f}; sn[m] = (f32x4){0.f, 0.f, 0.f, 0.f}; }
            if (any_rope) {
#pragma unroll
                for (int m = 0; m < 4; ++m) { const size_t ro = (size_t)(rowb + ai * HALF + m * 16) * 32 + i0; cs[m] = *(const f32x4*)(cosT + ro); sn[m] = *(const f32x4*)(sinT + ro); }
            }
            __builtin_amdgcn_sched_barrier(0);
#pragma unroll
            for (int m = 0; m < 4; ++m) {
                const int row = rowb + ai * HALF + m * 16;
#pragma unroll
                for (int bj = 0; bj < 2; ++bj) {
                    const f32x4 v0 = acc[ai][bj][m][0], v1 = acc[ai][bj][m][1];
                    float o[8];
                    if (kind[bj] == 1 || kind[bj] == 2) {
                        const f32x4 c = cs[m], s = sn[m];
                        o[0] = v0[0] * c[0] - v0[1] * s[0]; o[1] = v0[1] * c[0] + v0[0] * s[0]; o[2] = v0[2] * c[1] - v0[3] * s[1]; o[3] = v0[3] * c[1] + v0[2] * s[1];
                        o[4] = v1[0] * c[2] - v1[1] * s[2]; o[5] = v1[1] * c[2] + v1[0] * s[2]; o[6] = v1[2] * c[3] - v1[3] * s[3]; o[7] = v1[3] * c[3] + v1[2] * s[3];
                        if (kind[bj] == 2) {
#pragma unroll
                            for (int j = 0; j < 8; ++j) o[j] *= C2;
                        }
                    } else if (kind[bj] == 3) {
#pragma unroll
                        for (int j = 0; j < 4; ++j) { o[j] = sigm(v0[j]); o[4 + j] = sigm(v1[j]); }
                    } else {
#pragma unroll
                        for (int j = 0; j < 4; ++j) { o[j] = v0[j]; o[4 + j] = v1[j]; }
                    }
                    u32x4 w; w.x = cvt_pk_bf16(o[0], o[1]); w.y = cvt_pk_bf16(o[2], o[3]); w.z = cvt_pk_bf16(o[4], o[5]); w.w = cvt_pk_bf16(o[6], o[7]);
                    *(u32x4*)(dst[bj] + (size_t)row * ldd[bj]) = w;
                }
            }
            __builtin_amdgcn_sched_barrier(0);
        }
    }
};
struct EpiBranch {
    static constexpr bool PERM = true;
    const bf16_t* G; bf16_t* MG;
    __device__ __forceinline__ bool keep(const Unit& u) const { return u.a == 0; }
    __device__ __forceinline__ void operator()(f32x4 (&acc)[2][2][4][2], const Unit& u, int wr, int wc, int fr, int fq) const {
        const int rowb = u.pm * BM + wr * 64 + fr, colb = u.pn * BM + wc * 32 + 8 * fq;
#pragma unroll
        for (int ai = 0; ai < 2; ++ai)
#pragma unroll
            for (int mp = 0; mp < 2; ++mp) {
                u32x4 gb_[2][2], ga_[2][2];
#pragma unroll
                for (int mm = 0; mm < 2; ++mm)
#pragma unroll
                    for (int bj = 0; bj < 2; ++bj) {
                        const bf16_t* gp = G + (size_t)(rowb + ai * HALF + (2 * mp + mm) * 16) * 4096 + colb + bj * HALF;
                        gb_[mm][bj] = *(const u32x4*)(gp + 2048);
                        ga_[mm][bj] = (u.a == 0) ? *(const u32x4*)gp : (u32x4){0u, 0u, 0u, 0u};
                    }
                __builtin_amdgcn_sched_barrier(0);
#pragma unroll
                for (int mm = 0; mm < 2; ++mm) {
                    const int m = 2 * mp + mm, row = rowb + ai * HALF + m * 16;
#pragma unroll
                    for (int bj = 0; bj < 2; ++bj) {
                        float sb[8]; unpack8(gb_[mm][bj], sb);
                        if (u.a == 0) {
                            float sa[8]; unpack8(ga_[mm][bj], sa);
#pragma unroll
                            for (int j = 0; j < 4; ++j) { acc[ai][bj][m][0][j] *= sa[j] * __builtin_amdgcn_rcpf(sb[j]); acc[ai][bj][m][1][j] *= sa[4 + j] * __builtin_amdgcn_rcpf(sb[4 + j]); }
                        } else {
                            const f32x4 v0 = acc[ai][bj][m][0], v1 = acc[ai][bj][m][1];
                            u32x4 w; w.x = cvt_pk_bf16(v0[0] * sb[0], v0[1] * sb[1]); w.y = cvt_pk_bf16(v0[2] * sb[2], v0[3] * sb[3]); w.z = cvt_pk_bf16(v1[0] * sb[4], v1[1] * sb[5]); w.w = cvt_pk_bf16(v1[2] * sb[6], v1[3] * sb[7]);
                            *(u32x4*)(MG + (size_t)row * ND + colb + bj * HALF) = w;
                        }
                    }
                }
                __builtin_amdgcn_sched_barrier(0);
            }
    }
};
struct EpiOut {
    static constexpr bool PERM = false;
    const float* x; const float* mod; float* xmid; float* ssq;
    __device__ __forceinline__ bool keep(const Unit&) const { return false; }
    __device__ __forceinline__ void operator()(f32x4 (&acc)[2][2][4][2], const Unit& u, int wr, int wc, int fr, int fq) const {
        const int rowb = u.pm * BM + wr * 64 + fr, colb = u.pn * BM + wc * 32 + 4 * fq, b = (u.pm * BM) / NS;
        f32x4 gt[2][2];
#pragma unroll
        for (int bj = 0; bj < 2; ++bj)
#pragma unroll
            for (int n = 0; n < 2; ++n) gt[bj][n] = *(const f32x4*)(mod + (size_t)b * 12288 + 4096 + colb + bj * HALF + n * 16);
#pragma unroll
        for (int ai = 0; ai < 2; ++ai)
#pragma unroll
            for (int mp = 0; mp < 2; ++mp) {
                float sq[2] = {0.f, 0.f};
                f32x4 xv[2][2][2];
#pragma unroll
                for (int mm = 0; mm < 2; ++mm)
#pragma unroll
                    for (int bj = 0; bj < 2; ++bj)
#pragma unroll
                        for (int n = 0; n < 2; ++n) xv[mm][bj][n] = *(const f32x4*)(x + (size_t)(rowb + ai * HALF + (2 * mp + mm) * 16) * ND + colb + bj * HALF + n * 16);
                __builtin_amdgcn_sched_barrier(0);
#pragma unroll
                for (int mm = 0; mm < 2; ++mm)
#pragma unroll
                    for (int bj = 0; bj < 2; ++bj)
#pragma unroll
                        for (int n = 0; n < 2; ++n) { const f32x4 o = xv[mm][bj][n] + gt[bj][n] * acc[ai][bj][2 * mp + mm][n];
                            *(f32x4*)(xmid + (size_t)(rowb + ai * HALF + (2 * mp + mm) * 16) * ND + colb + bj * HALF + n * 16) = o; sq[mm] += (o[0] * o[0] + o[1] * o[1]) + (o[2] * o[2] + o[3] * o[3]); }
#pragma unroll
                for (int mm = 0; mm < 2; ++mm) { float s = sq[mm]; s += __shfl_xor(s, 16); s += __shfl_xor(s, 32);
                    if (fq == 0) ssq[(size_t)(rowb + ai * HALF + (2 * mp + mm) * 16) * 32 + 4 * u.pn + wc] = s; }
                __builtin_amdgcn_sched_barrier(0);
            }
    }
};
struct EpiMoe1 {
    static constexpr bool PERM = true;
    bf16_t* ACT;
    __device__ __forceinline__ bool keep(const Unit&) const { return false; }
    __device__ __forceinline__ void operator()(f32x4 (&acc)[2][2][4][2], const Unit& u, int wr, int wc, int fr, int fq) const {
        const int rowb = u.b + u.pm * BM + wr * 64 + fr, j0 = u.pn * HALF + wc * 32 + 8 * fq;
#pragma unroll
        for (int ai = 0; ai < 2; ++ai)
#pragma unroll
            for (int m = 0; m < 4; ++m) {
                float o[8];
#pragma unroll
                for (int n = 0; n < 2; ++n)
#pragma unroll
                    for (int j = 0; j < 4; ++j) { const float g = acc[ai][0][m][n][j], up = acc[ai][1][m][n][j]; o[4 * n + j] = g * sigm(g) * up; }
                u32x4 w; w.x = cvt_pk_bf16(o[0], o[1]); w.y = cvt_pk_bf16(o[2], o[3]); w.z = cvt_pk_bf16(o[4], o[5]); w.w = cvt_pk_bf16(o[6], o[7]);
                *(u32x4*)(ACT + (size_t)(rowb + ai * HALF + m * 16) * DE + j0) = w;
            }
    }
};
struct EpiMoe2 {
    static constexpr bool PERM = true;
    bf16_t* Y; const float* slw;
    __device__ __forceinline__ bool keep(const Unit&) const { return false; }
    __device__ __forceinline__ void operator()(f32x4 (&acc)[2][2][4][2], const Unit& u, int wr, int wc, int fr, int fq) const {
        const int lrb = u.pm * BM + wr * 64 + fr, colb = u.pn * BM + wc * 32 + 8 * fq;
#pragma unroll
        for (int ai = 0; ai < 2; ++ai)
#pragma unroll
            for (int m = 0; m < 4; ++m) {
                const int lr = lrb + ai * HALF + m * 16;
                const float w8 = (lr < u.a) ? slw[(size_t)u.e * ECAP + lr] : 0.f;
#pragma unroll
                for (int bj = 0; bj < 2; ++bj) {
                    const f32x4 v0 = acc[ai][bj][m][0] * w8, v1 = acc[ai][bj][m][1] * w8;
                    u32x4 w; w.x = cvt_pk_bf16(v0[0], v0[1]); w.y = cvt_pk_bf16(v0[2], v0[3]); w.z = cvt_pk_bf16(v1[0], v1[1]); w.w = cvt_pk_bf16(v1[2], v1[3]);
                    *(u32x4*)(Y + (size_t)(u.b + lr) * ND + colb + bj * HALF) = w;
                }
            }
    }
};
}

constexpr int RING_BYTES = 131072, TBL_OFF = 159744 + 1024;
__device__ __forceinline__ void phase_inproj_fast(const Params& p, LAS unsigned char* lds) {
    pg8::SchedGrid S; S.go.init(NM / 256, IN_COLS / 256, gridDim.x, blockIdx.x); S.A = (const char*)(p.ws + WS_H); S.Bt = (const char*)(p.ws + WS_WINT); S.K = ND;
    pg8::EpiIn E{p.ws};
    pg8::gemm_phase<pg8::EpiIn, pg8::SchedGrid, true>(lds, ND, S, E);
#if LATE_COPIES
    {
        const int nun = (NM / 256) * (IN_COLS / 256), rem = nun % (int)gridDim.x, first = rem, nhelp = (int)gridDim.x - rem;
        if ((int)blockIdx.x >= first) late_weight_copies(p, lds, make_ctx(), first, nhelp);
    }
#endif
}
__device__ __forceinline__ void phase_branch_fast(const Params& p, LAS unsigned char* lds) {
    pg8::SchedBranch S; S.go.init(NM / 256, ND / 256, gridDim.x, blockIdx.x);
    S.A0 = (const char*)(p.ws + WS_OA); S.A1 = (const char*)(p.ws + WS_OB); S.B0 = (const char*)(p.ws + WS_WAT); S.B1 = (const char*)(p.ws + WS_WBT);
    pg8::EpiBranch E{(const bf16_t*)(p.ws + WS_G), (bf16_t*)(p.ws + WS_MERGED)};
    pg8::gemm_phase<pg8::EpiBranch, pg8::SchedBranch, true>(lds, 1024, S, E);
}
__device__ __forceinline__ void phase_out_fast(const Params& p, LAS unsigned char* lds) {
    pg8::SchedGrid S; S.go.init(NM / 256, ND / 256, gridDim.x, blockIdx.x); S.A = (const char*)(p.ws + WS_MERGED); S.Bt = (const char*)(p.ws + WS_WOUTT); S.K = ND;
    pg8::EpiOut E{p.x, (const float*)(p.ws + WS_MOD), (float*)(p.ws + WS_XMID), (float*)(p.ws + WS_SSQ)};
    pg8::gemm_phase<pg8::EpiOut, pg8::SchedGrid, true>(lds, ND, S, E);
}
__device__ __forceinline__ void moe_tables(const Params& p, LAS int* tb, int tid) {
    __syncthreads();
    if (tid == 0) {
        const unsigned* cnt = (const unsigned*)(p.ws + WS_CTL) + CW_CNT;
        const int x = blockIdx.x & 7; int ps = 0, up = 0;
        for (int e = 0; e < NE; ++e) { const int n = (int)__hip_atomic_load(cnt + e, __ATOMIC_RELAXED, __HIP_MEMORY_SCOPE_AGENT);
            if ((e & 7) == x) { const int q = e >> 3; tb[q] = n; tb[8 + q] = ps; tb[16 + q] = up; up += ((n + 255) / 256) * 8; }
            ps += (n + PADR - 1) / PADR * PADR; }
        tb[24] = up;
    }
    __syncthreads();
}
__device__ __forceinline__ void phase_moe1_fast(const Params& p, LAS unsigned char* lds, const Ctx& cx) {
    LAS int* tb = (LAS int*)(lds + TBL_OFF);
    moe_tables(p, tb, cx.tid);
    pg8::SchedMoe<true> S{tb, (int)(blockIdx.x & 7), (int)(blockIdx.x >> 3), (int)(gridDim.x >> 3), (const char*)(p.ws + WS_H), (const char*)(p.ws + WS_WGUT), (const int*)(p.ws + WS_LIST)};
    pg8::EpiMoe1 E{(bf16_t*)(p.ws + WS_ACT)};
    pg8::gemm_phase<pg8::EpiMoe1, pg8::SchedMoe<true>, true>(lds, ND, S, E);
}
__device__ __forceinline__ void phase_moe2_fast(const Params& p, LAS unsigned char* lds, const Ctx& cx) {
    LAS int* tb = (LAS int*)(lds + TBL_OFF);
    moe_tables(p, tb, cx.tid);
    pg8::SchedMoe<false> S{tb, (int)(blockIdx.x & 7), (int)(blockIdx.x >> 3), (int)(gridDim.x >> 3), (const char*)(p.ws + WS_ACT), (const char*)(p.ws + WS_WDNT), nullptr};
    pg8::EpiMoe2 E{(bf16_t*)(p.ws + WS_Y), (const float*)(p.ws + WS_SLW)};
    pg8::gemm_phase<pg8::EpiMoe2, pg8::SchedMoe<false>, true>(lds, DE, S, E);
}

__device__ __forceinline__ void phase_router(const Params& p, LAS unsigned char* lds, const Ctx& cx) {
    const float* xmid = (const float*)(p.ws + WS_XMID); const float* mod = (const float*)(p.ws + WS_MOD);
    bf16_t* H2 = (bf16_t*)(p.ws + WS_H);
    unsigned* cnt = (unsigned*)(p.ws + WS_CTL) + CW_CNT;
    int* toke = (int*)(p.ws + WS_TOKE); int* tokr = (int*)(p.ws + WS_TOKR); int* list = (int*)(p.ws + WS_LIST); float* slw = (float*)(p.ws + WS_SLW);
    LAS float* hrow = (LAS float*)(lds + cx.wave * 8192);
    for (int row = cx.gw; row < NM; row += cx.ngw) {
        const int b = row / NS;
        const f32x4* xr = (const f32x4*)(xmid + (size_t)row * ND) + cx.lane;
        f32x4 v[8]; float ss = 0.f;
#pragma unroll
        for (int j = 0; j < 8; ++j) { v[j] = xr[64 * j]; ss += (v[j].x * v[j].x + v[j].y * v[j].y) + (v[j].z * v[j].z + v[j].w * v[j].w); }
        const float rstd = 1.f / sqrtf(wave_sum(ss) * (1.f / ND) + RMS_EPS);
        u32x2* o8 = (u32x2*)(H2 + (size_t)row * ND) + cx.lane;
#pragma unroll
        for (int j = 0; j < 8; ++j) {
            const int col = 4 * cx.lane + 256 * j;
            const f32x4 g = *(const f32x4*)(p.g_ffn + col);
            const f32x4 sh = *(const f32x4*)(mod + (size_t)b * 12288 + 6144 + col), sc = *(const f32x4*)(mod + (size_t)b * 12288 + 8192 + col);
            const f32x4 y = v[j] * rstd * g * (sc + 1.f) + sh;
            u32x2 w; w.x = pk2(y.x, y.y); w.y = pk2(y.z, y.w); o8[64 * j] = w;
            *(LAS f32x4*)(hrow + col) = y;
        }
        LDS_WAIT(); asm volatile("" ::: "memory");
        float eacc = 0.f, gacc = 0.f;
        const float* wre = p.w_re + cx.lane; const float* wrg = p.w_rg + (cx.lane & 7);
#pragma unroll 2
        for (int k = 0; k < ND; k += 4) {
            const f32x4 hv = *(const LAS f32x4*)(hrow + k);
            eacc += hv.x * wre[(size_t)(k + 0) * 64]; eacc += hv.y * wre[(size_t)(k + 1) * 64]; eacc += hv.z * wre[(size_t)(k + 2) * 64]; eacc += hv.w * wre[(size_t)(k + 3) * 64];
            gacc += hv.x * wrg[(size_t)(k + 0) * 8]; gacc += hv.y * wrg[(size_t)(k + 1) * 8]; gacc += hv.z * wrg[(size_t)(k + 2) * 8]; gacc += hv.w * wrg[(size_t)(k + 3) * 8];
        }
        eacc += p.b_re[cx.lane]; gacc += p.b_rg[cx.lane & 7];
        float gl[8];
#pragma unroll
        for (int j = 0; j < 8; ++j) gl[j] = __shfl(gacc, j);
        int gsel = 0; float gmax = gl[0];
#pragma unroll
        for (int j = 1; j < 8; ++j) if (gl[j] > gmax) { gmax = gl[j]; gsel = j; }
        float gsum = 0.f;
#pragma unroll
        for (int j = 0; j < 8; ++j) gsum += expf(gl[j] - gmax);
        const float gweight = 1.f / gsum;
        float el[8];
#pragma unroll
        for (int j = 0; j < 8; ++j) el[j] = __shfl(eacc, gsel * 8 + j);
        int i0 = 0;
#pragma unroll
        for (int j = 1; j < 8; ++j) if (el[j] > el[i0]) i0 = j;
        int i1 = (i0 == 0) ? 1 : 0;
#pragma unroll
        for (int j = 0; j < 8; ++j) if (j != i0 && j != i1 && el[j] > el[i1]) i1 = j;
        const float t = expf(el[i1] - el[i0]);
        const float w0 = gweight / (1.f + t), w1 = gweight * t / (1.f + t);
        if (cx.lane == 0) {
            const int e0 = gsel * 8 + i0, e1 = gsel * 8 + i1;
            const unsigned r0 = atomicAdd(cnt + e0, 1u), r1 = atomicAdd(cnt + e1, 1u);
            toke[row * 2] = e0; toke[row * 2 + 1] = e1; tokr[row * 2] = (int)r0; tokr[row * 2 + 1] = (int)r1;
            list[(size_t)e0 * ECAP + r0] = row; list[(size_t)e1 * ECAP + r1] = row;
            slw[(size_t)e0 * ECAP + r0] = w0; slw[(size_t)e1 * ECAP + r1] = w1;
        }
        LDS_WAIT(); asm volatile("" ::: "memory");
    }
}


__device__ __forceinline__ void phase_router_fast(const Params& p, LAS unsigned char* lds, const Ctx& cx) {
    constexpr int TP = 516;
    LAS float* T = (LAS float*)lds;
    LAS float* LG = (LAS float*)(lds + 132096);
    const float* xmid = (const float*)(p.ws + WS_XMID); const float* mod = (const float*)(p.ws + WS_MOD); const float* wrt = (const float*)(p.ws + WS_WRT);
    bf16_t* H2 = (bf16_t*)(p.ws + WS_H);
    unsigned* cnt = (unsigned*)(p.ws + WS_CTL) + CW_CNT;
    int* toke = (int*)(p.ws + WS_TOKE); int* tokr = (int*)(p.ws + WS_TOKR); int* list = (int*)(p.ws + WS_LIST); float* slw = (float*)(p.ws + WS_SLW);
    const int w = cx.wave, lane = cx.lane, fr = lane & 15, kq = lane >> 4;
    for (int rb = blockIdx.x; rb < NM / 64; rb += gridDim.x) {
        const int row0 = rb * 64, b = row0 / NS;
        LAS float* RS = LG + 64 * 80;
        {
            const f32x4 v = *(const f32x4*)((const float*)(p.ws + WS_SSQ) + (size_t)(row0 + 8 * w + (lane >> 3)) * 32 + 4 * (lane & 7));
            float ss = (v.x + v.y) + (v.z + v.w);
            ss += __shfl_xor(ss, 1); ss += __shfl_xor(ss, 2); ss += __shfl_xor(ss, 4);
            if ((lane & 7) == 0) RS[8 * w + (lane >> 3)] = 1.f / sqrtf(ss * (1.f / ND) + RMS_EPS);
        }
        LDS_WAIT(); asm volatile("" ::: "memory");
        f32x4 acc[4][5];
#pragma unroll
        for (int m = 0; m < 4; ++m)
#pragma unroll
            for (int t = 0; t < 5; ++t) acc[m][t] = (f32x4){0.f, 0.f, 0.f, 0.f};
        for (int c = 0; c < 4; ++c) {
#pragma unroll
            for (int j = 0; j < 2; ++j) {
                const int col = 512 * c + 256 * j + 4 * lane;
                const f32x4 g = *(const f32x4*)(p.g_ffn + col);
                const f32x4 sh = *(const f32x4*)(mod + (size_t)b * 12288 + 6144 + col), sc = *(const f32x4*)(mod + (size_t)b * 12288 + 8192 + col);
                const f32x4 gs = g * (sc + 1.f);
#pragma unroll 4
                for (int rr = 0; rr < 8; ++rr) {
                    const int r = 8 * w + rr;
                    const f32x4 xv = *(const f32x4*)(xmid + (size_t)(row0 + r) * ND + col);
                    const f32x4 y = xv * RS[r] * gs + sh;
                    *(LAS f32x4*)(T + r * TP + 256 * j + 4 * lane) = y;
                    u32x2 o; o.x = pk2(y.x, y.y); o.y = pk2(y.z, y.w); *(u32x2*)(H2 + (size_t)(row0 + r) * ND + col) = o;
                }
            }
            __syncthreads();
            const LAS float* ta = T + fr * TP + 64 * w + 4 * kq;
            const float* wb = wrt + (size_t)fr * ND + 512 * c + 64 * w + 4 * kq;
#pragma unroll
            for (int s = 0; s < 4; ++s) {
                f32x4 b4[5];
#pragma unroll
                for (int t = 0; t < 5; ++t) b4[t] = *(const f32x4*)(wb + (size_t)(16 * t) * ND + 16 * s);
#pragma unroll
                for (int m = 0; m < 4; ++m) {
                    const f32x4 a4 = *(const LAS f32x4*)(ta + (16 * m) * TP + 16 * s);
#pragma unroll
                    for (int t = 0; t < 5; ++t) {
                        acc[m][t] = __builtin_amdgcn_mfma_f32_16x16x4f32(a4.x, b4[t].x, acc[m][t], 0, 0, 0);
                        acc[m][t] = __builtin_amdgcn_mfma_f32_16x16x4f32(a4.y, b4[t].y, acc[m][t], 0, 0, 0);
                        acc[m][t] = __builtin_amdgcn_mfma_f32_16x16x4f32(a4.z, b4[t].z, acc[m][t], 0, 0, 0);
                        acc[m][t] = __builtin_amdgcn_mfma_f32_16x16x4f32(a4.w, b4[t].w, acc[m][t], 0, 0, 0);
                    }
                }
            }
            __syncthreads();
        }
        LAS float* PB = T;
#pragma unroll
        for (int step = 4; step >= 1; step >>= 1) {
            if (w >= step && w < 2 * step) {
                LAS float* dstp = PB + (w - step) * (64 * 80);
#pragma unroll
                for (int m = 0; m < 4; ++m)
#pragma unroll
                    for (int t = 0; t < 5; ++t)
#pragma unroll
                        for (int r = 0; r < 4; ++r) dstp[(16 * m + 4 * kq + r) * 80 + 16 * t + fr] = acc[m][t][r];
            }
            __syncthreads();
            if (w < step) {
                const LAS float* srcp = PB + w * (64 * 80);
#pragma unroll
                for (int m = 0; m < 4; ++m)
#pragma unroll
                    for (int t = 0; t < 5; ++t)
#pragma unroll
                        for (int r = 0; r < 4; ++r) acc[m][t][r] += srcp[(16 * m + 4 * kq + r) * 80 + 16 * t + fr];
            }
            __syncthreads();
        }
        if (w == 0) {
#pragma unroll
            for (int t = 0; t < 5; ++t) { const int colj = 16 * t + fr; const float bias = (colj < 64) ? p.b_re[colj] : (colj < 72) ? p.b_rg[colj - 64] : 0.f;
#pragma unroll
                for (int m = 0; m < 4; ++m)
#pragma unroll
                    for (int r = 0; r < 4; ++r) LG[(16 * m + 4 * kq + r) * 80 + colj] = acc[m][t][r] + bias; }
        }
        __syncthreads();
        if (cx.tid < 64) {
            const LAS float* lg = LG + cx.tid * 80; const int row = row0 + cx.tid;
            int gsel = 0; float gmax = lg[64];
            for (int j = 1; j < 8; ++j) { const float v = lg[64 + j]; if (v > gmax) { gmax = v; gsel = j; } }
            float gsum = 0.f;
            for (int j = 0; j < 8; ++j) gsum += expf(lg[64 + j] - gmax);
            const float gweight = 1.f / gsum;
            const LAS float* el = lg + gsel * 8;
            int i0 = 0; float v0 = el[0];
            for (int j = 1; j < 8; ++j) { const float v = el[j]; if (v > v0) { v0 = v; i0 = j; } }
            int i1 = (i0 == 0) ? 1 : 0; float v1 = el[i1];
            for (int j = 0; j < 8; ++j) { const float v = el[j]; if (j != i0 && j != i1 && v > v1) { v1 = v; i1 = j; } }
            const float tt = expf(v1 - v0);
            const float w0 = gweight / (1.f + tt), w1 = gweight * tt / (1.f + tt);
            const int e0 = gsel * 8 + i0, e1 = gsel * 8 + i1;
            const unsigned r0 = atomicAdd(cnt + e0, 1u), r1 = atomicAdd(cnt + e1, 1u);
            toke[row * 2] = e0; toke[row * 2 + 1] = e1; tokr[row * 2] = (int)r0; tokr[row * 2 + 1] = (int)r1;
            list[(size_t)e0 * ECAP + r0] = row; list[(size_t)e1 * ECAP + r1] = row;
            slw[(size_t)e0 * ECAP + r0] = w0; slw[(size_t)e1 * ECAP + r1] = w1;
        }
        __syncthreads();
    }
}

__device__ __forceinline__ void expert_tables(const Params& p, LAS int* tb, int tid) {
    __syncthreads();
    if (tid < 64) {
        const unsigned* cnt = (const unsigned*)(p.ws + WS_CTL) + CW_CNT;
        const int n = (int)__hip_atomic_load(cnt + tid, __ATOMIC_RELAXED, __HIP_MEMORY_SCOPE_AGENT);
        const int pad = (n + PADR - 1) / PADR * PADR, t64 = (n + 63) / 64;
        int ps = pad, tp = t64;
#pragma unroll
        for (int o = 1; o < 64; o <<= 1) { const int a = __shfl_up(ps, o), b = __shfl_up(tp, o); if (tid >= o) { ps += a; tp += b; } }
        tb[tid] = n; tb[64 + tid] = ps - pad; tb[192 + tid] = tp - t64;
        if (tid == 63) { tb[64 + NE] = ps; tb[192 + NE] = tp; }
    }
    __syncthreads();
}

namespace moe {
typedef short bf16x8 __attribute__((ext_vector_type(8)));
typedef short v4i16_t __attribute__((ext_vector_type(4)));
constexpr int NBMAX = 3, A_SLOT = NBMAX * 8 * 2048, NAS = 2, B_OFF = NAS * A_SLOT, B_PITCH = 288, B_SLOT = 32 * B_PITCH, RING_END = B_OFF + 3 * B_SLOT;
constexpr int UROWS = NBMAX * 128;
__host__ __device__ constexpr int rho(int k) { return (k & 3) | (((k >> 3) & 1) << 2) | (((k >> 2) & 1) << 3) | (k & 16); }
#define MOE_WAITV(n) asm volatile("s_waitcnt vmcnt(%0)" :: "n"(n) : "memory")
__device__ __forceinline__ void dma16(unsigned voff, const char* sbase, unsigned lds_dst) {
    unsigned keep; asm volatile("s_mov_b32 %0, m0\n\ts_mov_b32 m0, %3\n\ts_nop 0\n\tglobal_load_lds_dwordx4 %1, %2\n\ts_mov_b32 m0, %0" : "=&s"(keep) : "v"(voff), "s"(sbase), "s"(lds_dst) : "memory"); }
__device__ __forceinline__ void ldw16(f32x4& d, unsigned voff, const char* sbase) { asm volatile("global_load_dwordx4 %0, %1, %2 nt" : "=v"(d) : "v"(voff), "s"(sbase) : "memory"); }

template <bool FIRST, int NBC>
__device__ __forceinline__ void unit_lc(LAS unsigned char* lds, const Params& p, const int e, const int u, const int ps, const int r0, const int r1) {
    constexpr int K = FIRST ? 2048 : 1024, NT = K / 32, KSTART = FIRST ? -8 : -10, NP = 2 * NBC;
    static_assert((NT - KSTART) % 6 == 0 && KSTART <= -8 && (KSTART & 1) == 0, "six register sets rotate over the unrolled iterations; weight tile 0 is issued at iteration -7; iterations pair up");
    int tid_ = threadIdx.x; asm volatile("" : "+v"(tid_));
    const int tid = tid_, lane = tid & 63, w = __builtin_amdgcn_readfirstlane(tid >> 6), fr = lane & 15, fq = lane >> 4;
    const int rot = u * (NT / 16);
#define MOE_BAR() do { asm volatile("s_waitcnt lgkmcnt(0)" ::: "memory"); __builtin_amdgcn_s_barrier(); asm volatile("" ::: "memory"); } while (0)
    if (w < 4) {
        const char* Abase = (const char*)(p.ws + (FIRST ? WS_H : WS_ACT));
        unsigned aoff[NP];
#pragma unroll
        for (int i = 0; i < NP; ++i) {
            const int mt = (w * NP + i) >> 1, h = i & 1, rt = 8 * h + (lane >> 3);
            int lr = r0 + 16 * mt + rt; lr = lr < r1 ? lr : r1 - 1;
            const unsigned cb = (unsigned)(((lane & 7) ^ ((rt >> 1) & 7)) * 16);
            if (FIRST) aoff[i] = (unsigned)((const int*)(p.ws + WS_LIST))[(size_t)e * ECAP + lr] * (unsigned)(ND * 2) + cb;
            else aoff[i] = (unsigned)(ps + lr) * (unsigned)(DE * 2) + cb;
        }
#pragma unroll
        for (int i = 0; i < NP; ++i) asm volatile("" : "+v"(aoff[i]));
        const int t = 64 * w + lane, krow = t >> 5, c4 = t & 31, gi = c4 >> 3, cg = c4 & 7;
        const int gcol = FIRST ? ((c4 < 16 ? 0 : 1024) + 64 * u + 4 * (c4 & 15)) : (128 * u + 4 * c4);
        const char* wbase = (const char*)(FIRST ? p.w_gu + (size_t)e * 2048 * 2048 : p.w_dn + (size_t)e * 1024 * 2048);
        const unsigned woff = (unsigned)(krow * 2048 + gcol) * 4u;
        const int npos = 32 * gi + 4 * (4 * (cg & 1) + (cg >> 1));
        const unsigned bw = (unsigned)(rho(krow) * B_PITCH + 2 * npos);
        const unsigned lds0 = (unsigned)(uintptr_t)lds;
        f32x4 breg[6][4];
#pragma unroll
        for (int s = 0; s < 6; ++s)
#pragma unroll
            for (int i = 0; i < 4; ++i) breg[s][i] = (f32x4){0.f, 0.f, 0.f, 0.f};
        asm volatile("s_waitcnt vmcnt(0)" ::: "memory");
        int kt = KSTART; asm volatile("" : "+s"(kt));
#define MOE_LD_ITER(SET, ODD) do { \
            if (kt >= 0) MOE_BAR(); \
            if ((ODD) && kt >= -1) MOE_WAITV(4);        \
            if (kt + 1 >= 0) { \
                asm volatile("" : "+v"(breg[SET][0]), "+v"(breg[SET][1]), "+v"(breg[SET][2]), "+v"(breg[SET][3]) :: "memory"); \
                if (kt + 1 < NT) { LAS unsigned char* bs = lds + B_OFF + ((kt + 1) % 3) * B_SLOT + bw; \
                    _Pragma("unroll") for (int i = 0; i < 4; ++i) { u32x2 wv; wv.x = pg8::cvt_pk_bf16(breg[SET][i].x, breg[SET][i].y); wv.y = pg8::cvt_pk_bf16(breg[SET][i].z, breg[SET][i].w); \
                        *(LAS u32x2*)(bs + ((i & 1) * 4 + (i >> 1) * 16) * B_PITCH) = wv; } } \
            } \
            if (!(ODD)) { int tt = (kt >> 1) + 1; tt = tt < 0 ? 0 : (tt < NT / 2 ? tt : NT / 2 - 1); const int ta = (2 * tt + rot) & (NT - 1); \
                const unsigned dst = lds0 + (unsigned)((((kt >> 1) + 1) & 1) * A_SLOT + w * NP * 1024); \
                _Pragma("unroll") for (int i = 0; i < NP; ++i) dma16(aoff[i], Abase + ta * 64, dst + i * 1024); } \
            { const int tb_ = (((kt + 7 < 0) ? 0 : (kt + 7 < NT) ? kt + 7 : NT - 1) + rot) & (NT - 1); const char* wb = wbase + (size_t)tb_ * (32 * 2048 * 4); \
                _Pragma("unroll") for (int i = 0; i < 4; ++i) ldw16(breg[SET][i], woff, wb + i * (8 * 2048 * 4)); } \
            ++kt; } while (0)
        for (; kt < NT;) { MOE_LD_ITER(0, 0); MOE_LD_ITER(1, 1); MOE_LD_ITER(2, 0); MOE_LD_ITER(3, 1); MOE_LD_ITER(4, 0); MOE_LD_ITER(5, 1); }
#undef MOE_LD_ITER
        MOE_BAR();
        asm volatile("s_waitcnt vmcnt(0)" : "+v"(breg[0][0]), "+v"(breg[0][1]), "+v"(breg[0][2]), "+v"(breg[0][3]), "+v"(breg[1][0]), "+v"(breg[1][1]), "+v"(breg[1][2]), "+v"(breg[1][3]),
                     "+v"(breg[2][0]), "+v"(breg[2][1]), "+v"(breg[2][2]), "+v"(breg[2][3]) :: "memory");
        asm volatile("" : "+v"(breg[3][0]), "+v"(breg[3][1]), "+v"(breg[3][2]), "+v"(breg[3][3]), "+v"(breg[4][0]), "+v"(breg[4][1]), "+v"(breg[4][2]), "+v"(breg[4][3]),
                     "+v"(breg[5][0]), "+v"(breg[5][1]), "+v"(breg[5][2]), "+v"(breg[5][3]) :: "memory");
    } else {
        const int c = w - 4;
        const int q = (lane & 15) >> 2, pp = lane & 3;
        const unsigned br0 = (unsigned)(rho(8 * fq + q) * B_PITCH + 8 * pp);
        const unsigned ar0 = (unsigned)(c * 2048 + fr * 128 + ((fq ^ ((fr >> 1) & 7)) << 4));
        f32x4 acc[NBC][8];
#pragma unroll
        for (int mi = 0; mi < NBC; ++mi)
#pragma unroll
            for (int j = 0; j < 8; ++j) acc[mi][j] = (f32x4){0.f, 0.f, 0.f, 0.f};
#define MOE_CS_ITER(KT, ODD) do { \
            MOE_BAR(); \
            const LAS unsigned char* as = lds + (((KT) >> 1) & 1) * A_SLOT + ((ODD) ? (ar0 ^ 64u) : ar0); const LAS unsigned char* bs = lds + B_OFF + ((KT) % 3) * B_SLOT + br0; \
            bf16x8 af[NBC]; \
            _Pragma("unroll") for (int mi = 0; mi < NBC; ++mi) af[mi] = *(const LAS bf16x8*)(as + mi * 8192); \
            v4i16_t t0 = __builtin_amdgcn_ds_read_tr16_b64_v4i16((LAS v4i16_t*)(bs)), t1 = __builtin_amdgcn_ds_read_tr16_b64_v4i16((LAS v4i16_t*)(bs + 8 * B_PITCH)); \
            _Pragma("unroll") for (int j = 0; j < 8; ++j) { \
                const bf16x8 wf = (bf16x8){t0[0], t0[1], t0[2], t0[3], t1[0], t1[1], t1[2], t1[3]}; \
                if (j < 7) { t0 = __builtin_amdgcn_ds_read_tr16_b64_v4i16((LAS v4i16_t*)(bs + 32 * (j + 1))); t1 = __builtin_amdgcn_ds_read_tr16_b64_v4i16((LAS v4i16_t*)(bs + 32 * (j + 1) + 8 * B_PITCH)); } \
                __builtin_amdgcn_sched_barrier(0); \
                _Pragma("unroll") for (int mi = 0; mi < NBC; ++mi) acc[mi][j] = __builtin_amdgcn_mfma_f32_16x16x32_bf16(wf, af[mi], acc[mi][j], 0, 0, 0); \
                __builtin_amdgcn_sched_barrier(0); } \
        } while (0)
        for (int kt = 0; kt < NT; kt += 2) { MOE_CS_ITER(kt, 0); MOE_CS_ITER(kt + 1, 1); }
#undef MOE_CS_ITER
        MOE_BAR();
#pragma unroll
        for (int mi = 0; mi < NBC; ++mi) {
            const int lr = r0 + 16 * (4 * mi + c) + fr;
            if (lr < r1) {
                if (FIRST) {
                    bf16_t* dst = (bf16_t*)(p.ws + WS_ACT) + (size_t)(ps + lr) * DE + 64 * u + 8 * fq;
#pragma unroll
                    for (int t = 0; t < 2; ++t) { float o[8];
#pragma unroll
                        for (int jj = 0; jj < 2; ++jj)
#pragma unroll
                            for (int r = 0; r < 4; ++r) { const float g = acc[mi][2 * t + jj][r], up = acc[mi][4 + 2 * t + jj][r]; o[4 * jj + r] = g * pg8::sigm(g) * up; }
                        u32x4 wv; wv.x = pg8::cvt_pk_bf16(o[0], o[1]); wv.y = pg8::cvt_pk_bf16(o[2], o[3]); wv.z = pg8::cvt_pk_bf16(o[4], o[5]); wv.w = pg8::cvt_pk_bf16(o[6], o[7]);
                        *(u32x4*)(dst + 32 * t) = wv; }
                } else {
                    const float rw = ((const float*)(p.ws + WS_SLW))[(size_t)e * ECAP + lr];
                    bf16_t* dst = (bf16_t*)(p.ws + WS_Y) + (size_t)(ps + lr) * ND + 128 * u + 8 * fq;
#pragma unroll
                    for (int t = 0; t < 4; ++t) { const f32x4 v0 = acc[mi][2 * t] * rw, v1 = acc[mi][2 * t + 1] * rw;
                        u32x4 wv; wv.x = pg8::cvt_pk_bf16(v0[0], v0[1]); wv.y = pg8::cvt_pk_bf16(v0[2], v0[3]); wv.z = pg8::cvt_pk_bf16(v1[0], v1[1]); wv.w = pg8::cvt_pk_bf16(v1[2], v1[3]);
                        *(u32x4*)(dst + 32 * t) = wv; }
                }
            }
        }
    }
#undef MOE_BAR
}
struct Pass { int e, u, ps, r0, r1; };
struct PassIt { int i, r0, re, e, u, ps; };
__device__ __forceinline__ bool pass_next(PassIt& it, const LAS int* tb, Pass& P) {
    for (;;) {
        if (it.r0 < it.re) { P.e = it.e; P.u = it.u; P.ps = it.ps; P.r0 = it.r0; P.r1 = (it.re - it.r0 > UROWS) ? it.r0 + UROWS : it.re; it.r0 += UROWS; return true; }
        const int L = it.i * (int)gridDim.x + (int)blockIdx.x; if (L >= NE * 32) return false; ++it.i;
        const int rr = L >> 3; it.e = (L & 7) + 8 * (rr >> 5); it.u = (rr >> 1) & 15; const int half = rr & 1;
        const int n_e = __builtin_amdgcn_readfirstlane(tb[it.e]); it.ps = __builtin_amdgcn_readfirstlane(tb[64 + it.e]);
        const int hr = (n_e + 1) >> 1; it.r0 = half ? hr : 0; it.re = half ? n_e : hr;
    }
}
__device__ __forceinline__ void dma4(unsigned voff, const char* sbase, unsigned lds_dst) {
    unsigned keep; asm volatile("s_mov_b32 %0, m0\n\ts_mov_b32 m0, %3\n\ts_nop 0\n\tglobal_load_lds_dword %1, %2\n\ts_mov_b32 m0, %0" : "=&s"(keep) : "v"(voff), "s"(sbase), "s"(lds_dst) : "memory"); }
constexpr int TOK_OFF = 135168;

template <bool FIRST>
__device__ __forceinline__ void stream_loader(LAS unsigned char* lds, const Params& p, const LAS int* tb) {
    constexpr int K = FIRST ? 2048 : 1024, NT = K / 32, NP = 12;
    static_assert(NT % 8 == 0, "eight register sets");
    int tid_ = threadIdx.x; asm volatile("" : "+v"(tid_));
    const int tid = tid_, lane = tid & 63, w = __builtin_amdgcn_readfirstlane(tid >> 6);
    PassIt it{0, 0, 0, 0, 0, 0}; Pass cur, nxt;
    if (!pass_next(it, tb, cur)) return;
    bool has_nxt = pass_next(it, tb, nxt);
    const char* Abase = (const char*)(p.ws + (FIRST ? WS_H : WS_ACT));
    const char* listb = (const char*)(p.ws + WS_LIST);
    const int t = 64 * w + lane, krow = t >> 5, c4 = t & 31, gi = c4 >> 3, cg = c4 & 7;
    const int npos = 32 * gi + 4 * (4 * (cg & 1) + (cg >> 1));
    const unsigned bw = (unsigned)(rho(krow) * B_PITCH + 2 * npos);
    const unsigned lds0 = (unsigned)(uintptr_t)lds;
    const unsigned wrow = (unsigned)(krow * 2048) * 4u;
#define MOE_GCOL(U) (FIRST ? ((c4 < 16 ? 0 : 1024) + 64 * (U) + 4 * (c4 & 15)) : (128 * (U) + 4 * c4))
#define MOE_WBASE(E) ((const char*)(FIRST ? p.w_gu + (size_t)(E) * 2048 * 2048 : p.w_dn + (size_t)(E) * 1024 * 2048))
    unsigned aoff[NP];
#pragma unroll
    for (int i = 0; i < NP; ++i) {
        const int q_ = 4 * i + w, mt = q_ >> 1, rt = 8 * (q_ & 1) + (lane >> 3);
        int lr = cur.r0 + 16 * mt + rt; lr = lr < cur.r1 ? lr : cur.r1 - 1;
        const unsigned cb = (unsigned)(((lane & 7) ^ ((rt >> 1) & 7)) * 16);
        if (FIRST) aoff[i] = (unsigned)((const int*)listb)[(size_t)cur.e * ECAP + lr] * (unsigned)(ND * 2) + cb;
        else aoff[i] = (unsigned)(cur.ps + lr) * (unsigned)(DE * 2) + cb;
    }
#pragma unroll
    for (int i = 0; i < NP; ++i) asm volatile("" : "+v"(aoff[i]));
    int npieces = (((cur.r1 - cur.r0 + 15) >> 4) * 2 - w + 3) >> 2;
    const char* wbase = MOE_WBASE(cur.e); unsigned woff = wrow + (unsigned)MOE_GCOL(cur.u) * 4u;
    const char* wbaseN = wbase; unsigned woffN = woff; int npiecesN = 0;
    f32x4 breg[8][4];
#pragma unroll
    for (int s = 0; s < 8; ++s)
#pragma unroll
        for (int i = 0; i < 4; ++i) breg[s][i] = (f32x4){0.f, 0.f, 0.f, 0.f};
    asm volatile("s_waitcnt vmcnt(0)" ::: "memory");
    int g0 = 0;
    int kstart = -16;
#define MOE_BAR() do { asm volatile("s_waitcnt lgkmcnt(0)" ::: "memory"); __builtin_amdgcn_s_barrier(); asm volatile("" ::: "memory"); } while (0)
#define MOE_SL_ITER(SET, ODD) do { \
          \
        if (!(ODD) && kt >= 0) { if (FIRST && kt == 0 && kstart == 0) MOE_WAITV(20); else MOE_WAITV(8); } \
        if (kt >= -8 && kt < -3) MOE_WAITV(28);        \
        if (kt == -3 || kt == -1) MOE_WAITV(4);        \
        if (kt >= 0) MOE_BAR(); \
        if ((ODD) && kt + 3 >= 0) {        \
            _Pragma("unroll") for (int h_ = 0; h_ < 2; ++h_) { \
                asm volatile("" : "+v"(breg[((SET) + 1 + h_) & 7][0]), "+v"(breg[((SET) + 1 + h_) & 7][1]), "+v"(breg[((SET) + 1 + h_) & 7][2]), "+v"(breg[((SET) + 1 + h_) & 7][3]) :: "memory"); \
                if (kt + 2 + h_ >= 0 && (kt + 2 + h_ < NT || has_nxt)) { LAS unsigned char* bs = lds + B_OFF + ((kt + 2 + h_) & 3) * B_SLOT + bw; \
                    _Pragma("unroll") for (int i = 0; i < 4; ++i) { u32x2 wv; wv.x = pg8::cvt_pk_bf16(breg[((SET) + 1 + h_) & 7][i].x, breg[((SET) + 1 + h_) & 7][i].y); wv.y = pg8::cvt_pk_bf16(breg[((SET) + 1 + h_) & 7][i].z, breg[((SET) + 1 + h_) & 7][i].w); \
                        *(LAS u32x2*)(bs + ((i & 1) * 4 + (i >> 1) * 16) * B_PITCH) = wv; } } } \
        } \
        if (!(ODD)) { \
            const int T1 = (kt >> 1) + 1; const unsigned dst = lds0 + (unsigned)((((g0 >> 1) + T1) & 1) * A_SLOT + w * 1024); \
            if (T1 < NT / 2) { if (T1 >= 0) { _Pragma("unroll") for (int i = 0; i < NP; ++i) if (i < npieces) dma16(aoff[i], Abase + T1 * 128, dst + i * 4096); } } \
            else if (has_nxt) { \
                _Pragma("unroll") for (int i = 0; i < NP; ++i) { const int q_ = 4 * i + w, rt = 8 * (q_ & 1) + (lane >> 3); const unsigned cb = (unsigned)(((lane & 7) ^ ((rt >> 1) & 7)) * 16); \
                    if (FIRST) aoff[i] = *(const LAS unsigned*)(lds + TOK_OFF + q_ * 256 + lane * 4) * (unsigned)(ND * 2) + cb; \
                    else { const int mt = q_ >> 1; int lr = nxt.r0 + 16 * mt + rt; lr = lr < nxt.r1 ? lr : nxt.r1 - 1; aoff[i] = (unsigned)(nxt.ps + lr) * (unsigned)(DE * 2) + cb; } } \
                _Pragma("unroll") for (int i = 0; i < NP; ++i) if (i < npiecesN) dma16(aoff[i], Abase, dst + i * 4096); }        \
        } \
        { const int tb_ = kt + 10; const bool nx_ = (tb_ >= NT) && has_nxt;        \
          const int tile_ = nx_ ? tb_ - NT : (tb_ < 0 ? 0 : (tb_ < NT ? tb_ : NT - 1)); \
          const char* wb = (nx_ ? wbaseN : wbase) + (size_t)tile_ * (32 * 2048 * 4); const unsigned wo = nx_ ? woffN : woff; \
          _Pragma("unroll") for (int i = 0; i < 4; ++i) ldw16(breg[((SET) + 1) & 7][i], wo, wb + i * (8 * 2048 * 4)); } \
        ++kt; } while (0)
    for (;;) {
        if (has_nxt) { wbaseN = MOE_WBASE(nxt.e); woffN = wrow + (unsigned)MOE_GCOL(nxt.u) * 4u; npiecesN = (((nxt.r1 - nxt.r0 + 15) >> 4) * 2 - w + 3) >> 2; }
        if (FIRST) {
            const int qe = __builtin_amdgcn_readfirstlane(has_nxt ? nxt.e : cur.e), qr0 = __builtin_amdgcn_readfirstlane(has_nxt ? nxt.r0 : cur.r0), qr1 = __builtin_amdgcn_readfirstlane(has_nxt ? nxt.r1 : cur.r1);
            const char* lb = listb + (size_t)qe * ECAP * 4;
#pragma unroll
            for (int i = 0; i < NP; ++i) { const int q_ = 4 * i + w, mt = q_ >> 1, rt = 8 * (q_ & 1) + (lane >> 3); int lr = qr0 + 16 * mt + rt; lr = lr < qr1 ? lr : qr1 - 1;
                dma4((unsigned)lr * 4u, lb, lds0 + (unsigned)(TOK_OFF + q_ * 256)); }
        }
        int kt = kstart; asm volatile("" : "+s"(kt));
        for (; kt < NT;) { MOE_SL_ITER(0, 0); MOE_SL_ITER(1, 1); MOE_SL_ITER(2, 0); MOE_SL_ITER(3, 1); MOE_SL_ITER(4, 0); MOE_SL_ITER(5, 1); MOE_SL_ITER(6, 0); MOE_SL_ITER(7, 1); }
        if (!has_nxt) break;
        cur = nxt; wbase = wbaseN; woff = woffN; npieces = npiecesN; g0 += NT; kstart = 0;
        has_nxt = pass_next(it, tb, nxt);
    }
#undef MOE_SL_ITER
#undef MOE_GCOL
#undef MOE_WBASE
    asm volatile("s_waitcnt vmcnt(0)" : "+v"(breg[0][0]), "+v"(breg[0][1]), "+v"(breg[0][2]), "+v"(breg[0][3]), "+v"(breg[1][0]), "+v"(breg[1][1]), "+v"(breg[1][2]), "+v"(breg[1][3]),
                 "+v"(breg[2][0]), "+v"(breg[2][1]), "+v"(breg[2][2]), "+v"(breg[2][3]) :: "memory");
    asm volatile("" : "+v"(breg[3][0]), "+v"(breg[3][1]), "+v"(breg[3][2]), "+v"(breg[3][3]), "+v"(breg[4][0]), "+v"(breg[4][1]), "+v"(breg[4][2]), "+v"(breg[4][3]),
                 "+v"(breg[5][0]), "+v"(breg[5][1]), "+v"(breg[5][2]), "+v"(breg[5][3]) :: "memory");
    asm volatile("" : "+v"(breg[6][0]), "+v"(breg[6][1]), "+v"(breg[6][2]), "+v"(breg[6][3]), "+v"(breg[7][0]), "+v"(breg[7][1]), "+v"(breg[7][2]), "+v"(breg[7][3]) :: "memory");
}

template <bool FIRST, int NBC>
__device__ __forceinline__ void consumer_pass(LAS unsigned char* lds, const Params& p, const Pass& P, const int g0) {
    constexpr int K = FIRST ? 2048 : 1024, NT = K / 32;
    int tid_ = threadIdx.x; asm volatile("" : "+v"(tid_));
    const int tid = tid_, lane = tid & 63, w = __builtin_amdgcn_readfirstlane(tid >> 6), fr = lane & 15, fq = lane >> 4, c = w - 4;
    const int q = (lane & 15) >> 2, pp = lane & 3;
    const unsigned br0 = (unsigned)(rho(8 * fq + q) * B_PITCH + 8 * pp);
    const unsigned ar0 = (unsigned)(c * 2048 + fr * 128 + ((fq ^ ((fr >> 1) & 7)) << 4));
    f32x4 acc[NBC][8];
#pragma unroll
    for (int mi = 0; mi < NBC; ++mi)
#pragma unroll
        for (int j = 0; j < 8; ++j) acc[mi][j] = (f32x4){0.f, 0.f, 0.f, 0.f};
    int sl = g0 & 3;
    bf16x8 af[NBC]; v4i16_t pt0, pt1, pu0, pu1;
#define MOE_CS_ITER(KT, ODD) do {        \
        asm volatile("" : "+s"(sl));        \
        const int sn = (sl + 1) & 3; \
        const LAS unsigned char* as = lds + (((g0 + (KT)) >> 1) & 1) * A_SLOT + ((ODD) ? (ar0 ^ 64u) : ar0); const LAS unsigned char* bs = lds + B_OFF + sl * B_SLOT + br0; \
        if (!(ODD) || NBC > 6) { _Pragma("unroll") for (int mi = 0; mi < NBC; ++mi) af[mi] = *(const LAS bf16x8*)(as + mi * 8192); }        \
        v4i16_t t0 = pt0, t1 = pt1; const LAS unsigned char* bn = lds + B_OFF + sn * B_SLOT + br0; \
        _Pragma("unroll") for (int j = 0; j < 8; ++j) { \
            const bf16x8 wf = (bf16x8){t0[0], t0[1], t0[2], t0[3], t1[0], t1[1], t1[2], t1[3]}; \
            if (j == 0) { t0 = pu0; t1 = pu1; } \
            else if (j < 7) { t0 = __builtin_amdgcn_ds_read_tr16_b64_v4i16((LAS v4i16_t*)(bs + 32 * (j + 1))); t1 = __builtin_amdgcn_ds_read_tr16_b64_v4i16((LAS v4i16_t*)(bs + 32 * (j + 1) + 8 * B_PITCH)); } \
            if (j == 3) { pt0 = __builtin_amdgcn_ds_read_tr16_b64_v4i16((LAS v4i16_t*)(bn)); pt1 = __builtin_amdgcn_ds_read_tr16_b64_v4i16((LAS v4i16_t*)(bn + 8 * B_PITCH)); } \
            if (j == 5) { pu0 = __builtin_amdgcn_ds_read_tr16_b64_v4i16((LAS v4i16_t*)(bn + 32)); pu1 = __builtin_amdgcn_ds_read_tr16_b64_v4i16((LAS v4i16_t*)(bn + 32 + 8 * B_PITCH)); }        \
            __builtin_amdgcn_sched_barrier(0); \
            _Pragma("unroll") for (int mi = 0; mi < NBC; ++mi) acc[mi][j] = __builtin_amdgcn_mfma_f32_16x16x32_bf16(wf, af[mi], acc[mi][j], 0, 0, 0); \
            __builtin_amdgcn_sched_barrier(0); } \
        {        \
          if (!(ODD) && NBC <= 6) { const LAS unsigned char* an = lds + (((g0 + (KT)) >> 1) & 1) * A_SLOT + (ar0 ^ 64u); _Pragma("unroll") for (int mi = 0; mi < NBC; ++mi) af[mi] = *(const LAS bf16x8*)(an + mi * 8192); } } \
        sl = sn; \
        __builtin_amdgcn_sched_barrier(0); \
    } while (0)
    MOE_BAR();
    { const LAS unsigned char* b0_ = lds + B_OFF + sl * B_SLOT + br0; pt0 = __builtin_amdgcn_ds_read_tr16_b64_v4i16((LAS v4i16_t*)(b0_)); pt1 = __builtin_amdgcn_ds_read_tr16_b64_v4i16((LAS v4i16_t*)(b0_ + 8 * B_PITCH));
      pu0 = __builtin_amdgcn_ds_read_tr16_b64_v4i16((LAS v4i16_t*)(b0_ + 32)); pu1 = __builtin_amdgcn_ds_read_tr16_b64_v4i16((LAS v4i16_t*)(b0_ + 32 + 8 * B_PITCH)); }
    for (int kt = 0; kt < NT; kt += 2) { MOE_CS_ITER(kt, 0); MOE_BAR(); MOE_CS_ITER(kt + 1, 1); if (kt + 2 < NT) MOE_BAR(); }
#undef MOE_CS_ITER
#undef MOE_BAR
    const int e = P.e, u = P.u, ps = P.ps, r0 = P.r0, r1 = P.r1;
#pragma unroll
    for (int mi = 0; mi < NBC; ++mi) {
        const int lr = r0 + 16 * (4 * mi + c) + fr;
        if (lr < r1) {
            if (FIRST) {
                bf16_t* dst = (bf16_t*)(p.ws + WS_ACT) + (size_t)(ps + lr) * DE + 64 * u + 8 * fq;
#pragma unroll
                for (int t = 0; t < 2; ++t) { float o[8];
#pragma unroll
                    for (int jj = 0; jj < 2; ++jj)
#pragma unroll
                        for (int r = 0; r < 4; ++r) { const float g = acc[mi][2 * t + jj][r], up = acc[mi][4 + 2 * t + jj][r]; o[4 * jj + r] = g * pg8::sigm(g) * up; }
                    u32x4 wv; wv.x = pg8::cvt_pk_bf16(o[0], o[1]); wv.y = pg8::cvt_pk_bf16(o[2], o[3]); wv.z = pg8::cvt_pk_bf16(o[4], o[5]); wv.w = pg8::cvt_pk_bf16(o[6], o[7]);
                    *(u32x4*)(dst + 32 * t) = wv; }
            } else {
                const float rw = ((const float*)(p.ws + WS_SLW))[(size_t)e * ECAP + lr];
                bf16_t* dst = (bf16_t*)(p.ws + WS_Y) + (size_t)(ps + lr) * ND + 128 * u + 8 * fq;
#pragma unroll
                for (int t = 0; t < 4; ++t) { const f32x4 v0 = acc[mi][2 * t] * rw, v1 = acc[mi][2 * t + 1] * rw;
                    u32x4 wv; wv.x = pg8::cvt_pk_bf16(v0[0], v0[1]); wv.y = pg8::cvt_pk_bf16(v0[2], v0[3]); wv.z = pg8::cvt_pk_bf16(v1[0], v1[1]); wv.w = pg8::cvt_pk_bf16(v1[2], v1[3]);
                    *(u32x4*)(dst + 32 * t) = wv; }
            }
        }
    }
}
#undef MOE_WAITV
static_assert(B_OFF + 4 * B_SLOT <= TOK_OFF && TOK_OFF + 12288 <= 159744, "expert engine ring (four weight-image slots) vs LDS map");
}

#ifndef MOE_CONT
#define MOE_CONT 3
#endif
template <bool FIRST>
__device__ __forceinline__ void phase_moe_stream(const Params& p, LAS unsigned char* lds, int tid) {
    LAS int* tb = (LAS int*)(lds + TBL_OFF);
    expert_tables(p, tb, tid);
#if MOE_CONT
  if (MOE_CONT == 3 || (MOE_CONT == 1 && FIRST) || (MOE_CONT == 2 && !FIRST)) {
    if (__builtin_amdgcn_readfirstlane(tid >> 6) < 4) moe::stream_loader<FIRST>(lds, p, tb);
    else {
        constexpr int NT = (FIRST ? 2048 : 1024) / 32;
        moe::PassIt it{0, 0, 0, 0, 0, 0}; moe::Pass P; int g0 = 0;
        while (moe::pass_next(it, tb, P)) {
            const int n = P.r1 - P.r0;
            if (n > 320) moe::consumer_pass<FIRST, 6>(lds, p, P, g0);
            else if (n > 256) moe::consumer_pass<FIRST, 5>(lds, p, P, g0);
            else if (n > 192) moe::consumer_pass<FIRST, 4>(lds, p, P, g0);
            else if (n > 128) moe::consumer_pass<FIRST, 3>(lds, p, P, g0);
            else moe::consumer_pass<FIRST, 2>(lds, p, P, g0);
            g0 += NT;
        }
    }
    return;
  }
#endif
    const int G = gridDim.x;
    for (int i = 0;; ++i) {
        const int L = i * G + (int)blockIdx.x; if (L >= NE * 32) break;
        const int rr = L >> 3, e = (L & 7) + 8 * (rr >> 5), u = (rr >> 1) & 15, half = rr & 1;
        const int n_e = __builtin_amdgcn_readfirstlane(tb[e]), ps = __builtin_amdgcn_readfirstlane(tb[64 + e]);
        const int hr = (n_e + 1) >> 1, rb = half ? hr : 0, re = half ? n_e : hr;
        for (int r0 = rb; r0 < re; r0 += moe::UROWS) {
            const int r1 = (re - r0 > moe::UROWS) ? r0 + moe::UROWS : re, n = r1 - r0;
            if (n > 256) moe::unit_lc<FIRST, 6>(lds, p, e, u, ps, r0, r1);
            else if (n > 128) moe::unit_lc<FIRST, 4>(lds, p, e, u, ps, r0, r1);
            else moe::unit_lc<FIRST, 2>(lds, p, e, u, ps, r0, r1);
        }
    }
}

struct Mo1A { const bf16_t* H2; const int* list; int n_e, r0; __device__ __forceinline__ const bf16_t* operator()(int r, int k0) const { const int lr = r0 + r; if (lr >= n_e) return nullptr; return H2 + (size_t)list[lr] * ND + k0; } };
struct Mo1B { const bf16_t* W; int v0; __device__ __forceinline__ const bf16_t* operator()(int n, int k0) const { const int v = v0 + n, j = v >> 1, isu = v & 1; return W + (size_t)((j >> 7) * 256 + isu * 128 + (j & 127)) * ND + k0; } };
struct Mo1Epi { bf16_t* ACT; int prow0, v0;
    __device__ __forceinline__ void operator()(int r, int c, f32x4& v) const { const int j = (v0 + c) >> 1;
        const float a0 = v.x / (1.f + __expf(-v.x)) * v.y, a1 = v.z / (1.f + __expf(-v.z)) * v.w;
        *(unsigned*)(ACT + (size_t)(prow0 + r) * DE + j) = pk2(a0, a1); } };
__device__ __forceinline__ void phase_moe1_naive(const Params& p, LAS unsigned char* lds, const Ctx& cx) {
    LAS int* tb = (LAS int*)(lds + 32768);
    expert_tables(p, tb, cx.tid);
    const int ntile = tb[192 + NE] * 32;
    for (int t = blockIdx.x; t < ntile; t += gridDim.x) {
        const int ct = t & 31, rtg = t >> 5;
        int e = 0; while (tb[192 + e + 1] <= rtg) ++e;
        const int rt = rtg - tb[192 + e], n_e = tb[e], ps = tb[64 + e];
        Mo1A af{(const bf16_t*)(p.ws + WS_H), (const int*)(p.ws + WS_LIST) + (size_t)e * ECAP, n_e, rt * 64};
        Mo1B bf{(const bf16_t*)(p.ws + WS_WGUT) + (size_t)e * 2048 * ND, ct * 64};
        Mo1Epi ef{(bf16_t*)(p.ws + WS_ACT), ps + rt * 64, ct * 64};
        ngemm_tile(lds, ND, -1, af, bf, NoMid(), ef, cx.tid);
    }
}
struct Mo2A { const bf16_t* ACT; int prow0; __device__ __forceinline__ const bf16_t* operator()(int r, int k0) const { return ACT + (size_t)(prow0 + r) * DE + k0; } };
struct Mo2B { const bf16_t* W; int col0; __device__ __forceinline__ const bf16_t* operator()(int n, int k0) const { return W + (size_t)(col0 + n) * DE + k0; } };
struct Mo2Epi { bf16_t* Y; const float* slw; int prow0, r0, n_e, col0;
    __device__ __forceinline__ void operator()(int r, int c, f32x4& v) const { const int lr = r0 + r; if (lr >= n_e) return; const float w = slw[lr];
        u32x2 o; o.x = pk2(v.x * w, v.y * w); o.y = pk2(v.z * w, v.w * w); *(u32x2*)(Y + (size_t)(prow0 + lr) * ND + col0 + c) = o; } };
__device__ __forceinline__ void phase_moe2_naive(const Params& p, LAS unsigned char* lds, const Ctx& cx) {
    LAS int* tb = (LAS int*)(lds + 32768);
    expert_tables(p, tb, cx.tid);
    const int ntile = tb[192 + NE] * 32;
    for (int t = blockIdx.x; t < ntile; t += gridDim.x) {
        const int ct = t & 31, rtg = t >> 5;
        int e = 0; while (tb[192 + e + 1] <= rtg) ++e;
        const int rt = rtg - tb[192 + e], n_e = tb[e], ps = tb[64 + e];
        Mo2A af{(const bf16_t*)(p.ws + WS_ACT), ps + rt * 64};
        Mo2B bf{(const bf16_t*)(p.ws + WS_WDNT) + (size_t)e * ND * DE, ct * 64};
        Mo2Epi ef{(bf16_t*)(p.ws + WS_Y), (const float*)(p.ws + WS_SLW) + (size_t)e * ECAP, ps, rt * 64, n_e, ct * 64};
        ngemm_tile(lds, DE, -1, af, bf, NoMid(), ef, cx.tid);
    }
}

__device__ __forceinline__ void phase_final(const Params& p, LAS unsigned char* lds, const Ctx& cx) {
    LAS int* tb = (LAS int*)(lds + 32768);
    expert_tables(p, tb, cx.tid);
    const float* xmid = (const float*)(p.ws + WS_XMID); const float* mod = (const float*)(p.ws + WS_MOD);
    const int* toke = (const int*)(p.ws + WS_TOKE); const int* tokr = (const int*)(p.ws + WS_TOKR); const bf16_t* Y = (const bf16_t*)(p.ws + WS_Y);
    f32x4 gfin[8];
#pragma unroll
    for (int j = 0; j < 8; ++j) gfin[j] = *(const f32x4*)(p.g_final + 4 * cx.lane + 256 * j);
    for (int row = cx.gw; row + cx.ngw < NM + cx.ngw; row += 2 * cx.ngw) {
        const int rowa = row, rowb = (row + cx.ngw < NM) ? row + cx.ngw : row; const bool hasb = row + cx.ngw < NM;
        const int ba = rowa / NS, bb = rowb / NS;
        const int sa0 = tb[64 + toke[rowa * 2]] + tokr[rowa * 2], sa1 = tb[64 + toke[rowa * 2 + 1]] + tokr[rowa * 2 + 1];
        const int sb0 = tb[64 + toke[rowb * 2]] + tokr[rowb * 2], sb1 = tb[64 + toke[rowb * 2 + 1]] + tokr[rowb * 2 + 1];
        const f32x4* xa = (const f32x4*)(xmid + (size_t)rowa * ND) + cx.lane; const f32x4* xb = (const f32x4*)(xmid + (size_t)rowb * ND) + cx.lane;
        const u32x2* ya0 = (const u32x2*)(Y + (size_t)sa0 * ND) + cx.lane; const u32x2* ya1 = (const u32x2*)(Y + (size_t)sa1 * ND) + cx.lane;
        const u32x2* yb0 = (const u32x2*)(Y + (size_t)sb0 * ND) + cx.lane; const u32x2* yb1 = (const u32x2*)(Y + (size_t)sb1 * ND) + cx.lane;
        f32x4 va[8], vb[8]; float ssa = 0.f, ssb = 0.f;
#pragma unroll
        for (int j = 0; j < 8; ++j) {
            const int col = 4 * cx.lane + 256 * j;
            const f32x4 gta = *(const f32x4*)(mod + (size_t)ba * 12288 + 10240 + col), gtb = *(const f32x4*)(mod + (size_t)bb * 12288 + 10240 + col);
            const u32x2 a0 = __builtin_nontemporal_load(ya0 + 64 * j), a1 = __builtin_nontemporal_load(ya1 + 64 * j), b0 = __builtin_nontemporal_load(yb0 + 64 * j), b1 = __builtin_nontemporal_load(yb1 + 64 * j);
            f32x4 fa, fb;
            fa.x = bf2f(a0.x & 0xffffu) + bf2f(a1.x & 0xffffu); fa.y = bf2f(a0.x >> 16) + bf2f(a1.x >> 16); fa.z = bf2f(a0.y & 0xffffu) + bf2f(a1.y & 0xffffu); fa.w = bf2f(a0.y >> 16) + bf2f(a1.y >> 16);
            fb.x = bf2f(b0.x & 0xffffu) + bf2f(b1.x & 0xffffu); fb.y = bf2f(b0.x >> 16) + bf2f(b1.x >> 16); fb.z = bf2f(b0.y & 0xffffu) + bf2f(b1.y & 0xffffu); fb.w = bf2f(b0.y >> 16) + bf2f(b1.y >> 16);
            va[j] = __builtin_nontemporal_load(xa + 64 * j) + gta * fa; vb[j] = __builtin_nontemporal_load(xb + 64 * j) + gtb * fb;
            ssa += (va[j].x * va[j].x + va[j].y * va[j].y) + (va[j].z * va[j].z + va[j].w * va[j].w);
            ssb += (vb[j].x * vb[j].x + vb[j].y * vb[j].y) + (vb[j].z * vb[j].z + vb[j].w * vb[j].w);
        }
        const float ra = 1.f / sqrtf(wave_sum(ssa) * (1.f / ND) + RMS_EPS), rbv = 1.f / sqrtf(wave_sum(ssb) * (1.f / ND) + RMS_EPS);
        f32x4* oa = (f32x4*)(p.out + (size_t)rowa * ND) + cx.lane; f32x4* ob = (f32x4*)(p.out + (size_t)rowb * ND) + cx.lane;
#pragma unroll
        for (int j = 0; j < 8; ++j) __builtin_nontemporal_store(va[j] * ra * gfin[j], oa + 64 * j);
        if (hasb) {
#pragma unroll
            for (int j = 0; j < 8; ++j) __builtin_nontemporal_store(vb[j] * rbv * gfin[j], ob + 64 * j);
        }
    }
}

#ifndef FAST_ATTN
#define FAST_ATTN 1
#endif
#ifndef FAST_ROUTER
#define FAST_ROUTER 1
#endif
#ifndef FAST_INPROJ
#define FAST_INPROJ 1
#endif
#ifndef FAST_BRANCH
#define FAST_BRANCH 1
#endif
#ifndef FAST_OUT
#define FAST_OUT 1
#endif
#ifndef FAST_MOE1
#define FAST_MOE1 1
#endif
#ifndef FAST_MOE2
#define FAST_MOE2 1
#endif
__global__ void __launch_bounds__(NTHR, 2) fwd(Params p) {
    extern __shared__ __attribute__((aligned(16))) unsigned char lds_raw[];
    LAS unsigned char* lds = (LAS unsigned char*)lds_raw;
    volatile LAS unsigned* MISC = (volatile LAS unsigned*)(lds + MISC_OFF);
    if (threadIdx.x < 32) MISC[threadIdx.x] = 0u;
    __syncthreads();
    XcdBarrier bar = xcd_barrier_post((unsigned*)(p.ws + WS_CTL) + CW_BAR, MISC + 8);

#ifndef REP_MASK
#define REP_MASK 0
#endif
#define REPS(k) (((REP_MASK >> (k)) & 1) ? 2 : 1)
    for (int rep = 0; rep < REPS(0); ++rep) { phase_prologue(p, lds, make_ctx());        xcd_barrier(bar); }
    for (int rep = 0; rep < REPS(1); ++rep) { phase_h(p, lds, make_ctx());               xcd_barrier(bar); }
    for (int rep = 0; rep < REPS(2); ++rep) {
#if FAST_INPROJ
    phase_inproj_fast(p, lds);         xcd_barrier(bar);
#else
    phase_inproj_naive(p, lds, make_ctx());    xcd_barrier(bar);
#endif
    }
    for (int rep = 0; rep < REPS(3); ++rep) {
#if FAST_ATTN
    phase_attn_fast(p, (char*)lds_raw);        xcd_barrier(bar);
#else
    phase_swa_naive(p, make_ctx());
    phase_diff_naive(p, make_ctx());           xcd_barrier(bar);
#endif
    }
    for (int rep = 0; rep < REPS(4); ++rep) {
#if FAST_BRANCH
    phase_branch_fast(p, lds);         xcd_barrier(bar);
#else
    phase_branch_naive(p, lds, make_ctx());    xcd_barrier(bar);
#endif
    }
    for (int rep = 0; rep < REPS(5); ++rep) {
#if FAST_OUT
    phase_out_fast(p, lds);            xcd_barrier(bar);
#else
    phase_out_naive(p, lds, make_ctx());       xcd_barrier(bar);
#endif
    }
#if FAST_ROUTER
    phase_router_fast(p, lds, make_ctx());     xcd_barrier(bar);
#else
    phase_router(p, lds, make_ctx());          xcd_barrier(bar);
#endif
    for (int rep = 0; rep < REPS(7); ++rep) {
#if MOE_STREAM
    phase_moe_stream<true>(p, lds, threadIdx.x);   xcd_barrier(bar);
#elif FAST_MOE1
    phase_moe1_fast(p, lds, make_ctx());       xcd_barrier(bar);
#else
    phase_moe1_naive(p, lds, make_ctx());      xcd_barrier(bar);
#endif
    }
    for (int rep = 0; rep < REPS(8); ++rep) {
#if MOE_STREAM
    phase_moe_stream<false>(p, lds, threadIdx.x);  xcd_barrier(bar);
#elif FAST_MOE2
    phase_moe2_fast(p, lds, make_ctx());       xcd_barrier(bar);
#else
    phase_moe2_naive(p, lds, make_ctx());      xcd_barrier(bar);
#endif
    }
    for (int rep = 0; rep < REPS(9); ++rep) { if (rep) xcd_barrier(bar); phase_final(p, lds, make_ctx()); }
}

extern "C" void kernel_launch(void* const* d_in, const int* in_sizes, int n_in, void* d_out, int out_size, void* d_ws, size_t ws_size, hipStream_t stream) {
    static int grid = 0;
    if (grid == 0) {
        if (n_in != 24 || in_sizes[0] != NM * ND || out_size != NM * ND || ws_size < WS_END) { fprintf(stderr, "kernel_launch: unexpected shapes (n_in %d, in0 %d, out %d, ws %zu)\n", n_in, n_in > 0 ? in_sizes[0] : -1, out_size, ws_size); grid = -1; return; }
        int dev = 0, cus = 0, per_cu = 0;
        if (hipGetDevice(&dev) != hipSuccess || hipDeviceGetAttribute(&cus, hipDeviceAttributeMultiprocessorCount, dev) != hipSuccess) { grid = -1; return; }
        if (hipFuncSetAttribute((const void*)fwd, hipFuncAttributeMaxDynamicSharedMemorySize, LDS_BYTES) != hipSuccess) { fprintf(stderr, "kernel_launch: hipFuncSetAttribute failed\n"); grid = -1; return; }
        if (hipOccupancyMaxActiveBlocksPerMultiprocessor(&per_cu, (const void*)fwd, NTHR, LDS_BYTES) != hipSuccess || per_cu < 1) fprintf(stderr, "kernel_launch: occupancy query says %d\n", per_cu);
        (void)hipGetLastError();
        grid = cus;
    }
    if (grid < 0) return;
    (void)hipMemsetAsync((char*)d_ws + WS_CTL, 0, CTL_ZERO_BYTES, stream);
    Params p{};
    p.x = (const float*)d_in[0]; p.c = (const float*)d_in[1]; p.pos = (const int*)d_in[2]; p.w_ada = (const float*)d_in[3]; p.b_ada = (const float*)d_in[4];
    p.g_mix = (const float*)d_in[5]; p.w_in = (const float*)d_in[6]; p.sinks = (const float*)d_in[7]; p.lq1 = (const float*)d_in[8]; p.lk1 = (const float*)d_in[9];
    p.lq2 = (const float*)d_in[10]; p.lk2 = (const float*)d_in[11]; p.subln = (const float*)d_in[12]; p.w_a = (const float*)d_in[13]; p.w_b = (const float*)d_in[14];
    p.w_out = (const float*)d_in[15]; p.g_ffn = (const float*)d_in[16]; p.w_rg = (const float*)d_in[17]; p.b_rg = (const float*)d_in[18]; p.w_re = (const float*)d_in[19];
    p.b_re = (const float*)d_in[20]; p.w_gu = (const float*)d_in[21]; p.w_dn = (const float*)d_in[22]; p.g_final = (const float*)d_in[23];
    p.out = (float*)d_out; p.ws = (unsigned char*)d_ws;
    hipLaunchKernelGGL(fwd, dim3(grid), dim3(NTHR), LDS_BYTES, stream, p);
}
```

```cpp
#include <hip/hip_runtime.h>
#include <cstdio>
#include <cstdint>

#ifndef LATE_COPIES
#define LATE_COPIES 1
#endif
#ifndef DIFF128
#define DIFF128 1
#endif
#ifndef MOE_STREAM
#define MOE_STREAM 1
#endif
#define LAS __attribute__((address_space(3)))
#define GAS __attribute__((address_space(1)))
typedef unsigned short bf16_t;
typedef float f32x4 __attribute__((ext_vector_type(4)));
typedef float f32x2 __attribute__((ext_vector_type(2)));
typedef unsigned u32x4 __attribute__((ext_vector_type(4)));
typedef unsigned u32x2 __attribute__((ext_vector_type(2)));

constexpr int NB = 8, NS = 2048, ND = 2048, NM = NB * NS;
constexpr int IN_COLS = 8448;
constexpr int C_KA = 1024, C_VA = 1152, C_QD = 1280, C_KD = 2304, C_VD = 3328, C_GA = 4352;
constexpr int NE = 64, DE = 1024;
constexpr int ECAP = 16384;
constexpr int PADR = 256;
constexpr int PMAX = 49152;
constexpr int KS_ADA = 32, KCH_ADA = ND / KS_ADA;
constexpr float RMS_EPS = 1e-6f;
constexpr float LOG2E = 1.4426950408889634f;
constexpr float C2 = 0.125f * LOG2E;
constexpr int NTHR = 512, NWAVES = 8;

constexpr size_t MiB = 1u << 20;
constexpr size_t WS_CTL = 0, CTL_ZERO_BYTES = 1 * MiB;
constexpr size_t WS_MOD = 1 * MiB;
constexpr size_t WS_MODP = 2 * MiB;
constexpr size_t WS_COS = 16 * MiB, WS_SIN = 18 * MiB;
constexpr size_t WS_TOKE = 20 * MiB;
constexpr size_t WS_TOKR = 21 * MiB;
constexpr size_t WS_LIST = 22 * MiB;
constexpr size_t WS_SLW = 26 * MiB;
constexpr size_t WS_WRT = 30 * MiB;
constexpr size_t WS_SSQ = 14 * MiB;
constexpr size_t WS_WINT = 32 * MiB;
constexpr size_t WS_WAT = 66 * MiB;
constexpr size_t WS_WBT = 70 * MiB;
constexpr size_t WS_WOUTT = 74 * MiB;
constexpr size_t WS_H = 96 * MiB;
constexpr size_t WS_QA = 160 * MiB;
constexpr size_t WS_KA = 192 * MiB;
constexpr size_t WS_VA = 196 * MiB;
constexpr size_t WS_QD = 200 * MiB, WS_KD = 232 * MiB, WS_VD = 264 * MiB;
constexpr size_t WS_G = 296 * MiB;
constexpr size_t WS_TMP = 424 * MiB;
constexpr size_t WS_OA = 488 * MiB, WS_OB = 520 * MiB;
constexpr size_t WS_MERGED = 552 * MiB;
constexpr size_t WS_XMID = 616 * MiB;
constexpr size_t WS_ACT = 744 * MiB;
constexpr size_t WS_Y = 840 * MiB;
constexpr size_t WS_WGUT = 1032 * MiB;
constexpr size_t WS_WDNT = 1544 * MiB;
constexpr size_t WS_END = 1800 * MiB;
constexpr int CW_CNT = 1024;
constexpr int CW_BAR = 4096;

constexpr int LDS_BYTES = 163840;
constexpr int MISC_OFF = 159744 + 64;

__device__ __forceinline__ float bf2f(unsigned v) { return __uint_as_float(v << 16); }
__device__ __forceinline__ unsigned f2bf(float f) { unsigned u = __float_as_uint(f); return (u + 0x7fffu + ((u >> 16) & 1u)) >> 16; }
__device__ __forceinline__ unsigned pk2(float lo, float hi) { return f2bf(lo) | (f2bf(hi) << 16); }
__device__ __forceinline__ float wave_sum(float v) {
#pragma unroll
    for (int o = 1; o < 64; o <<= 1) v += __shfl_xor(v, o);
    return v;
}
#define LDS_WAIT() asm volatile("s_waitcnt lgkmcnt(0)" ::: "memory")

__device__ const float INVF[32] = {
    1.000000000e+00f, 7.498942614e-01f, 5.623413324e-01f, 4.216965139e-01f, 3.162277639e-01f, 2.371373773e-01f, 1.778279394e-01f, 1.333521307e-01f,
    1.000000015e-01f, 7.498941571e-02f, 5.623413250e-02f, 4.216965288e-02f, 3.162277490e-02f, 2.371373773e-02f, 1.778279431e-02f, 1.333521493e-02f,
    9.999999776e-03f, 7.498941850e-03f, 5.623413250e-03f, 4.216964822e-03f, 3.162277630e-03f, 2.371373586e-03f, 1.778279431e-03f, 1.333521446e-03f,
    1.000000047e-03f, 7.498942432e-04f, 5.623413017e-04f, 4.216965172e-04f, 3.162277571e-04f, 2.371373703e-04f, 1.778279402e-04f, 1.333521504e-04f};

__device__ __forceinline__ void sincos_d(double a, double& s, double& c) {
    const double n = __builtin_rint(a * 0.63661977236758134308);
    double r = __builtin_fma(-n, 1.5707963267948966, a);
    r = __builtin_fma(-n, 6.123233995736766e-17, r);
    const double r2 = r * r;
    double ps = -1.0 / 1307674368000.0;
    ps = ps * r2 + 1.0 / 6227020800.0; ps = ps * r2 - 1.0 / 39916800.0; ps = ps * r2 + 1.0 / 362880.0; ps = ps * r2 - 1.0 / 5040.0; ps = ps * r2 + 1.0 / 120.0; ps = ps * r2 - 1.0 / 6.0;
    const double sr = r + r * r2 * ps;
    double pc = 1.0 / 87178291200.0;
    pc = pc * r2 - 1.0 / 479001600.0; pc = pc * r2 + 1.0 / 3628800.0; pc = pc * r2 - 1.0 / 40320.0; pc = pc * r2 + 1.0 / 720.0; pc = pc * r2 - 1.0 / 24.0; pc = pc * r2 + 0.5;
    const double cr = 1.0 - r2 * pc;
    const int q = ((int)n) & 3;
    s = (q == 0) ? sr : (q == 1) ? cr : (q == 2) ? -sr : -cr;
    c = (q == 0) ? cr : (q == 1) ? -sr : (q == 2) ? -cr : sr;
}

#define XB_TMO      128
#define XB_XCNT(j)  (256  + 64 * (j))
#define XB_XSUB(j)  (1280 + 64 * (j))
#define XB_XGEN(j)  (2304 + 64 * (j))
#define XB_TOP      3328
#define XB_TOPGEN   3392
#define XCD_BAR_WORDS 3456
#define XB_SPIN_CAP (1u << 18)

__device__ __forceinline__ unsigned xb_ld(unsigned* p)              { return __hip_atomic_load(p, __ATOMIC_RELAXED, __HIP_MEMORY_SCOPE_AGENT); }
__device__ __forceinline__ unsigned xb_add(unsigned* p, unsigned v) { return __hip_atomic_fetch_add(p, v, __ATOMIC_RELAXED, __HIP_MEMORY_SCOPE_AGENT); }
__device__ __forceinline__ unsigned xb_xcc_id() { return (unsigned)__builtin_amdgcn_s_getreg((3 << 11) | 20) & 0xFu; }
#define XB_SPIN(cond, bar) do { unsigned _sp = 0; while (cond) { __builtin_amdgcn_s_sleep(1); \
    if ((++_sp & 255u) == 0u) { if (xb_ld(&(bar)[XB_TMO])) break; if (_sp > XB_SPIN_CAP) { atomicAdd(&(bar)[XB_TMO], 1u); break; } } } } while (0)

struct XcdBarrier {
    unsigned* bar; unsigned x;
    volatile LAS unsigned* st;
};
__device__ __forceinline__ XcdBarrier xcd_barrier_post(unsigned* bar, volatile LAS unsigned* st) {
    XcdBarrier b; b.bar = bar; b.x = xb_xcc_id(); b.st = st;
    if (threadIdx.x == 0) (void)xb_add(&bar[XB_XCNT(b.x)], 1u);
    return b;
}
__device__ __forceinline__ void xcd_barrier_complete(unsigned* bar, unsigned x, unsigned& nloc, unsigned& nx) {
    const unsigned G = gridDim.x * gridDim.y * gridDim.z;
    unsigned sum, cnt, mine, sp = 0u;
    for (;;) {
        sum = 0u; cnt = 0u; mine = 0u;
#pragma unroll
        for (unsigned j = 0; j < 16; ++j) { const unsigned c = xb_ld(&bar[XB_XCNT(j)]); sum += c; cnt += (c > 0u) ? 1u : 0u; mine = (j == x) ? c : mine; }
        if (sum == G) break;
        __builtin_amdgcn_s_sleep(1);
        if ((++sp & 255u) == 0u) { if (xb_ld(&bar[XB_TMO])) break; if (sp > XB_SPIN_CAP) { atomicAdd(&bar[XB_TMO], 1u); break; } }
    }
    nloc = mine > 0u ? mine : 1u; nx = cnt > 0u ? cnt : 1u;
}
__device__ __forceinline__ void xcd_barrier(const XcdBarrier& b) {
    asm volatile("s_waitcnt vmcnt(0)" ::: "memory");
    __syncthreads();
    if (threadIdx.x == 0) {
        unsigned* bar = b.bar;
        __builtin_amdgcn_s_waitcnt(0);
        unsigned nloc = b.st[0], nx = b.st[1];
        if (nloc == 0u) { xcd_barrier_complete(bar, b.x, nloc, nx); b.st[0] = nloc; b.st[1] = nx; }
        const unsigned old = xb_add(&bar[XB_XSUB(b.x)], 1u);
        const unsigned gen = old / nloc;
        if (old + 1u == (gen + 1u) * nloc) {
            __builtin_amdgcn_fence(__ATOMIC_RELEASE, "agent");
            asm volatile("s_waitcnt vmcnt(0)" ::: "memory");
            const unsigned og = xb_add(&bar[XB_TOP], 1u);
            const unsigned tg = og / nx;
            if (og + 1u == (tg + 1u) * nx) xb_add(&bar[XB_TOPGEN], 1u);
            else XB_SPIN(xb_ld(&bar[XB_TOPGEN]) == tg, bar);
            __builtin_amdgcn_fence(__ATOMIC_ACQUIRE, "agent");
            xb_add(&bar[XB_XGEN(b.x)], 1u);
            asm volatile("s_waitcnt vmcnt(0)" ::: "memory");
        } else {
            XB_SPIN(xb_ld(&bar[XB_XGEN(b.x)]) == gen, bar);
            __builtin_amdgcn_fence(__ATOMIC_ACQUIRE, "agent");
            asm volatile("s_waitcnt vmcnt(0)" ::: "memory");
        }
    }
    __syncthreads();
}

struct Params {
    const float* x; const float* c; const int* pos; const float* w_ada; const float* b_ada; const float* g_mix; const float* w_in;
    const float* sinks; const float* lq1; const float* lk1; const float* lq2; const float* lk2; const float* subln;
    const float* w_a; const float* w_b; const float* w_out; const float* g_ffn; const float* w_rg; const float* b_rg;
    const float* w_re; const float* b_re; const float* w_gu; const float* w_dn; const float* g_final;
    float* out; unsigned char* ws;
};

struct Ctx { int tid, lane, wave, gw, ngw, gtid, ngt; };
__device__ __forceinline__ Ctx make_ctx() {
    Ctx cx; int t = threadIdx.x; asm volatile("" : "+v"(t));
    cx.tid = t; cx.lane = t & 63; cx.wave = __builtin_amdgcn_readfirstlane(t >> 6);
    cx.gw = blockIdx.x * NWAVES + cx.wave; cx.ngw = gridDim.x * NWAVES; cx.gtid = blockIdx.x * NTHR + t; cx.ngt = gridDim.x * NTHR;
    return cx;
}

template <int MODE> __device__ __forceinline__ int dest_row(int n) {
    if (MODE == 1) {
        const bool rope = (n < C_VA) || (n >= C_QD && n < C_VD);
        if (!rope) return n;
        const int hb = n & ~63, d = n & 63;
        return hb + ((d < 32) ? 2 * d : 2 * (d - 32) + 1);
    }
    if (MODE == 2) {
        const int j = n & 1023, isu = n >> 10;
        return (j >> 7) * 256 + isu * 128 + (j & 127);
    }
    return n;
}
template <int MODE>
__device__ __forceinline__ void transpose_item(const float* W, int K, int N, bf16_t* WT, LAS float* scr, int item, int lane) {
    const int nblk = N / 32, kb = item / nblk, nb = item % nblk, k0 = 64 * kb, n0 = 32 * nb;
    {
        f32x4 v[8];
#pragma unroll
        for (int i = 0; i < 8; ++i) v[i] = *(const f32x4*)(W + (size_t)(k0 + 8 * i + (lane >> 3)) * N + n0 + 4 * (lane & 7));
        __builtin_amdgcn_sched_barrier(0);
#pragma unroll
        for (int i = 0; i < 8; ++i) { LAS float* d = scr + (8 * i + (lane >> 3)) * 33 + 4 * (lane & 7); d[0] = v[i].x; d[1] = v[i].y; d[2] = v[i].z; d[3] = v[i].w; }
    }
    LDS_WAIT(); asm volatile("" ::: "memory");
    const int c = lane & 7;
#pragma unroll
    for (int j = 0; j < 4; ++j) { const int n = (lane >> 3) + 8 * j; const LAS float* s = scr + (8 * c) * 33 + n;
        u32x4 o; o.x = pk2(s[0 * 33], s[1 * 33]); o.y = pk2(s[2 * 33], s[3 * 33]); o.z = pk2(s[4 * 33], s[5 * 33]); o.w = pk2(s[6 * 33], s[7 * 33]);
        *(u32x4*)(WT + (size_t)dest_row<MODE>(n0 + n) * K + k0 + 8 * c) = o; }
    LDS_WAIT(); asm volatile("" ::: "memory");
}

__device__ __forceinline__ void phase_prologue(const Params& p, LAS unsigned char* lds, const Ctx& cx) {
    unsigned char* ws = p.ws;
    LAS float* cact = (LAS float*)lds;
    for (int i = cx.tid; i < NB * ND; i += NTHR) { const float v = p.c[i]; cact[i] = v / (1.f + __expf(-v)); }
    __syncthreads();
    {
        float* mod = (float*)(ws + WS_MOD);
        LAS float* part = (LAS float*)(lds + 65536);
        for (int cb = blockIdx.x; cb < 12288 / 48; cb += gridDim.x) {
            const int cq = cx.lane % 12, kr = cx.lane / 12;
            f32x4 acc[8];
#pragma unroll
            for (int b = 0; b < 8; ++b) acc[b] = (f32x4){0.f, 0.f, 0.f, 0.f};
            if (kr < 5) {
                const float* wp = p.w_ada + 48 * cb + 4 * cq;
#pragma unroll 13
                for (int i = 0; i < 52; ++i) {
                    const int kl = 5 * i + kr;
                    if (kl < 256) {
                        const int k = cx.wave * 256 + kl;
                        const f32x4 wv = *(const f32x4*)(wp + (size_t)k * 12288);
#pragma unroll
                        for (int b = 0; b < 8; ++b) acc[b] += cact[b * ND + k] * wv;
                    }
                }
#pragma unroll
                for (int b = 0; b < 8; ++b) *(LAS f32x4*)(part + ((cx.wave * 5 + kr) * 8 + b) * 48 + 4 * cq) = acc[b];
            }
            __syncthreads();
            if (cx.tid < 384) {
                const int b = cx.tid / 48, j = cx.tid % 48;
                float s = p.b_ada[48 * cb + j];
                for (int q = 0; q < 40; ++q) s += part[(q * 8 + b) * 48 + j];
                mod[(size_t)b * 12288 + 48 * cb + j] = s;
            }
            __syncthreads();
        }
    }
    __syncthreads();
    LAS float* scr = (LAS float*)(lds + cx.wave * 8448);
    constexpr int I_IN = (ND / 64) * (IN_COLS / 32), I_AB = (1024 / 64) * (ND / 32), I_OUT = (ND / 64) * (ND / 32), I_GU = (ND / 64) * (2048 / 32), I_DN = (DE / 64) * (ND / 32);
#if LATE_COPIES
    for (int it = cx.gw; it < I_IN; it += cx.ngw) transpose_item<1>(p.w_in, ND, IN_COLS, (bf16_t*)(ws + WS_WINT), scr, it, cx.lane);
#else
    constexpr int NITEMS = MOE_STREAM ? (I_IN + 2 * I_AB + I_OUT) : (I_IN + 2 * I_AB + I_OUT + NE * I_GU + NE * I_DN);
    for (int it = cx.gw; it < NITEMS; it += cx.ngw) {
        int r = it;
        if (r < I_IN) { transpose_item<1>(p.w_in, ND, IN_COLS, (bf16_t*)(ws + WS_WINT), scr, r, cx.lane); continue; } r -= I_IN;
        if (r < I_AB) { transpose_item<0>(p.w_a, 1024, ND, (bf16_t*)(ws + WS_WAT), scr, r, cx.lane); continue; } r -= I_AB;
        if (r < I_AB) { transpose_item<0>(p.w_b, 1024, ND, (bf16_t*)(ws + WS_WBT), scr, r, cx.lane); continue; } r -= I_AB;
        if (r < I_OUT) { transpose_item<0>(p.w_out, ND, ND, (bf16_t*)(ws + WS_WOUTT), scr, r, cx.lane); continue; } r -= I_OUT;
#if !MOE_STREAM
        if (r < NE * I_GU) { const int e = r / I_GU; transpose_item<2>(p.w_gu + (size_t)e * ND * 2048, ND, 2048, (bf16_t*)(ws + WS_WGUT) + (size_t)e * 2048 * ND, scr, r % I_GU, cx.lane); continue; } r -= NE * I_GU;
        { const int e = r / I_DN; transpose_item<0>(p.w_dn + (size_t)e * DE * ND, DE, ND, (bf16_t*)(ws + WS_WDNT) + (size_t)e * ND * DE, scr, r % I_DN, cx.lane); }
#endif
    }
    { float* wrt = (float*)(ws + WS_WRT);
      for (int i = cx.gtid; i < 80 * ND; i += cx.ngt) { const int j = i >> 11, k = i & (ND - 1); wrt[i] = (j < 64) ? p.w_re[(size_t)k * 64 + j] : (j < 72) ? p.w_rg[(size_t)k * 8 + (j - 64)] : 0.f; } }
#endif
    float* cosT = (float*)(ws + WS_COS); float* sinT = (float*)(ws + WS_SIN);
    for (int i = cx.gtid; i < NM * 32; i += cx.ngt) {
        const int row = i >> 5, fi = i & 31;
        const float ang = (float)p.pos[row] * INVF[fi];
        double s, c; sincos_d((double)ang, s, c);
        cosT[i] = (float)c; sinT[i] = (float)s;
    }
}

__device__ __forceinline__ void late_weight_copies(const Params& p, LAS unsigned char* lds, const Ctx& cx, int first, int nhelp) {
    unsigned char* ws = p.ws;
    LAS float* scr = (LAS float*)(lds + cx.wave * 8448);
    constexpr int I_AB = (1024 / 64) * (ND / 32), I_OUT = (ND / 64) * (ND / 32);
    const int hw = ((int)blockIdx.x - first) * NWAVES + cx.wave, nhw = nhelp * NWAVES;
    for (int it = hw; it < 2 * I_AB + I_OUT; it += nhw) {
        int r = it;
        if (r < I_AB) { transpose_item<0>(p.w_a, 1024, ND, (bf16_t*)(ws + WS_WAT), scr, r, cx.lane); continue; } r -= I_AB;
        if (r < I_AB) { transpose_item<0>(p.w_b, 1024, ND, (bf16_t*)(ws + WS_WBT), scr, r, cx.lane); continue; } r -= I_AB;
        transpose_item<0>(p.w_out, ND, ND, (bf16_t*)(ws + WS_WOUTT), scr, r, cx.lane);
    }
    float* wrt = (float*)(ws + WS_WRT);
    for (int i = ((int)blockIdx.x - first) * NTHR + cx.tid; i < 80 * ND; i += nhelp * NTHR) { const int j = i >> 11, k = i & (ND - 1); wrt[i] = (j < 64) ? p.w_re[(size_t)k * 64 + j] : (j < 72) ? p.w_rg[(size_t)k * 8 + (j - 64)] : 0.f; }
}

__device__ __forceinline__ void phase_h(const Params& p, LAS unsigned char* lds, const Ctx& cx) {
    const float* mod = (const float*)(p.ws + WS_MOD);
    LAS float* shsc = (LAS float*)lds;
    bf16_t* H = (bf16_t*)(p.ws + WS_H);
    f32x4 gmix[8];
#pragma unroll
    for (int j = 0; j < 8; ++j) gmix[j] = *(const f32x4*)(p.g_mix + 4 * cx.lane + 256 * j);
    for (int rb = blockIdx.x; rb < NM / 64; rb += gridDim.x) {
        const int b = rb / (NS / 64);
        __syncthreads();
        for (int j = cx.tid; j < 4096; j += NTHR) shsc[j] = mod[(size_t)b * 12288 + j];
        __syncthreads();
        for (int rr = cx.wave; rr < 64; rr += 2 * NWAVES) {
            const int rowa = rb * 64 + rr, rowb = rowa + NWAVES;
            const f32x4* xa = (const f32x4*)(p.x + (size_t)rowa * ND) + cx.lane; const f32x4* xb = (const f32x4*)(p.x + (size_t)rowb * ND) + cx.lane;
            f32x4 va[8], vb[8]; float sa = 0.f, sb = 0.f;
#pragma unroll
            for (int j = 0; j < 8; ++j) { va[j] = __builtin_nontemporal_load(xa + 64 * j); vb[j] = __builtin_nontemporal_load(xb + 64 * j); }
#pragma unroll
            for (int j = 0; j < 8; ++j) { sa += (va[j].x * va[j].x + va[j].y * va[j].y) + (va[j].z * va[j].z + va[j].w * va[j].w); sb += (vb[j].x * vb[j].x + vb[j].y * vb[j].y) + (vb[j].z * vb[j].z + vb[j].w * vb[j].w); }
            const float ra = 1.f / sqrtf(wave_sum(sa) * (1.f / ND) + RMS_EPS), rbv = 1.f / sqrtf(wave_sum(sb) * (1.f / ND) + RMS_EPS);
            u32x2* oa = (u32x2*)(H + (size_t)rowa * ND) + cx.lane; u32x2* ob = (u32x2*)(H + (size_t)rowb * ND) + cx.lane;
#pragma unroll
            for (int j = 0; j < 8; ++j) {
                const int col = 4 * cx.lane + 256 * j;
                const f32x4 sh = *(const LAS f32x4*)(shsc + col), gs = gmix[j] * (*(const LAS f32x4*)(shsc + 2048 + col) + 1.f);
                const f32x4 ya = va[j] * ra * gs + sh, yb = vb[j] * rbv * gs + sh;
                u32x2 w; w.x = pk2(ya.x, ya.y); w.y = pk2(ya.z, ya.w); oa[64 * j] = w;
                w.x = pk2(yb.x, yb.y); w.y = pk2(yb.z, yb.w); ob[64 * j] = w;
            }
        }
    }
}

template <class AF, class BF, class MF, class EF>
__device__ __forceinline__ void ngemm_tile(LAS unsigned char* lds, int K, int midk, const AF& af, const BF& bf, const MF& mf, const EF& ef, int tid) {
    LAS float* As = (LAS float*)lds; LAS float* Bs = As + 32 * 68;
    const int ty = tid >> 4, tx = tid & 15, lr = tid >> 3, lk = (tid & 7) * 4;
    f32x4 acc0 = (f32x4){0.f, 0.f, 0.f, 0.f}, acc1 = acc0;
    for (int k0 = 0; k0 < K; k0 += 32) {
        if (k0 == midk) { mf(2 * ty, 4 * tx, acc0); mf(2 * ty + 1, 4 * tx, acc1); }
        const bf16_t* pa = af(lr, k0); const bf16_t* pb = bf(lr, k0);
        u32x2 ra = (u32x2){0u, 0u}, rb = ra;
        if (pa) ra = *(const u32x2*)(pa + lk);
        if (pb) rb = *(const u32x2*)(pb + lk);
        __syncthreads();
        As[(lk + 0) * 68 + lr] = bf2f(ra.x & 0xffffu); As[(lk + 1) * 68 + lr] = bf2f(ra.x >> 16); As[(lk + 2) * 68 + lr] = bf2f(ra.y & 0xffffu); As[(lk + 3) * 68 + lr] = bf2f(ra.y >> 16);
        Bs[(lk + 0) * 68 + lr] = bf2f(rb.x & 0xffffu); Bs[(lk + 1) * 68 + lr] = bf2f(rb.x >> 16); Bs[(lk + 2) * 68 + lr] = bf2f(rb.y & 0xffffu); Bs[(lk + 3) * 68 + lr] = bf2f(rb.y >> 16);
        __syncthreads();
#pragma unroll 8
        for (int kk = 0; kk < 32; ++kk) {
            const f32x2 a = *(const LAS f32x2*)(As + kk * 68 + 2 * ty);
            const f32x4 b = *(const LAS f32x4*)(Bs + kk * 68 + 4 * tx);
            acc0 += a.x * b; acc1 += a.y * b;
        }
    }
    ef(2 * ty, 4 * tx, acc0); ef(2 * ty + 1, 4 * tx, acc1);
    __syncthreads();
}
struct NoMid { __device__ __forceinline__ void operator()(int, int, f32x4&) const {} };

struct InA { const bf16_t* H; int row0; __device__ __forceinline__ const bf16_t* operator()(int r, int k0) const { return H + (size_t)(row0 + r) * ND + k0; } };
struct InB { const bf16_t* W; int col0; __device__ __forceinline__ const bf16_t* operator()(int n, int k0) const { return W + (size_t)(col0 + n) * ND + k0; } };
struct InEpi {
    unsigned char* ws; int row0, col0;
    __device__ __forceinline__ void operator()(int r, int c, f32x4& v) const {
        const int row = row0 + r, col = col0 + c;
        const bool rope = (col < C_VA) || (col >= C_QD && col < C_VD);
        if (rope) {
            const int i0 = (col & 63) >> 1;
            const float* cosT = (const float*)(ws + WS_COS) + (size_t)row * 32 + i0; const float* sinT = (const float*)(ws + WS_SIN) + (size_t)row * 32 + i0;
            const float c0 = cosT[0], c1 = cosT[1], s0 = sinT[0], s1 = sinT[1];
            float o0 = v.x * c0 - v.y * s0, o1 = v.y * c0 + v.x * s0, o2 = v.z * c1 - v.w * s1, o3 = v.w * c1 + v.z * s1;
            const bool isq = (col < C_KA) || (col >= C_QD && col < C_KD);
            if (isq) { o0 *= C2; o1 *= C2; o2 *= C2; o3 *= C2; }
            bf16_t* dst;
            if (col < C_KA) dst = (bf16_t*)(ws + WS_QA) + (size_t)row * 1024 + col;
            else if (col < C_VA) dst = (bf16_t*)(ws + WS_KA) + (size_t)row * 128 + (col - C_KA);
            else if (col < C_KD) dst = (bf16_t*)(ws + WS_QD) + (size_t)row * 1024 + (col - C_QD);
            else dst = (bf16_t*)(ws + WS_KD) + (size_t)row * 1024 + (col - C_KD);
            u32x2 w; w.x = pk2(o0, o1); w.y = pk2(o2, o3); *(u32x2*)dst = w;
        } else if (col < C_GA) {
            bf16_t* dst = (col < C_QD) ? (bf16_t*)(ws + WS_VA) + (size_t)row * 128 + (col - C_VA) : (bf16_t*)(ws + WS_VD) + (size_t)row * 1024 + (col - C_VD);
            u32x2 w; w.x = pk2(v.x, v.y); w.y = pk2(v.z, v.w); *(u32x2*)dst = w;
        } else {
            bf16_t* dst = (bf16_t*)(ws + WS_G) + (size_t)row * 4096 + (col - C_GA);
            u32x2 w; w.x = pk2(1.f / (1.f + __expf(-v.x)), 1.f / (1.f + __expf(-v.y))); w.y = pk2(1.f / (1.f + __expf(-v.z)), 1.f / (1.f + __expf(-v.w))); *(u32x2*)dst = w;
        }
    }
};
__device__ __forceinline__ void phase_inproj_naive(const Params& p, LAS unsigned char* lds, const Ctx& cx) {
    constexpr int NTN = IN_COLS / 64, NT = (NM / 64) * NTN;
    for (int t = blockIdx.x; t < NT; t += gridDim.x) {
        const int tm = t / NTN, tn = t % NTN;
        InA af{(const bf16_t*)(p.ws + WS_H), tm * 64}; InB bf{(const bf16_t*)(p.ws + WS_WINT), tn * 64}; InEpi ef{p.ws, tm * 64, tn * 64};
        ngemm_tile(lds, ND, -1, af, bf, NoMid(), ef, cx.tid);
    }
}

__device__ __forceinline__ void load8(const bf16_t* p, float* d) {
    const u32x4 w = *(const u32x4*)p;
    d[0] = bf2f(w.x & 0xffffu); d[1] = bf2f(w.x >> 16); d[2] = bf2f(w.y & 0xffffu); d[3] = bf2f(w.y >> 16);
    d[4] = bf2f(w.z & 0xffffu); d[5] = bf2f(w.z >> 16); d[6] = bf2f(w.w & 0xffffu); d[7] = bf2f(w.w >> 16);
}
__device__ __forceinline__ void phase_swa_naive(const Params& p, const Ctx& cx) {
    const bf16_t* QA = (const bf16_t*)(p.ws + WS_QA); const bf16_t* KA = (const bf16_t*)(p.ws + WS_KA); const bf16_t* VA = (const bf16_t*)(p.ws + WS_VA);
    bf16_t* OA = (bf16_t*)(p.ws + WS_OA);
    for (int it = cx.gtid; it < NB * 16 * NS; it += cx.ngt) {
        const int s = it & (NS - 1), qh = (it >> 11) & 15, b = it >> 15, kvh = qh >> 3;
        const int row = b * NS + s, s0 = s - cx.lane;
        float q[64], acc[64];
#pragma unroll
        for (int d = 0; d < 64; d += 8) load8(QA + (size_t)row * 1024 + qh * 64 + d, q + d);
#pragma unroll
        for (int d = 0; d < 64; ++d) acc[d] = 0.f;
        float m = p.sinks[qh] * LOG2E, l = 1.f;
        const int klo = (s0 - 127 < 0) ? 0 : s0 - 127, khi = s0 + 63;
        for (int kp = klo; kp <= khi; ++kp) {
            const bf16_t* kr = KA + (size_t)(b * NS + kp) * 128 + kvh * 64;
            float sc = 0.f;
#pragma unroll
            for (int d = 0; d < 64; d += 8) { float kk[8]; load8(kr + d, kk);
#pragma unroll
                for (int j = 0; j < 8; ++j) sc += q[d + j] * kk[j]; }
            const bool valid = (kp <= s) && (s - kp < 128);
            if (valid) {
                const float mn = fmaxf(m, sc), alpha = exp2f(m - mn), pe = exp2f(sc - mn);
                l = l * alpha + pe; m = mn;
                const bf16_t* vr = VA + (size_t)(b * NS + kp) * 128 + kvh * 64;
#pragma unroll
                for (int d = 0; d < 64; d += 8) { float vv[8]; load8(vr + d, vv);
#pragma unroll
                    for (int j = 0; j < 8; ++j) acc[d + j] = acc[d + j] * alpha + pe * vv[j]; }
            }
        }
        const float il = 1.f / l;
        bf16_t* o = OA + (size_t)row * 1024 + qh * 64;
#pragma unroll
        for (int d = 0; d < 64; d += 8) { u32x4 w; w.x = pk2(acc[d] * il, acc[d + 1] * il); w.y = pk2(acc[d + 2] * il, acc[d + 3] * il); w.z = pk2(acc[d + 4] * il, acc[d + 5] * il); w.w = pk2(acc[d + 6] * il, acc[d + 7] * il); *(u32x4*)(o + d) = w; }
    }
}
__device__ __forceinline__ float diff_lambda(const Params& p) {
    float s1 = 0.f, s2 = 0.f;
    for (int i = 0; i < 64; ++i) { s1 += p.lq1[i] * p.lk1[i]; s2 += p.lq2[i] * p.lk2[i]; }
    return expf(s1) - expf(s2) + 0.2f;
}
__device__ __forceinline__ void phase_diff_naive(const Params& p, const Ctx& cx) {
    const bf16_t* QD = (const bf16_t*)(p.ws + WS_QD); const bf16_t* KD = (const bf16_t*)(p.ws + WS_KD); const bf16_t* VD = (const bf16_t*)(p.ws + WS_VD);
    bf16_t* OB = (bf16_t*)(p.ws + WS_OB); float* TMP = (float*)(p.ws + WS_TMP);
    const float lam = diff_lambda(p);
    for (int it = cx.gtid; it < NB * 8 * NS; it += cx.ngt) {
        const int s = it & (NS - 1), h = (it >> 11) & 7, b = it >> 14;
        const int row = b * NS + s, smax = s - cx.lane + 63;
        float* tr = TMP + (size_t)row * 1024 + h * 128;
        float ssq = 0.f;
        for (int vh = 0; vh < 2; ++vh) {
            for (int c = 0; c < 2; ++c) {
                float q[64], acc[64];
#pragma unroll
                for (int d = 0; d < 64; d += 8) load8(QD + (size_t)row * 1024 + (2 * h + c) * 64 + d, q + d);
#pragma unroll
                for (int d = 0; d < 64; ++d) acc[d] = 0.f;
                float m = -1e30f, l = 0.f;
                for (int kp = 0; kp <= smax; ++kp) {
                    const bf16_t* kr = KD + (size_t)(b * NS + kp) * 1024 + (2 * h + c) * 64;
                    float sc = 0.f;
#pragma unroll
                    for (int d = 0; d < 64; d += 8) { float kk[8]; load8(kr + d, kk);
#pragma unroll
                        for (int j = 0; j < 8; ++j) sc += q[d + j] * kk[j]; }
                    if (kp <= s) {
                        const float mn = fmaxf(m, sc), alpha = exp2f(m - mn), pe = exp2f(sc - mn);
                        l = l * alpha + pe; m = mn;
                        const bf16_t* vr = VD + (size_t)(b * NS + kp) * 1024 + h * 128 + vh * 64;
#pragma unroll
                        for (int d = 0; d < 64; d += 8) { float vv[8]; load8(vr + d, vv);
#pragma unroll
                            for (int j = 0; j < 8; ++j) acc[d + j] = acc[d + j] * alpha + pe * vv[j]; }
                    }
                }
                const float il = 1.f / l;
                if (c == 0) {
#pragma unroll
                    for (int d = 0; d < 64; d += 4) *(f32x4*)(tr + vh * 64 + d) = (f32x4){acc[d] * il, acc[d + 1] * il, acc[d + 2] * il, acc[d + 3] * il};
                } else {
#pragma unroll
                    for (int d = 0; d < 64; d += 4) { f32x4 t = *(const f32x4*)(tr + vh * 64 + d);
                        t.x -= lam * acc[d] * il; t.y -= lam * acc[d + 1] * il; t.z -= lam * acc[d + 2] * il; t.w -= lam * acc[d + 3] * il;
                        ssq += (t.x * t.x + t.y * t.y) + (t.z * t.z + t.w * t.w); *(f32x4*)(tr + vh * 64 + d) = t; }
                }
            }
        }
        const float rstd = 0.8f / sqrtf(ssq * (1.f / 128.f) + RMS_EPS);
        bf16_t* o = OB + (size_t)row * 1024 + h * 128;
        for (int d = 0; d < 128; d += 4) { const f32x4 t = *(const f32x4*)(tr + d); const f32x4 g = *(const f32x4*)(p.subln + d);
            u32x2 w; w.x = pk2(t.x * rstd * g.x, t.y * rstd * g.y); w.y = pk2(t.z * rstd * g.z, t.w * rstd * g.w); *(u32x2*)(o + d) = w; }
    }
}

namespace att {
using bf16=unsigned short;
using bf16x8=__attribute__((ext_vector_type(8)))short;
using s16x4=__attribute__((ext_vector_type(4)))short;
using f32x16=__attribute__((ext_vector_type(16)))float;
using u32x4=__attribute__((ext_vector_type(4)))unsigned;
constexpr int D=64;
constexpr int NW=8,QBLK=32,QB=QBLK*NW,KVBLK=64;
__device__ __forceinline__ int crow(int r,int hi){return (r&3)+8*(r>>2)+4*hi;}
#define SBAR() __builtin_amdgcn_sched_barrier(0)
__device__ __forceinline__ void cmask(f32x16&p0,f32x16&p1,int jb,int qrel,int hi){
  const float NEG=-INFINITY; int kb=64*jb+4*hi;
  #pragma unroll
  for(int r=0;r<16;++r){int kv=kb+(r&3)+8*(r>>2); if(kv>qrel)p0[r]=NEG; if(kv+32>qrel)p1[r]=NEG;}
}
__device__ __forceinline__ void wmask(f32x16&p0,f32x16&p1,int kv0,int qrel,int hi){
  const float NEG=-1000.f; const int kb=kv0+4*hi;
  #pragma unroll
  for(int r=0;r<16;++r){const int kv=kb+(r&3)+8*(r>>2); if(kv>qrel||qrel-kv>=128)p0[r]=NEG; if(kv+32>qrel||qrel-(kv+32)>=128)p1[r]=NEG;}
}

constexpr int NSLOT=3, SLOTB=8192;
constexpr int LDS_K=0, LDS_V=NSLOT*SLOTB, LDS_WS=2*NSLOT*SLOTB, LDS_OST=LDS_WS+NW*64*4, LDS_BYTES=LDS_OST+NW*4096;
constexpr float C2=0.125f*1.4426950408889634f;
__device__ __forceinline__ void glds16(const void*gsrc,unsigned lds_dst){unsigned keep;
  asm volatile("s_mov_b32 %0, m0\n\ts_mov_b32 m0, %2\n\ts_nop 0\n\tglobal_load_lds_dwordx4 %1, off\n\ts_mov_b32 m0, %0":"=&s"(keep):"v"(gsrc),"s"(lds_dst):"memory");}
__device__ __forceinline__ float max3f(float a,float b,float c){float r;asm("v_max3_f32 %0, %1, %2, %3":"=v"(r):"v"(a),"v"(b),"v"(c));return r;}
__device__ __forceinline__ float max2f(float a,float b){float r;asm("v_max_f32_e32 %0, %1, %2":"=v"(r):"v"(a),"v"(b));return r;}
__device__ __forceinline__ float fadd_s(float a,float b){float r;asm("v_add_f32_e32 %0, %1, %2":"=v"(r):"v"(a),"v"(b));return r;}
__device__ __forceinline__ float fsub_s(float a,float b){float r;asm("v_sub_f32_e32 %0, %1, %2":"=v"(r):"v"(a),"v"(b));return r;}
typedef float f32x2_t __attribute__((ext_vector_type(2))); typedef __bf16 bf16x2_t __attribute__((ext_vector_type(2)));
__device__ __forceinline__ unsigned cvtpk_s(float lo,float hi){f32x2_t v={lo,hi};bf16x2_t b=__builtin_convertvector(v,bf16x2_t);return __builtin_bit_cast(unsigned,b);}
#define WAIT_BAR(N) asm volatile("s_waitcnt vmcnt(" #N ") lgkmcnt(0)\n\ts_barrier":::"memory")

__device__ __forceinline__ void qkt(f32x16&p0,f32x16&p1,const char*Kslot,const bf16x8*qr,const f32x16&negm,int r32,int hi){
  const char*kb=Kslot+hi*1024+r32*16;
  #pragma unroll
  for(int d0=0;d0<4;++d0){
    const bf16x8 b0=*reinterpret_cast<const bf16x8*>(kb+d0*2048);
    const bf16x8 b1=*reinterpret_cast<const bf16x8*>(kb+d0*2048+512);
    if(d0==0){p0=__builtin_amdgcn_mfma_f32_32x32x16_bf16(b0,qr[0],negm,0,0,0);p1=__builtin_amdgcn_mfma_f32_32x32x16_bf16(b1,qr[0],negm,0,0,0);}
    else{p0=__builtin_amdgcn_mfma_f32_32x32x16_bf16(b0,qr[d0],p0,0,0,0);p1=__builtin_amdgcn_mfma_f32_32x32x16_bf16(b1,qr[d0],p1,0,0,0);}}
}
typedef __attribute__((address_space(3))) const char* lds_cptr;
typedef short v4i16_t __attribute__((ext_vector_type(4)));
__device__ __forceinline__ void kload8(bf16x8*kf,lds_cptr kp){
  kf[0]=*(const __attribute__((address_space(3))) bf16x8*)(kp);      kf[1]=*(const __attribute__((address_space(3))) bf16x8*)(kp+512);
  kf[2]=*(const __attribute__((address_space(3))) bf16x8*)(kp+2048); kf[3]=*(const __attribute__((address_space(3))) bf16x8*)(kp+2560);
  kf[4]=*(const __attribute__((address_space(3))) bf16x8*)(kp+4096); kf[5]=*(const __attribute__((address_space(3))) bf16x8*)(kp+4608);
  kf[6]=*(const __attribute__((address_space(3))) bf16x8*)(kp+6144); kf[7]=*(const __attribute__((address_space(3))) bf16x8*)(kp+6656);
}
__device__ __forceinline__ void kload2(bf16x8*kf,lds_cptr kp,int j){ kf[2*j]=*(const __attribute__((address_space(3))) bf16x8*)(kp+j*2048); kf[2*j+1]=*(const __attribute__((address_space(3))) bf16x8*)(kp+j*2048+512); }
__device__ __forceinline__ s16x4 vtr(lds_cptr p){ return __builtin_bit_cast(s16x4,__builtin_amdgcn_ds_read_tr16_b64_v4i16((__attribute__((address_space(3))) v4i16_t*)p)); }
__device__ __forceinline__ float rowmax(const f32x16&p0,const f32x16&p1){
  float a=max3f(p0[0],p0[1],p1[0]),b=max3f(p0[2],p0[3],p1[1]);a=max3f(a,p1[2],p1[3]);
  #pragma unroll
  for(int r=4;r<16;r+=4){a=max3f(a,p0[r],p0[r+1]);b=max3f(b,p0[r+2],p0[r+3]);a=max3f(a,p1[r],p1[r+1]);b=max3f(b,p1[r+2],p1[r+3]);}
  const float m=max2f(a,b);
  auto rr=__builtin_amdgcn_permlane32_swap(__float_as_uint(m),__float_as_uint(m),false,false);
  return max2f(__uint_as_float(rr[0]),__uint_as_float(rr[1]));
}
__device__ __forceinline__ void pv(f32x16*o,int vb,bf16x8 pa0,bf16x8 pa1,bf16x8 pa2,bf16x8 pa3){
  #pragma unroll
  for(int d0=0;d0<2;++d0){s16x4 lo[4],hi[4];
    #pragma unroll
    for(int ks=0;ks<4;++ks){
      asm volatile("ds_read_b64_tr_b16 %0,%1 offset:%c2":"=&v"(lo[ks]):"v"(vb),"i"(d0*4096+ks*1024):"memory");
      asm volatile("ds_read_b64_tr_b16 %0,%1 offset:%c2":"=&v"(hi[ks]):"v"(vb),"i"(d0*4096+ks*1024+512):"memory");}
    asm volatile("s_waitcnt lgkmcnt(0)":::"memory");SBAR();
    #define PK(k) (bf16x8){lo[k][0],lo[k][1],lo[k][2],lo[k][3],hi[k][0],hi[k][1],hi[k][2],hi[k][3]}
    o[d0]=__builtin_amdgcn_mfma_f32_32x32x16_bf16(pa0,PK(0),o[d0],0,0,0);
    o[d0]=__builtin_amdgcn_mfma_f32_32x32x16_bf16(pa1,PK(1),o[d0],0,0,0);
    o[d0]=__builtin_amdgcn_mfma_f32_32x32x16_bf16(pa2,PK(2),o[d0],0,0,0);
    o[d0]=__builtin_amdgcn_mfma_f32_32x32x16_bf16(pa3,PK(3),o[d0],0,0,0);
    #undef PK
  }
}

#ifndef ATTN_STORE16
#define ATTN_STORE16(p,v) (*(u32x4*)(p)=(v))
#endif
struct EpiArgs { int mode; float lam; float sink2; float sink2b; float* stash; const float* subln; bf16* O; };
template<int KIND,int QP,int KP,int THRL> __device__ __forceinline__ void attn_unit(const bf16*Qu,const bf16*__restrict__ Kh,const bf16*__restrict__ Vh,const int NT,const int koff,const EpiArgs ep,char*shm){
  constexpr int DM=KP;
  int tid_=threadIdx.x; asm volatile("":"+v"(tid_));
  const int tid=tid_,lane=tid&63,r32=lane&31,hi=lane>>5; const int wid=__builtin_amdgcn_readfirstlane(tid>>6);
  const int wq=(KIND==1)?(wid&3):wid, wh=(KIND==1)?(wid>>2):0;
  const bf16*Qw=Qu+(long)(wq*QBLK)*QP+wh*64;
  const unsigned lds0=(unsigned)(uintptr_t)shm;
  float*wsf=(float*)(shm+LDS_WS)+wid*64;
  const bf16*ksrc=Kh+(long)lane*DM+wid*8;
  const bf16*vsrc=Vh+(long)(16*(wid&3)+(lane>>2))*DM+(wid>>2)*32+(lane&3)*8;
  const unsigned kdst=lds0+LDS_K+wid*1024, vdst=lds0+LDS_V+wid*1024;
  #define DMA_K(t,slot) glds16(ksrc+(long)(t)*KVBLK*DM,(unsigned)__builtin_amdgcn_readfirstlane(kdst+(slot)))
  #define DMA_V(t,slot) glds16(vsrc+(long)(t)*KVBLK*DM,(unsigned)__builtin_amdgcn_readfirstlane(vdst+(slot)))
  const int vb0=(int)(lds0+LDS_V)+((lane>>4)&1)*32+(lane&3)*8+(4*hi+((lane&15)>>2))*64;
  const char*Kbase=shm+LDS_K; bf16x8 kf[8];
  const lds_cptr shm3=(lds_cptr)shm; const lds_cptr kp0=shm3+LDS_K+hi*1024+r32*16; const lds_cptr vp0=shm3+LDS_V+((lane>>4)&1)*32+(lane&3)*8+(4*hi+((lane&15)>>2))*64;
  DMA_K(0,0);DMA_V(0,0);DMA_K(1,SLOTB);
  bf16x8 qr[4];
  #pragma unroll
  for(int d0=0;d0<4;++d0)qr[d0]=*reinterpret_cast<const bf16x8*>(&Qw[(long)r32*QP+d0*16+hi*8]);
  float mhat=0.f,l_reg=0.f;f32x16 o[2];o[0]=f32x16{};o[1]=f32x16{};f32x16 negm=f32x16{};asm volatile("":"+v"(negm));
  const int qrel=wq*QBLK+r32;
  #define CMASK(P0,P1,t) do{ if(KIND==1){ wmask(P0,P1,64*(t)+koff,qrel,hi); } else { int jb_=(t)-(NT-4); if(jb_>=0)cmask(P0,P1,jb_,qrel,hi); } }while(0)
  bool resc=false;
  #define START(P0,P1) do{ const float rm=rowmax(P0,P1); resc=false; \
    { const float dl=rm; mhat=fadd_s(mhat,dl); \
      _Pragma("unroll") for(int r=0;r<16;++r){P0[r]=fsub_s(P0[r],dl);P1[r]=fsub_s(P1[r],dl);} \
      _Pragma("unroll") for(int r=0;r<16;++r)negm[r]=-mhat; asm volatile("":"+v"(negm)); } \
    _Pragma("unroll") for(int r=0;r<16;++r)P0[r]=__builtin_amdgcn_exp2f(P0[r]); }while(0)
  #define RESC() do{ if(resc){ asm volatile("s_waitcnt lgkmcnt(0)":::"memory"); \
      _Pragma("unroll") for(int d_=0;d_<2;++d_) _Pragma("unroll") for(int r=0;r<16;++r)o[d_][r]*=wsf[crow(r,hi)]; } }while(0)
  f32x16 pA0,pA1,pB0,pB1;
  int sl_prev=0,sl_cur=0,sl_next=SLOTB;
  #define ROT() do{sl_prev=sl_cur;sl_cur=sl_next;sl_next=(sl_next==(NSLOT-1)*SLOTB)?0:sl_next+SLOTB;}while(0)
  DMA_K(2,2*SLOTB);
  WAIT_BAR(3);
  qkt(pA0,pA1,Kbase,qr,negm,r32,hi);asm volatile("s_nop 15\n\ts_nop 7":"+v"(pA0),"+v"(pA1));CMASK(pA0,pA1,0);
  START(pA0,pA1);
  _Pragma("unroll") for(int r=0;r<16;++r)pA1[r]=__builtin_amdgcn_exp2f(pA1[r]);
  WAIT_BAR(0);
  DMA_K(3,0);DMA_V(1,SLOTB);
  ROT();
  kload8(kf,kp0+sl_cur);
  WAIT_BAR(2);
  s16x4 vlo[8],vhi[8]; u32x4 pw0,pw1,pw2,pw3;
  #define PKW(P,B) cvtpk_s(P[B],P[B+1])
  #define PAF(k) __builtin_bit_cast(bf16x8,pw##k)
  #define VFR(i) (bf16x8){vlo[i][0],vlo[i][1],vlo[i][2],vlo[i][3],vhi[i][0],vhi[i][1],vhi[i][2],vhi[i][3]}
  #define PIN(x) asm volatile("":"+v"(x))
  #define MX3(a,b,c) __builtin_fmaxf(__builtin_fmaxf((a),(b)),(c))
  #define GAPA(MF,A0,A1,A2,A3,W0,W1,PW) do{ MF; sacc+=A0; sacc+=A1; sacc+=A2; sacc+=A3; PIN(sacc); W0; W1; PIN(PW); SBAR(); }while(0)
  #define EX(v) __builtin_amdgcn_exp2f(v)
  #define GAPB(MF,X,B) do{ MF; X[B]=EX(X[B]); X[B+1]=EX(X[B+1]); X[B+2]=EX(X[B+2]); X[B+3]=EX(X[B+3]); PIN(X); SBAR(); }while(0)
  #define VRD(i) do{ vlo[i]=vtr(vp_+(((i)>>2)*4096+((i)&3)*1024)); vhi[i]=vtr(vp_+(((i)>>2)*4096+((i)&3)*1024+512)); }while(0)
  #define KRD(G,j) do{ if(G){ kload2(kf,kp0+sl_next,j); SBAR(); } }while(0)
  #define STEP(C0,C1,P0,P1,t,GK,GV,GL) do{ SBAR(); \
    const lds_cptr vp_=vp0+sl_prev; \
    VRD(0); SBAR(); float sacc=(P0[0]+P0[1]); \
    GAPA(C0=__builtin_amdgcn_mfma_f32_32x32x16_bf16(kf[0],qr[0],negm,0,0,0), P0[2],P0[3],P0[4],P0[5],     pw0[0]=PKW(P0,0), pw0[1]=PKW(P0,2), pw0); \
    VRD(4); SBAR(); GAPA(C1=__builtin_amdgcn_mfma_f32_32x32x16_bf16(kf[1],qr[0],negm,0,0,0), P0[6],P0[7],P0[8],P0[9],     pw0[2]=PKW(P0,4), pw0[3]=PKW(P0,6), pw0); \
    VRD(1); SBAR(); GAPA(C0=__builtin_amdgcn_mfma_f32_32x32x16_bf16(kf[2],qr[1],C0,0,0,0),   P0[10],P0[11],P0[12],P0[13], pw1[0]=PKW(P0,8), pw1[1]=PKW(P0,10), pw1); \
    VRD(5); SBAR(); GAPA(C1=__builtin_amdgcn_mfma_f32_32x32x16_bf16(kf[3],qr[1],C1,0,0,0),   P0[14],P0[15],P1[0],P1[1],   pw1[2]=PKW(P0,12),pw1[3]=PKW(P0,14), pw1); \
    VRD(2); SBAR(); GAPA(C0=__builtin_amdgcn_mfma_f32_32x32x16_bf16(kf[4],qr[2],C0,0,0,0),   P1[2],P1[3],P1[4],P1[5],     pw2[0]=PKW(P1,0), pw2[1]=PKW(P1,2), pw2); \
    VRD(6); SBAR(); GAPA(C1=__builtin_amdgcn_mfma_f32_32x32x16_bf16(kf[5],qr[2],C1,0,0,0),   P1[6],P1[7],P1[8],P1[9],     pw2[2]=PKW(P1,4), pw2[3]=PKW(P1,6), pw2); \
    VRD(3); SBAR(); GAPA(C0=__builtin_amdgcn_mfma_f32_32x32x16_bf16(kf[6],qr[3],C0,0,0,0),   P1[10],P1[11],P1[12],P1[13], pw3[0]=PKW(P1,8), pw3[1]=PKW(P1,10), pw3); \
    VRD(7); SBAR(); GAPA(C1=__builtin_amdgcn_mfma_f32_32x32x16_bf16(kf[7],qr[3],C1,0,0,0),   P1[14],P1[15],0.f,0.f,       pw3[2]=PKW(P1,12),pw3[3]=PKW(P1,14), pw3); \
    l_reg+=sacc; \
    if(GK){DMA_K((t)+3,sl_cur);} if(GV){DMA_V((t)+1,sl_next);} \
    CMASK(C0,C1,t); \
    { float a=MX3(C0[0],C0[1],C1[0]),b=MX3(C0[2],C0[3],C1[1]); a=MX3(a,C1[2],C1[3]); \
      _Pragma("unroll") for(int r=4;r<16;r+=4){a=MX3(a,C0[r],C0[r+1]);b=MX3(b,C0[r+2],C0[r+3]);a=MX3(a,C1[r],C1[r+1]);b=MX3(b,C1[r+2],C1[r+3]);} \
      float rm=__builtin_fmaxf(a,b); { auto rr=__builtin_amdgcn_permlane32_swap(__float_as_uint(rm),__float_as_uint(rm),false,false); rm=__builtin_fmaxf(__uint_as_float(rr[0]),__uint_as_float(rr[1])); } \
      resc=false; \
      if(__builtin_expect(__any(rm>(float)THRL),0)){ const float dl=__builtin_fmaxf(rm,0.f); mhat+=dl; \
        _Pragma("unroll") for(int r=0;r<16;++r){C0[r]-=dl;C1[r]-=dl;} \
        _Pragma("unroll") for(int r=0;r<16;++r)negm[r]=-mhat; asm volatile("":"+v"(negm)); \
        const float f=__builtin_amdgcn_exp2f(-dl); l_reg*=f; if(hi==0)wsf[r32]=f; resc=true; } } \
    SBAR(); \
    GAPB(o[0]=__builtin_amdgcn_mfma_f32_32x32x16_bf16(PAF(0),VFR(0),o[0],0,0,0), C0,0); \
    GAPB(o[1]=__builtin_amdgcn_mfma_f32_32x32x16_bf16(PAF(0),VFR(4),o[1],0,0,0), C0,4); \
    KRD(GL,0); GAPB(o[0]=__builtin_amdgcn_mfma_f32_32x32x16_bf16(PAF(1),VFR(1),o[0],0,0,0), C0,8); \
    KRD(GL,1); GAPB(o[1]=__builtin_amdgcn_mfma_f32_32x32x16_bf16(PAF(1),VFR(5),o[1],0,0,0), C0,12); \
    KRD(GL,2); GAPB(o[0]=__builtin_amdgcn_mfma_f32_32x32x16_bf16(PAF(2),VFR(2),o[0],0,0,0), C1,0); \
    KRD(GL,3); GAPB(o[1]=__builtin_amdgcn_mfma_f32_32x32x16_bf16(PAF(2),VFR(6),o[1],0,0,0), C1,4); \
    GAPB(o[0]=__builtin_amdgcn_mfma_f32_32x32x16_bf16(PAF(3),VFR(3),o[0],0,0,0), C1,8); \
    GAPB(o[1]=__builtin_amdgcn_mfma_f32_32x32x16_bf16(PAF(3),VFR(7),o[1],0,0,0), C1,12); \
    }while(0)
  int t=1;
  #undef CMASK
  #define CMASK(P0,P1,t) do{}while(0)
  for(;t+5<NT;t+=2){
    STEP(pB0,pB1,pA0,pA1,t,true,true,true);     WAIT_BAR(2); RESC(); ROT();
    STEP(pA0,pA1,pB0,pB1,t+1,true,true,true);   WAIT_BAR(2); RESC(); ROT();
  }
  #undef CMASK
  #define CMASK(P0,P1,t) do{ if(KIND==1){ wmask(P0,P1,64*(t)+koff,qrel,hi); } else { int jb_=(t)-(NT-4); if(jb_>=0)cmask(P0,P1,jb_,qrel,hi); } }while(0)
  #define ENDW(tt) do{ if((tt)+3<NT){WAIT_BAR(2);} else if((tt)+2<NT){WAIT_BAR(1);} else {WAIT_BAR(0);} }while(0)
  for(;t+1<NT;t+=2){
    STEP(pB0,pB1,pA0,pA1,t,(t+3<NT),(t+1<NT),(t+1<NT));       ENDW(t);   RESC(); ROT();
    STEP(pA0,pA1,pB0,pB1,t+1,(t+4<NT),(t+2<NT),(t+2<NT));     ENDW(t+1); RESC(); ROT();
  }
  STEP(pB0,pB1,pA0,pA1,NT-1,false,false,false); RESC();
  { float sacc=pB0[0]+pB0[1]; _Pragma("unroll") for(int r=2;r<16;++r)sacc+=pB0[r]; _Pragma("unroll") for(int r=0;r<16;++r)sacc+=pB1[r]; l_reg+=sacc;
    pw0=(u32x4){PKW(pB0,0),PKW(pB0,2),PKW(pB0,4),PKW(pB0,6)};pw1=(u32x4){PKW(pB0,8),PKW(pB0,10),PKW(pB0,12),PKW(pB0,14)};pw2=(u32x4){PKW(pB1,0),PKW(pB1,2),PKW(pB1,4),PKW(pB1,6)};pw3=(u32x4){PKW(pB1,8),PKW(pB1,10),PKW(pB1,12),PKW(pB1,14)};
    SBAR(); pv(o,vb0+sl_cur,PAF(0),PAF(1),PAF(2),PAF(3)); }
  #undef PKW
  #undef PAF
  #undef VFR
  #undef PIN
  #undef MX3
  #undef GAPA
  #undef GAPB
  #undef EX
  #undef VRD
  #undef KRD
  #undef STEP
  #undef ENDW
  {auto rr=__builtin_amdgcn_permlane32_swap(__float_as_uint(l_reg),__float_as_uint(l_reg),false,false);l_reg=__uint_as_float(rr[0])+__uint_as_float(rr[1]);}
  if(KIND==1)l_reg+=__builtin_amdgcn_exp2f((wh?ep.sink2b:ep.sink2)-mhat);
  if(hi==0)wsf[32+r32]=l_reg;asm volatile("s_waitcnt lgkmcnt(0)":::"memory");
  float rli[16];
  #pragma unroll
  for(int r=0;r<16;++r)rli[r]=__builtin_amdgcn_rcpf(wsf[32+crow(r,hi)]);
  bf16*stg=(bf16*)(shm+LDS_OST)+wid*2048;
  #define STAGE_OUT(EXPR,OPTR) do{ \
    _Pragma("unroll") for(int r=0;r<16;++r){const int orow=crow(r,hi); _Pragma("unroll") for(int d0=0;d0<2;++d0){ const float val_=(EXPR); stg[orow*64+d0*32+r32]=(bf16)f2bf(val_);} } \
    asm volatile("s_waitcnt lgkmcnt(0)":::"memory"); \
    _Pragma("unroll") for(int i=0;i<4;++i){const int row=i*8+(lane>>3),ch=lane&7; const u32x4 v=*(const u32x4*)(stg+row*64+ch*8); *(u32x4*)((OPTR)+(long)(wq*QBLK+row)*1024+wh*64+ch*8)=v;} \
    asm volatile("s_waitcnt lgkmcnt(0)":::"memory"); }while(0)
  if(KIND==1){
    STAGE_OUT(o[d0][r]*rli[r],ep.O);
  } else {
    float*st=ep.stash+(size_t)(blockIdx.x*NW+wid)*6144+lane;
    const int mode=ep.mode;
    if(mode==0||mode==2){
      #pragma unroll
      for(int d0=0;d0<2;++d0)
        #pragma unroll
        for(int r=0;r<16;++r)st[(d0*16+r)*64]=o[d0][r]*rli[r];
    } else if(mode==1){
      float ssq[16];
      #pragma unroll
      for(int r=0;r<16;++r)ssq[r]=0.f;
      #pragma unroll
      for(int d0=0;d0<2;++d0)
        #pragma unroll
        for(int r=0;r<16;++r){const float rv=st[(d0*16+r)*64]-ep.lam*(o[d0][r]*rli[r]); st[2048+(d0*16+r)*64]=rv; ssq[r]+=rv*rv;}
      #pragma unroll
      for(int r=0;r<16;++r)st[4096+r*64]=ssq[r];
    } else {
      float ssq[16];
      #pragma unroll
      for(int r=0;r<16;++r)ssq[r]=st[4096+r*64];
      #pragma unroll
      for(int d0=0;d0<2;++d0)
        #pragma unroll
        for(int r=0;r<16;++r){const float rv=st[(d0*16+r)*64]-ep.lam*(o[d0][r]*rli[r]); o[d0][r]=rv; ssq[r]+=rv*rv;}
      #pragma unroll
      for(int r=0;r<16;++r){
        #pragma unroll
        for(int k=1;k<32;k<<=1)ssq[r]+=__shfl_xor(ssq[r],k);
        ssq[r]=0.8f/sqrtf(ssq[r]*(1.f/128.f)+1e-6f);
      }
      float g0[2],g1[2];
      #pragma unroll
      for(int d0=0;d0<2;++d0){g0[d0]=ep.subln[d0*32+r32];g1[d0]=ep.subln[64+d0*32+r32];}
      STAGE_OUT(st[2048+(d0*16+r)*64]*ssq[r]*g0[d0],ep.O);
      STAGE_OUT(o[d0][r]*ssq[r]*g1[d0],ep.O+64);
    }
  }
  #undef STAGE_OUT
  asm volatile("s_waitcnt lgkmcnt(0)\n\ts_barrier":::"memory");
  #undef DMA_K
  #undef DMA_V
  #undef CMASK
  #undef START
  #undef RESC
  #undef ROT
}
constexpr int V2SLOT=2*SLOTB, L2_K=0, L2_V=NSLOT*SLOTB, L2_WS=L2_V+NSLOT*V2SLOT, L2_OST=L2_WS+NW*64*4, L2_BYTES=L2_OST+NW*4096;
template<int THRL> __device__ __forceinline__ void attn_unit128(const bf16*Qu,const bf16*__restrict__ Kh,const bf16*__restrict__ Vh,const int NT,const EpiArgs ep,char*shm){
  constexpr int DM=1024, QP=1024;
  int tid_=threadIdx.x; asm volatile("":"+v"(tid_));
  const int tid=tid_,lane=tid&63,r32=lane&31,hi=lane>>5; const int wid=__builtin_amdgcn_readfirstlane(tid>>6);
  const bf16*Qw=Qu+(long)(wid*QBLK)*QP;
  const unsigned lds0=(unsigned)(uintptr_t)shm;
  float*wsf=(float*)(shm+L2_WS)+wid*64;
  const bf16*ksrc=Kh+(long)lane*DM+wid*8;
  const bf16*vsrc=Vh+(long)(16*(wid&3)+(lane>>2))*DM+(wid>>2)*32+(lane&3)*8;
  const unsigned kdst=lds0+L2_K+wid*1024, vdst=lds0+L2_V+wid*1024;
  #define DMA_K(t,slot) glds16(ksrc+(long)(t)*KVBLK*DM,(unsigned)__builtin_amdgcn_readfirstlane(kdst+(slot)))
  #define DMA_V(t,slot) do{ glds16(vsrc+(long)(t)*KVBLK*DM,(unsigned)__builtin_amdgcn_readfirstlane(vdst+2*(slot))); glds16(vsrc+(long)(t)*KVBLK*DM+64,(unsigned)__builtin_amdgcn_readfirstlane(vdst+2*(slot)+8192)); }while(0)
  const int vb0=(int)(lds0+L2_V)+((lane>>4)&1)*32+(lane&3)*8+(4*hi+((lane&15)>>2))*64;
  const char*Kbase=shm+L2_K; bf16x8 kf[8];
  const lds_cptr shm3=(lds_cptr)shm; const lds_cptr kp0=shm3+L2_K+hi*1024+r32*16; const lds_cptr vp0=shm3+L2_V+((lane>>4)&1)*32+(lane&3)*8+(4*hi+((lane&15)>>2))*64;
  DMA_K(0,0);DMA_V(0,0);DMA_K(1,SLOTB);
  bf16x8 qr[4];
  #pragma unroll
  for(int d0=0;d0<4;++d0)qr[d0]=*reinterpret_cast<const bf16x8*>(&Qw[(long)r32*QP+d0*16+hi*8]);
  float mhat=0.f,l_reg=0.f;f32x16 o[4];o[0]=f32x16{};o[1]=f32x16{};o[2]=f32x16{};o[3]=f32x16{};
  const f32x16 zero16=f32x16{};
  const int qrel=wid*QBLK+r32;
  #define CMASK(P0,P1,t) do{ int jb_=(t)-(NT-4); if(jb_>=0)cmask(P0,P1,jb_,qrel,hi); }while(0)
  bool resc=false;
  #define RESC() do{ if(resc){ asm volatile("s_waitcnt lgkmcnt(0)":::"memory"); \
      _Pragma("unroll") for(int d_=0;d_<4;++d_) _Pragma("unroll") for(int r=0;r<16;++r)o[d_][r]*=wsf[crow(r,hi)]; } }while(0)
  f32x16 pA0,pA1,pB0,pB1;
  int sl_prev=0,sl_cur=0,sl_next=SLOTB;
  #define ROT() do{sl_prev=sl_cur;sl_cur=sl_next;sl_next=(sl_next==(NSLOT-1)*SLOTB)?0:sl_next+SLOTB;}while(0)
  DMA_K(2,2*SLOTB);
  WAIT_BAR(4);
  qkt(pA0,pA1,Kbase,qr,zero16,r32,hi);asm volatile("s_nop 15\n\ts_nop 7":"+v"(pA0),"+v"(pA1));CMASK(pA0,pA1,0);
  { const float rm=rowmax(pA0,pA1); mhat=rm;
    _Pragma("unroll") for(int r=0;r<16;++r)pA0[r]=__builtin_amdgcn_exp2f(pA0[r]-mhat);
    _Pragma("unroll") for(int r=0;r<16;++r)pA1[r]=__builtin_amdgcn_exp2f(pA1[r]-mhat); }
  WAIT_BAR(0);
  DMA_K(3,0);DMA_V(1,SLOTB);
  ROT();
  kload8(kf,kp0+sl_cur);
  WAIT_BAR(3);
  s16x4 vlo[8],vhi[8]; u32x4 pw0,pw1,pw2,pw3;
  #define PKW(P,B) cvtpk_s(P[B],P[B+1])
  #define PAF(k) __builtin_bit_cast(bf16x8,pw##k)
  #define VFR(i) (bf16x8){vlo[i][0],vlo[i][1],vlo[i][2],vlo[i][3],vhi[i][0],vhi[i][1],vhi[i][2],vhi[i][3]}
  #define PIN(x) asm volatile("":"+v"(x))
  #define MX3(a,b,c) __builtin_fmaxf(__builtin_fmaxf((a),(b)),(c))
  #define GAPA(MF,A0,A1,A2,A3,W0,W1,PW) do{ MF; sacc+=A0; sacc+=A1; sacc+=A2; sacc+=A3; PIN(sacc); W0; W1; PIN(PW); SBAR(); }while(0)
  #define EX(v) __builtin_amdgcn_exp2f((v)-mh_)
  #define GAPB(MF,X,B) do{ MF; X[B]=EX(X[B]); X[B+1]=EX(X[B+1]); PIN(X); SBAR(); }while(0)
  #define VRD(i) do{ vlo[i]=vtr(vp_+(((i)>>2)*4096+((i)&3)*1024)); vhi[i]=vtr(vp_+(((i)>>2)*4096+((i)&3)*1024+512)); }while(0)
  #define VRD2(i) do{ vlo[i]=vtr(vp_+(8192+((i)>>2)*4096+((i)&3)*1024)); vhi[i]=vtr(vp_+(8192+((i)>>2)*4096+((i)&3)*1024+512)); SBAR(); }while(0)
  #define KRD(G,j) do{ if(G){ kload2(kf,kp0+sl_next,j); SBAR(); } }while(0)
  #define STEP(C0,C1,P0,P1,t,GK,GV,GL) do{ SBAR(); \
    const lds_cptr vp_=vp0+2*sl_prev; \
    VRD(0); SBAR(); float sacc=(P0[0]+P0[1]); \
    GAPA(C0=__builtin_amdgcn_mfma_f32_32x32x16_bf16(kf[0],qr[0],zero16,0,0,0), P0[2],P0[3],P0[4],P0[5],     pw0[0]=PKW(P0,0), pw0[1]=PKW(P0,2), pw0); \
    VRD(4); SBAR(); GAPA(C1=__builtin_amdgcn_mfma_f32_32x32x16_bf16(kf[1],qr[0],zero16,0,0,0), P0[6],P0[7],P0[8],P0[9],     pw0[2]=PKW(P0,4), pw0[3]=PKW(P0,6), pw0); \
    VRD(1); SBAR(); GAPA(C0=__builtin_amdgcn_mfma_f32_32x32x16_bf16(kf[2],qr[1],C0,0,0,0),   P0[10],P0[11],P0[12],P0[13], pw1[0]=PKW(P0,8), pw1[1]=PKW(P0,10), pw1); \
    VRD(5); SBAR(); GAPA(C1=__builtin_amdgcn_mfma_f32_32x32x16_bf16(kf[3],qr[1],C1,0,0,0),   P0[14],P0[15],P1[0],P1[1],   pw1[2]=PKW(P0,12),pw1[3]=PKW(P0,14), pw1); \
    VRD(2); SBAR(); GAPA(C0=__builtin_amdgcn_mfma_f32_32x32x16_bf16(kf[4],qr[2],C0,0,0,0),   P1[2],P1[3],P1[4],P1[5],     pw2[0]=PKW(P1,0), pw2[1]=PKW(P1,2), pw2); \
    VRD(6); SBAR(); GAPA(C1=__builtin_amdgcn_mfma_f32_32x32x16_bf16(kf[5],qr[2],C1,0,0,0),   P1[6],P1[7],P1[8],P1[9],     pw2[2]=PKW(P1,4), pw2[3]=PKW(P1,6), pw2); \
    VRD(3); SBAR(); GAPA(C0=__builtin_amdgcn_mfma_f32_32x32x16_bf16(kf[6],qr[3],C0,0,0,0),   P1[10],P1[11],P1[12],P1[13], pw3[0]=PKW(P1,8), pw3[1]=PKW(P1,10), pw3); \
    VRD(7); SBAR(); GAPA(C1=__builtin_amdgcn_mfma_f32_32x32x16_bf16(kf[7],qr[3],C1,0,0,0),   P1[14],P1[15],0.f,0.f,       pw3[2]=PKW(P1,12),pw3[3]=PKW(P1,14), pw3); \
    l_reg+=sacc; \
    if(GK){DMA_K((t)+3,sl_cur);} if(GV){DMA_V((t)+1,sl_next);} \
    CMASK(C0,C1,t); \
    { float a=MX3(C0[0],C0[1],C1[0]),b=MX3(C0[2],C0[3],C1[1]); a=MX3(a,C1[2],C1[3]); \
      _Pragma("unroll") for(int r=4;r<16;r+=4){a=MX3(a,C0[r],C0[r+1]);b=MX3(b,C0[r+2],C0[r+3]);a=MX3(a,C1[r],C1[r+1]);b=MX3(b,C1[r+2],C1[r+3]);} \
      float rm=__builtin_fmaxf(a,b); { auto rr=__builtin_amdgcn_permlane32_swap(__float_as_uint(rm),__float_as_uint(rm),false,false); rm=__builtin_fmaxf(__uint_as_float(rr[0]),__uint_as_float(rr[1])); } \
      resc=false; \
      if(__builtin_expect(__any(rm-mhat>(float)THRL),0)){ const float dl=__builtin_fmaxf(rm-mhat,0.f); mhat+=dl; \
        const float f=__builtin_amdgcn_exp2f(-dl); l_reg*=f; if(hi==0)wsf[r32]=f; resc=true; } } \
    const float mh_=mhat; \
    SBAR(); \
    GAPB(o[0]=__builtin_amdgcn_mfma_f32_32x32x16_bf16(PAF(0),VFR(0),o[0],0,0,0), C0,0);  VRD2(0); \
    GAPB(o[1]=__builtin_amdgcn_mfma_f32_32x32x16_bf16(PAF(0),VFR(4),o[1],0,0,0), C0,2);  VRD2(4); \
    GAPB(o[0]=__builtin_amdgcn_mfma_f32_32x32x16_bf16(PAF(1),VFR(1),o[0],0,0,0), C0,4);  VRD2(1); \
    GAPB(o[1]=__builtin_amdgcn_mfma_f32_32x32x16_bf16(PAF(1),VFR(5),o[1],0,0,0), C0,6);  VRD2(5); \
    GAPB(o[0]=__builtin_amdgcn_mfma_f32_32x32x16_bf16(PAF(2),VFR(2),o[0],0,0,0), C0,8);  VRD2(2); \
    GAPB(o[1]=__builtin_amdgcn_mfma_f32_32x32x16_bf16(PAF(2),VFR(6),o[1],0,0,0), C0,10); VRD2(6); \
    GAPB(o[0]=__builtin_amdgcn_mfma_f32_32x32x16_bf16(PAF(3),VFR(3),o[0],0,0,0), C0,12); VRD2(3); \
    GAPB(o[1]=__builtin_amdgcn_mfma_f32_32x32x16_bf16(PAF(3),VFR(7),o[1],0,0,0), C0,14); VRD2(7); \
    GAPB(o[2]=__builtin_amdgcn_mfma_f32_32x32x16_bf16(PAF(0),VFR(0),o[2],0,0,0), C1,0); \
    GAPB(o[3]=__builtin_amdgcn_mfma_f32_32x32x16_bf16(PAF(0),VFR(4),o[3],0,0,0), C1,2); \
    KRD(GL,0); GAPB(o[2]=__builtin_amdgcn_mfma_f32_32x32x16_bf16(PAF(1),VFR(1),o[2],0,0,0), C1,4); \
    KRD(GL,1); GAPB(o[3]=__builtin_amdgcn_mfma_f32_32x32x16_bf16(PAF(1),VFR(5),o[3],0,0,0), C1,6); \
    KRD(GL,2); GAPB(o[2]=__builtin_amdgcn_mfma_f32_32x32x16_bf16(PAF(2),VFR(2),o[2],0,0,0), C1,8); \
    KRD(GL,3); GAPB(o[3]=__builtin_amdgcn_mfma_f32_32x32x16_bf16(PAF(2),VFR(6),o[3],0,0,0), C1,10); \
    GAPB(o[2]=__builtin_amdgcn_mfma_f32_32x32x16_bf16(PAF(3),VFR(3),o[2],0,0,0), C1,12); \
    GAPB(o[3]=__builtin_amdgcn_mfma_f32_32x32x16_bf16(PAF(3),VFR(7),o[3],0,0,0), C1,14); \
    }while(0)
  int t=1;
  #undef CMASK
  #define CMASK(P0,P1,t) do{}while(0)
  for(;t+5<NT;t+=2){
    STEP(pB0,pB1,pA0,pA1,t,true,true,true);     WAIT_BAR(3); RESC(); ROT();
    STEP(pA0,pA1,pB0,pB1,t+1,true,true,true);   WAIT_BAR(3); RESC(); ROT();
  }
  #undef CMASK
  #define CMASK(P0,P1,t) do{ int jb_=(t)-(NT-4); if(jb_>=0)cmask(P0,P1,jb_,qrel,hi); }while(0)
  #define ENDW(tt) do{ if((tt)+3<NT){WAIT_BAR(3);} else if((tt)+2<NT){WAIT_BAR(2);} else {WAIT_BAR(0);} }while(0)
  for(;t+1<NT;t+=2){
    STEP(pB0,pB1,pA0,pA1,t,(t+3<NT),(t+1<NT),(t+1<NT));       ENDW(t);   RESC(); ROT();
    STEP(pA0,pA1,pB0,pB1,t+1,(t+4<NT),(t+2<NT),(t+2<NT));     ENDW(t+1); RESC(); ROT();
  }
  STEP(pB0,pB1,pA0,pA1,NT-1,false,false,false); RESC();
  { float sacc=pB0[0]+pB0[1]; _Pragma("unroll") for(int r=2;r<16;++r)sacc+=pB0[r]; _Pragma("unroll") for(int r=0;r<16;++r)sacc+=pB1[r]; l_reg+=sacc;
    pw0=(u32x4){PKW(pB0,0),PKW(pB0,2),PKW(pB0,4),PKW(pB0,6)};pw1=(u32x4){PKW(pB0,8),PKW(pB0,10),PKW(pB0,12),PKW(pB0,14)};pw2=(u32x4){PKW(pB1,0),PKW(pB1,2),PKW(pB1,4),PKW(pB1,6)};pw3=(u32x4){PKW(pB1,8),PKW(pB1,10),PKW(pB1,12),PKW(pB1,14)};
    SBAR(); pv(o,vb0+2*sl_cur,PAF(0),PAF(1),PAF(2),PAF(3)); pv(o+2,vb0+2*sl_cur+8192,PAF(0),PAF(1),PAF(2),PAF(3)); }
  #undef PKW
  #undef PAF
  #undef VFR
  #undef PIN
  #undef MX3
  #undef GAPA
  #undef GAPB
  #undef EX
  #undef VRD
  #undef VRD2
  #undef KRD
  #undef STEP
  #undef ENDW
  {auto rr=__builtin_amdgcn_permlane32_swap(__float_as_uint(l_reg),__float_as_uint(l_reg),false,false);l_reg=__uint_as_float(rr[0])+__uint_as_float(rr[1]);}
  if(hi==0)wsf[32+r32]=l_reg;asm volatile("s_waitcnt lgkmcnt(0)":::"memory");
  float rli[16];
  #pragma unroll
  for(int r=0;r<16;++r)rli[r]=__builtin_amdgcn_rcpf(wsf[32+crow(r,hi)]);
  bf16*stg=(bf16*)(shm+L2_OST)+wid*2048;
  #define STAGE_OUT(EXPR,OPTR) do{ \
    _Pragma("unroll") for(int r=0;r<16;++r){const int orow=crow(r,hi); _Pragma("unroll") for(int d0=0;d0<2;++d0){ const float val_=(EXPR); stg[orow*64+d0*32+r32]=(bf16)f2bf(val_);} } \
    asm volatile("s_waitcnt lgkmcnt(0)":::"memory"); \
    _Pragma("unroll") for(int i=0;i<4;++i){const int row=i*8+(lane>>3),ch=lane&7; const u32x4 v=*(const u32x4*)(stg+row*64+ch*8); *(u32x4*)((OPTR)+(long)(wid*QBLK+row)*1024+ch*8)=v;} \
    asm volatile("s_waitcnt lgkmcnt(0)":::"memory"); }while(0)
  float*st=ep.stash+(size_t)(blockIdx.x*NW+wid)*6144+lane;
  if(ep.mode==0){
    #pragma unroll
    for(int dq=0;dq<4;++dq)
      #pragma unroll
      for(int r=0;r<16;++r)st[(dq*16+r)*64]=o[dq][r]*rli[r];
  } else {
    float ssq[16];
    #pragma unroll
    for(int r=0;r<16;++r)ssq[r]=0.f;
    #pragma unroll
    for(int dq=0;dq<4;++dq)
      #pragma unroll
      for(int r=0;r<16;++r){const float rv=st[(dq*16+r)*64]-ep.lam*(o[dq][r]*rli[r]); o[dq][r]=rv; ssq[r]+=rv*rv;}
    #pragma unroll
    for(int r=0;r<16;++r){
      #pragma unroll
      for(int k=1;k<32;k<<=1)ssq[r]+=__shfl_xor(ssq[r],k);
      ssq[r]=0.8f/sqrtf(ssq[r]*(1.f/128.f)+1e-6f);
    }
    float g0[2],g1[2];
    #pragma unroll
    for(int d0=0;d0<2;++d0){g0[d0]=ep.subln[d0*32+r32];g1[d0]=ep.subln[64+d0*32+r32];}
    STAGE_OUT(o[d0][r]*ssq[r]*g0[d0],ep.O);
    STAGE_OUT(o[2+d0][r]*ssq[r]*g1[d0],ep.O+64);
  }
  #undef STAGE_OUT
  asm volatile("s_waitcnt lgkmcnt(0)\n\ts_barrier":::"memory");
  #undef DMA_K
  #undef DMA_V
  #undef CMASK
  #undef RESC
  #undef ROT
}
constexpr int ATTN_LDS_BYTES=LDS_BYTES;
#undef SBAR
#undef WAIT_BAR
}


__device__ __forceinline__ void phase_attn_fast(const Params& p, char* ldsg) {
    const int G = gridDim.x, bx = blockIdx.x, vcu = (G % 8 == 0) ? (bx % 8) * (G / 8) + bx / 8 : bx;
    const att::bf16* QA = (const att::bf16*)(p.ws + WS_QA); const att::bf16* KA = (const att::bf16*)(p.ws + WS_KA); const att::bf16* VA = (const att::bf16*)(p.ws + WS_VA);
    const att::bf16* QD = (const att::bf16*)(p.ws + WS_QD); const att::bf16* KD = (const att::bf16*)(p.ws + WS_KD); const att::bf16* VD = (const att::bf16*)(p.ws + WS_VD);
    att::bf16* OA = (att::bf16*)(p.ws + WS_OA); att::bf16* OB = (att::bf16*)(p.ws + WS_OB);
    const int UPW = (1024 + G - 1) / G;
    for (int uid = vcu * UPW; uid < (vcu + 1) * UPW && uid < 1024; ++uid) {
        const int grp = uid >> 6, uidx = uid & 63, b = grp >> 1, kvh = grp & 1, qh = kvh * 8 + 2 * (uidx >> 4), qb = uidx & 15;
        const int q0 = 128 * qb, t0 = (2 * qb - 2 < 0) ? 0 : 2 * qb - 2, koff = 64 * t0 - q0;
        att::EpiArgs ep; ep.mode = 0; ep.lam = 0.f; ep.sink2 = p.sinks[qh] * LOG2E; ep.sink2b = p.sinks[qh + 1] * LOG2E; ep.stash = nullptr; ep.subln = nullptr; ep.O = OA + (size_t)(b * NS + q0) * 1024 + qh * 64;
        att::attn_unit<1, 1024, 128, 8>(QA + (size_t)(b * NS + q0) * 1024 + qh * 64, KA + (size_t)(b * NS + 64 * t0) * 128 + kvh * 64, VA + (size_t)(b * NS + 64 * t0) * 128 + kvh * 64, 4, koff, ep, ldsg);
    }
    const float lam = diff_lambda(p);
#ifndef REP_DIFF
#define REP_DIFF 1
#endif
#if DIFF128
    for (int rep_ = 0; rep_ < REP_DIFF; ++rep_)
    for (int slot = vcu; slot < 256; slot += G) {
        const int bh = slot >> 2, s = slot & 3, b = bh >> 3, h = bh & 7;
        for (int i = 0; i < 4; ++i) {
            const int qb = (i < 2) ? 7 - s : s, c = i & 1, q0 = 256 * qb;
            att::EpiArgs ep; ep.mode = c; ep.lam = lam; ep.sink2 = 0.f; ep.sink2b = 0.f; ep.stash = (float*)(p.ws + WS_TMP); ep.subln = p.subln; ep.O = OB + (size_t)(b * NS + q0) * 1024 + h * 128;
            att::attn_unit128<8>(QD + (size_t)(b * NS + q0) * 1024 + (2 * h + c) * 64, KD + (size_t)(b * NS) * 1024 + (2 * h + c) * 64, VD + (size_t)(b * NS) * 1024 + h * 128, 4 * qb + 4, ep, ldsg);
        }
    }
#else
    for (int rep_ = 0; rep_ < REP_DIFF; ++rep_)
    for (int slot = vcu; slot < 256; slot += G) {
        const int bh = slot >> 2, s = slot & 3, b = bh >> 3, h = bh & 7;
        for (int i = 0; i < 8; ++i) {
            const int qb = (i < 4) ? 7 - s : s, piece = i & 3, c = piece & 1, vh = piece >> 1, q0 = 256 * qb;
            att::EpiArgs ep; ep.mode = piece; ep.lam = lam; ep.sink2 = 0.f; ep.sink2b = 0.f; ep.stash = (float*)(p.ws + WS_TMP); ep.subln = p.subln; ep.O = OB + (size_t)(b * NS + q0) * 1024 + h * 128;
            att::attn_unit<0, 1024, 1024, 8>(QD + (size_t)(b * NS + q0) * 1024 + (2 * h + c) * 64, KD + (size_t)(b * NS) * 1024 + (2 * h + c) * 64, VD + (size_t)(b * NS) * 1024 + h * 128 + vh * 64, 4 * qb + 4, -q0, ep, ldsg);
        }
    }
#endif
}

struct BrA { const bf16_t* OA; const bf16_t* OB; int row0; __device__ __forceinline__ const bf16_t* operator()(int r, int k0) const { return (k0 < 1024 ? OA + k0 : OB + (k0 - 1024)) + (size_t)(row0 + r) * 1024; } };
struct BrB { const bf16_t* WA; const bf16_t* WB; int col0; __device__ __forceinline__ const bf16_t* operator()(int n, int k0) const { return (k0 < 1024 ? WA + k0 : WB + (k0 - 1024)) + (size_t)(col0 + n) * 1024; } };
__device__ __forceinline__ void load4bf(const bf16_t* p, f32x4& v) { const u32x2 w = *(const u32x2*)p; v.x = bf2f(w.x & 0xffffu); v.y = bf2f(w.x >> 16); v.z = bf2f(w.y & 0xffffu); v.w = bf2f(w.y >> 16); }
struct BrMid { const bf16_t* G; int row0, col0;
    __device__ __forceinline__ void operator()(int r, int c, f32x4& v) const { f32x4 sa, sb; const bf16_t* g = G + (size_t)(row0 + r) * 4096 + col0 + c; load4bf(g, sa); load4bf(g + 2048, sb);
        v.x *= sa.x / sb.x; v.y *= sa.y / sb.y; v.z *= sa.z / sb.z; v.w *= sa.w / sb.w; } };
struct BrEpi { const bf16_t* G; bf16_t* MG; int row0, col0;
    __device__ __forceinline__ void operator()(int r, int c, f32x4& v) const { f32x4 sb; load4bf(G + (size_t)(row0 + r) * 4096 + 2048 + col0 + c, sb);
        u32x2 w; w.x = pk2(v.x * sb.x, v.y * sb.y); w.y = pk2(v.z * sb.z, v.w * sb.w); *(u32x2*)(MG + (size_t)(row0 + r) * ND + col0 + c) = w; } };
__device__ __forceinline__ void phase_branch_naive(const Params& p, LAS unsigned char* lds, const Ctx& cx) {
    constexpr int NTN = ND / 64, NT = (NM / 64) * NTN;
    for (int t = blockIdx.x; t < NT; t += gridDim.x) {
        const int tm = t / NTN, tn = t % NTN;
        BrA af{(const bf16_t*)(p.ws + WS_OA), (const bf16_t*)(p.ws + WS_OB), tm * 64}; BrB bf{(const bf16_t*)(p.ws + WS_WAT), (const bf16_t*)(p.ws + WS_WBT), tn * 64};
        BrMid mf{(const bf16_t*)(p.ws + WS_G), tm * 64, tn * 64}; BrEpi ef{(const bf16_t*)(p.ws + WS_G), (bf16_t*)(p.ws + WS_MERGED), tm * 64, tn * 64};
        ngemm_tile(lds, 2048, 1024, af, bf, mf, ef, cx.tid);
    }
}
struct OutB { const bf16_t* W; int col0; __device__ __forceinline__ const bf16_t* operator()(int n, int k0) const { return W + (size_t)(col0 + n) * ND + k0; } };
struct OutEpi { const float* x; const float* mod; float* xmid; int row0, col0;
    __device__ __forceinline__ void operator()(int r, int c, f32x4& v) const { const int row = row0 + r, col = col0 + c, b = row / NS;
        const f32x4 xv = *(const f32x4*)(x + (size_t)row * ND + col), gt = *(const f32x4*)(mod + (size_t)b * 12288 + 4096 + col);
        *(f32x4*)(xmid + (size_t)row * ND + col) = xv + gt * v; } };
__device__ __forceinline__ void phase_out_naive(const Params& p, LAS unsigned char* lds, const Ctx& cx) {
    constexpr int NTN = ND / 64, NT = (NM / 64) * NTN;
    for (int t = blockIdx.x; t < NT; t += gridDim.x) {
        const int tm = t / NTN, tn = t % NTN;
        InA af{(const bf16_t*)(p.ws + WS_MERGED), tm * 64}; OutB bf{(const bf16_t*)(p.ws + WS_WOUTT), tn * 64};
        OutEpi ef{p.x, (const float*)(p.ws + WS_MOD), (float*)(p.ws + WS_XMID), tm * 64, tn * 64};
        ngemm_tile(lds, ND, -1, af, bf, NoMid(), ef, cx.tid);
    }
}


namespace pg8 {
typedef short bf16x8 __attribute__((ext_vector_type(8)));
constexpr int BM = 256, BK = 64, HALF = 128, HTB = HALF * BK * 2, STAGE_BYTES = 8 * HTB, NXCD = 8, WGM = 8;
__host__ __device__ __forceinline__ int lds_byte(int r, int c) { const int st = (r >> 4) * 2 + (c >> 5), rr = r & 15, cc = c & 31, ob = rr * 64 + cc * 2; return st * 1024 + (ob ^ (((ob >> 9) & 1) << 5)); }
__host__ __device__ __forceinline__ void stage_rc(int b, int& R, int& C) { const int st = b / 1024, sb = b % 1024, swz = sb ^ (((sb >> 9) & 1) << 5); R = (st >> 1) * 16 + swz / 64; C = (st & 1) * 32 + (swz % 64) / 2; }
__host__ __device__ __forceinline__ int perm32(int rho) { const int n = rho >> 4, i = rho & 15; return 8 * (i >> 2) + 4 * n + (i & 3); }
__device__ __forceinline__ unsigned cvt_pk_bf16(float lo, float hi) { unsigned r; asm volatile("v_cvt_pk_bf16_f32 %0, %1, %2" : "=v"(r) : "v"(lo), "v"(hi)); return r; }

struct Unit { int pm, pn, e, a, b; };

struct GridOrder {
    int nM, nN, nwg, G, c;
    __device__ __forceinline__ void init(int nM_, int nN_, int G_, int c_) { nM = nM_; nN = nN_; nwg = nM * nN; G = G_; c = c_; }
    __device__ __forceinline__ bool tile(int i, int& pm, int& pn) const {
        const long L = (long)i * G + c; if (L >= nwg) return false;
        int wgid = (int)L; { const int q = nwg / NXCD, r = nwg % NXCD, xcd = wgid % NXCD, off = wgid / NXCD; wgid = (xcd < r ? xcd * (q + 1) : r * (q + 1) + (xcd - r) * q) + off; }
        const int nig = WGM * nN, gid = wgid / nig, fm = gid * WGM, gsz = (nM - fm) < WGM ? (nM - fm) : WGM;
        pm = fm + ((wgid % nig) % gsz); pn = (wgid % nig) / gsz; return true;
    }
};

template <class Epi, class Sched, bool ALIGN_EPI>
__device__ __forceinline__ void gemm_phase(LAS unsigned char* lds, const int K, const Sched& S, const Epi& E) {
    int tid_ = threadIdx.x; asm volatile("" : "+v"(tid_));
    const int tid = tid_, wid = __builtin_amdgcn_readfirstlane(tid >> 6), lane = tid & 63, wr = wid >> 2, wc = wid & 3, fr = lane & 15, fq = lane >> 4;
    const int nt = K / BK;
    int sR[2], sC[2]; unsigned voffB[2];
#pragma unroll
    for (int i = 0; i < 2; ++i) { int R, C; stage_rc(tid * 16 + i * 8192, R, C); sR[i] = R; sC[i] = C; const int Rb = Epi::PERM ? ((R & ~31) + perm32(R & 31)) : R; voffB[i] = (unsigned)(Rb * K + C) * 2u; }
    const size_t kstep = (size_t)(BK * 2);
    const size_t hstep = (size_t)HALF * K * 2;
    const unsigned ldsw = (unsigned)wid * 1024u;
    const int aoff = lds_byte(wr * 64 + fr, fq * 8), boff = lds_byte(wc * 32 + fr, fq * 8);
#define PG8_SA(b, h) (((b) * 2 + (h)) * HTB)
#define PG8_SB(b, h) ((4 + (b) * 2 + (h)) * HTB)
#define PG8_STAGE(bufoff, gbase, voff) do { _Pragma("unroll") for (int _i = 0; _i < 2; ++_i) \
        __builtin_amdgcn_global_load_lds((const unsigned*)((const char*)(gbase) + (voff)[_i]), (LAS unsigned*)(lds + (bufoff) + ldsw + _i * 8192), 16, 0, 0); } while (0)
#define PG8_LDA(dst, b, h) do { _Pragma("unroll") for (int m = 0; m < 4; ++m) _Pragma("unroll") for (int k = 0; k < 2; ++k) dst[m][k] = *(const LAS bf16x8*)(lds + PG8_SA(b, h) + aoff + m * 2048 + k * 1024); } while (0)
#define PG8_LDB(dst, b, h) do { _Pragma("unroll") for (int n = 0; n < 2; ++n) _Pragma("unroll") for (int k = 0; k < 2; ++k) dst[n][k] = *(const LAS bf16x8*)(lds + PG8_SB(b, h) + boff + n * 2048 + k * 1024); } while (0)
#define PG8_MMA(ai, bj, At, Bt) do { __builtin_amdgcn_s_setprio(1); _Pragma("unroll") for (int m = 0; m < 4; ++m) _Pragma("unroll") for (int n = 0; n < 2; ++n) _Pragma("unroll") for (int k = 0; k < 2; ++k) \
        acc[ai][bj][m][n] = __builtin_amdgcn_mfma_f32_16x16x32_bf16(Bt[n][k], At[m][k], acc[ai][bj][m][n], 0, 0, 0); __builtin_amdgcn_s_setprio(0); } while (0)
#define PG8_WAIT_V(n) asm volatile("s_waitcnt vmcnt(" #n ")" ::: "memory")
#define PG8_WAIT_L(n) asm volatile("s_waitcnt lgkmcnt(" #n ")" ::: "memory")
#define PG8_BAR __builtin_amdgcn_s_barrier()
#define PG8_SCHED __builtin_amdgcn_sched_barrier(0)
    Unit cur, nxt; int ui = 0;
    if (!S.next(0, cur)) return;
    f32x4 acc[2][2][4][2];
#pragma unroll
    for (int a = 0; a < 2; ++a)
#pragma unroll
        for (int b = 0; b < 2; ++b)
#pragma unroll
            for (int m = 0; m < 4; ++m)
#pragma unroll
                for (int n = 0; n < 2; ++n) acc[a][b][m][n] = (f32x4){0.f, 0.f, 0.f, 0.f};
    bf16x8 At[4][2], B0[2][2], B1[2][2];
    const char* cA; const char* cB; S.ptrs(cur, cA, cB);
    unsigned voffA[2][2], voffX[2][2];
    S.voff(cur, sR, sC, voffA);
#pragma unroll
    for (int h = 0; h < 2; ++h)
#pragma unroll
        for (int i = 0; i < 2; ++i) voffX[h][i] = voffA[h][i];
    PG8_STAGE(PG8_SB(0, 0), cB, voffB); PG8_STAGE(PG8_SB(0, 1), cB + hstep, voffB); PG8_STAGE(PG8_SA(0, 0), cA, voffA[0]); PG8_STAGE(PG8_SA(0, 1), cA, voffA[1]);
    if (wr == 1) PG8_BAR;
    PG8_WAIT_V(2); PG8_BAR;
    PG8_STAGE(PG8_SB(1, 0), cB + kstep, voffB); PG8_STAGE(PG8_SA(1, 0), cA + kstep, voffA[0]); PG8_STAGE(PG8_SB(1, 1), cB + hstep + kstep, voffB);
    PG8_WAIT_V(6); PG8_BAR;
    for (;;) {
        const bool has_next = S.next(ui + 1, nxt);
        const char* nA = cA; const char* nB = cB; if (has_next) S.ptrs(nxt, nA, nB);
        for (int t = 0; t < nt; t += 2) {
            const bool last = (t == nt - 2);
            const char* a1 = cA + (size_t)(t + 1) * kstep;
            const char* a2 = last ? nA : cA + (size_t)(t + 2) * kstep; const char* b2 = last ? nB : cB + (size_t)(t + 2) * kstep;
            const char* a3 = a2 + kstep; const char* b3 = b2 + kstep;
            if (Sched::GATHER) { if (last && has_next) S.voff(nxt, sR, sC, voffX); }
            PG8_LDB(B0, 0, 0); PG8_LDB(B1, 0, 1); PG8_SCHED; PG8_LDA(At, 0, 0); PG8_STAGE(PG8_SA(1, 1), a1, voffA[1]);
            PG8_WAIT_V(8); PG8_WAIT_L(0); PG8_BAR; PG8_MMA(0, 0, At, B0); PG8_MMA(0, 1, At, B1); PG8_BAR; PG8_SCHED;
            PG8_LDA(At, 0, 1); PG8_STAGE(PG8_SB(0, 0), b2, voffB); PG8_STAGE(PG8_SB(0, 1), b2 + hstep, voffB); PG8_STAGE(PG8_SA(0, 0), a2, voffX[0]);
            PG8_WAIT_V(8); PG8_WAIT_L(0); PG8_BAR; PG8_MMA(1, 0, At, B0); PG8_MMA(1, 1, At, B1); PG8_BAR; PG8_SCHED;
            PG8_LDB(B0, 1, 0); PG8_LDB(B1, 1, 1); PG8_SCHED; PG8_LDA(At, 1, 0); PG8_STAGE(PG8_SA(0, 1), a2, voffX[1]);
            PG8_WAIT_V(8); PG8_WAIT_L(0); PG8_BAR; PG8_MMA(0, 0, At, B0); PG8_MMA(0, 1, At, B1); PG8_BAR; PG8_SCHED;
            PG8_LDA(At, 1, 1); PG8_STAGE(PG8_SB(1, 0), b3, voffB); PG8_STAGE(PG8_SB(1, 1), b3 + hstep, voffB); PG8_STAGE(PG8_SA(1, 0), a3, voffX[0]);
            PG8_WAIT_V(8); PG8_WAIT_L(0); PG8_BAR; PG8_MMA(1, 0, At, B0); PG8_MMA(1, 1, At, B1); PG8_BAR; PG8_SCHED;
        }
        if constexpr (ALIGN_EPI) { if (wr == 0) PG8_BAR; }
        E(acc, cur, wr, wc, fr, fq);
        if (!has_next) break;
        if (!E.keep(cur)) {
#pragma unroll
            for (int a = 0; a < 2; ++a)
#pragma unroll
                for (int b = 0; b < 2; ++b)
#pragma unroll
                    for (int m = 0; m < 4; ++m)
#pragma unroll
                        for (int n = 0; n < 2; ++n) acc[a][b][m][n] = (f32x4){0.f, 0.f, 0.f, 0.f};
        }
        cur = nxt; cA = nA; cB = nB; ++ui;
        if (Sched::GATHER) {
#pragma unroll
            for (int h = 0; h < 2; ++h)
#pragma unroll
                for (int i = 0; i < 2; ++i) voffA[h][i] = voffX[h][i];
        }
        if constexpr (ALIGN_EPI) { if (wr == 1) PG8_BAR; }
    }
    PG8_WAIT_V(0);
    if constexpr (!ALIGN_EPI) { if (wr == 0) PG8_BAR; }
    PG8_BAR;
#undef PG8_SA
#undef PG8_SB
#undef PG8_STAGE
#undef PG8_LDA
#undef PG8_LDB
#undef PG8_MMA
#undef PG8_WAIT_V
#undef PG8_WAIT_L
#undef PG8_BAR
#undef PG8_SCHED
}

struct SchedGrid {
    static constexpr bool GATHER = false;
    GridOrder go; const char* A; const char* Bt; int K;
    __device__ __forceinline__ bool next(int i, Unit& u) const { u.e = 0; u.a = 0; u.b = 0; return go.tile(i, u.pm, u.pn); }
    __device__ __forceinline__ void ptrs(const Unit& u, const char*& cA, const char*& cB) const { cA = A + (size_t)u.pm * 256 * K * 2; cB = Bt + (size_t)u.pn * 256 * K * 2; }
    __device__ __forceinline__ void voff(const Unit&, const int (&sR)[2], const int (&sC)[2], unsigned (&vo)[2][2]) const {
#pragma unroll
        for (int h = 0; h < 2; ++h)
#pragma unroll
            for (int i = 0; i < 2; ++i) vo[h][i] = (unsigned)((sR[i] + 128 * h) * K + sC[i]) * 2u;
    }
};
struct SchedBranch {
    static constexpr bool GATHER = false;
    GridOrder go; const char* A0; const char* A1; const char* B0; const char* B1;
    __device__ __forceinline__ bool next(int i, Unit& u) const { u.e = 0; u.b = 0; u.a = i & 1; return go.tile(i >> 1, u.pm, u.pn); }
    __device__ __forceinline__ void ptrs(const Unit& u, const char*& cA, const char*& cB) const { cA = (u.a ? A1 : A0) + (size_t)u.pm * 256 * 1024 * 2; cB = (u.a ? B1 : B0) + (size_t)u.pn * 256 * 1024 * 2; }
    __device__ __forceinline__ void voff(const Unit&, const int (&sR)[2], const int (&sC)[2], unsigned (&vo)[2][2]) const {
#pragma unroll
        for (int h = 0; h < 2; ++h)
#pragma unroll
            for (int i = 0; i < 2; ++i) vo[h][i] = (unsigned)((sR[i] + 128 * h) * 1024 + sC[i]) * 2u;
    }
};
template <bool FIRST> struct SchedMoe {
    static constexpr bool GATHER = FIRST;
    const LAS int* tb; int xcls, rank, nranks; const char* A; const char* W; const int* list;
    __device__ __forceinline__ bool next(int i, Unit& u) const {
        const int L = i * nranks + rank; if (L >= tb[24]) return false;
        int q = 0; while (tb[16 + q + 1] <= L) ++q;
        const int loc = L - tb[16 + q]; u.pm = loc >> 3; u.pn = loc & 7; u.e = xcls + 8 * q; u.a = tb[q]; u.b = tb[8 + q]; return true;
    }
    __device__ __forceinline__ void ptrs(const Unit& u, const char*& cA, const char*& cB) const {
        if (FIRST) { cA = A; cB = W + ((size_t)u.e * 2048 + (size_t)u.pn * 256) * ND * 2; }
        else { cA = A + (size_t)(u.b + u.pm * 256) * DE * 2; cB = W + ((size_t)u.e * 2048 + (size_t)u.pn * 256) * DE * 2; }
    }
    __device__ __forceinline__ void voff(const Unit& u, const int (&sR)[2], const int (&sC)[2], unsigned (&vo)[2][2]) const {
#pragma unroll
        for (int h = 0; h < 2; ++h)
#pragma unroll
            for (int i = 0; i < 2; ++i) {
                if (FIRST) { const int lr = u.pm * 256 + 128 * h + sR[i]; const int tok = (lr < u.a) ? list[(size_t)u.e * ECAP + lr] : 0; vo[h][i] = (unsigned)(tok * ND + sC[i]) * 2u; }
                else vo[h][i] = (unsigned)((sR[i] + 128 * h) * DE + sC[i]) * 2u;
            }
    }
};

__device__ __forceinline__ float sigm(float v) { return __builtin_amdgcn_rcpf(1.f + __builtin_amdgcn_exp2f(-LOG2E * v)); }
__device__ __forceinline__ void unpack8(const u32x4 w, float (&f)[8]) { f[0] = bf2f(w.x & 0xffffu); f[1] = bf2f(w.x >> 16); f[2] = bf2f(w.y & 0xffffu); f[3] = bf2f(w.y >> 16); f[4] = bf2f(w.z & 0xffffu); f[5] = bf2f(w.z >> 16); f[6] = bf2f(w.w & 0xffffu); f[7] = bf2f(w.w >> 16); }

struct EpiIn {
    static constexpr bool PERM = true;
    unsigned char* ws;
    __device__ __forceinline__ bool keep(const Unit&) const { return false; }
    __device__ __forceinline__ void operator()(f32x4 (&acc)[2][2][4][2], const Unit& u, int wr, int wc, int fr, int fq) const {
        const int rowb = u.pm * BM + wr * 64 + fr, lc = wc * 32 + 8 * fq, i0 = (lc & 63) >> 1;
        const float* cosT = (const float*)(ws + WS_COS); const float* sinT = (const float*)(ws + WS_SIN);
        bf16_t* dst[2]; int ldd[2], kind[2];
#pragma unroll
        for (int bj = 0; bj < 2; ++bj) {
            const int cb = u.pn * BM + bj * HALF;
            if (cb < C_KA) { dst[bj] = (bf16_t*)(ws + WS_QA) + cb; ldd[bj] = 1024; kind[bj] = 2; }
            else if (cb < C_VA) { dst[bj] = (bf16_t*)(ws + WS_KA) + (cb - C_KA); ldd[bj] = 128; kind[bj] = 1; }
            else if (cb < C_QD) { dst[bj] = (bf16_t*)(ws + WS_VA) + (cb - C_VA); ldd[bj] = 128; kind[bj] = 0; }
            else if (cb < C_KD) { dst[bj] = (bf16_t*)(ws + WS_QD) + (cb - C_QD); ldd[bj] = 1024; kind[bj] = 2; }
            else if (cb < C_VD) { dst[bj] = (bf16_t*)(ws + WS_KD) + (cb - C_KD); ldd[bj] = 1024; kind[bj] = 1; }
            else if (cb < C_GA) { dst[bj] = (bf16_t*)(ws + WS_VD) + (cb - C_VD); ldd[bj] = 1024; kind[bj] = 0; }
            else { dst[bj] = (bf16_t*)(ws + WS_G) + (cb - C_GA); ldd[bj] = 4096; kind[bj] = 3; }
            dst[bj] += lc;
        }
        const bool any_rope = (kind[0] == 1 || kind[0] == 2 || kind[1] == 1 || kind[1] == 2);
#pragma unroll
        for (int ai = 0; ai < 2; ++ai) {
            f32x4 cs[4], sn[4];
#pragma unroll
            for (int m = 0; m < 4; ++m) { cs[m] = (f32x4){1.f, 1.f, 1.f, 1.f}; sn[m] = (f32x4){0.f, 0.f, 0.f, 0.f}; }
            if (any_rope) {
#pragma unroll
                for (int m = 0; m < 4; ++m) { const size_t ro = (size_t)(rowb + ai * HALF + m * 16) * 32 + i0; cs[m] = *(const f32x4*)(cosT + ro); sn[m] = *(const f32x4*)(sinT + ro); }
            }
            __builtin_amdgcn_sched_barrier(0);
#pragma unroll
            for (int m = 0; m < 4; ++m) {
                const int row = rowb + ai * HALF + m * 16;
#pragma unroll
                for (int bj = 0; bj < 2; ++bj) {
                    const f32x4 v0 = acc[ai][bj][m][0], v1 = acc[ai][bj][m][1];
                    float o[8];
                    if (kind[bj] == 1 || kind[bj] == 2) {
                        const f32x4 c = cs[m], s = sn[m];
                        o[0] = v0[0] * c[0] - v0[1] * s[0]; o[1] = v0[1] * c[0] + v0[0] * s[0]; o[2] = v0[2] * c[1] - v0[3] * s[1]; o[3] = v0[3] * c[1] + v0[2] * s[1];
                        o[4] = v1[0] * c[2] - v1[1] * s[2]; o[5] = v1[1] * c[2] + v1[0] * s[2]; o[6] = v1[2] * c[3] - v1[3] * s[3]; o[7] = v1[3] * c[3] + v1[2] * s[3];
                        if (kind[bj] == 2) {
#pragma unroll
                            for (int j = 0; j < 8; ++j) o[j] *= C2;
                        }
                    } else if (kind[bj] == 3) {
#pragma unroll
                        for (int j = 0; j < 4; ++j) { o[j] = sigm(v0[j]); o[4 + j] = sigm(v1[j]); }
                    } else {
#pragma unroll
                        for (int j = 0; j < 4; ++j) { o[j] = v0[j]; o[4 + j] = v1[j]; }
                    }
                    u32x4 w; w.x = cvt_pk_bf16(o[0], o[1]); w.y = cvt_pk_bf16(o[2], o[3]); w.z = cvt_pk_bf16(o[4], o[5]); w.w = cvt_pk_bf16(o[6], o[7]);
                    *(u32x4*)(dst[bj] + (size_t)row * ldd[bj]) = w;
                }
            }
            __builtin_amdgcn_sched_barrier(0);
        }
    }
};
struct EpiBranch {
    static constexpr bool PERM = true;
    const bf16_t* G; bf16_t* MG;
    __device__ __forceinline__ bool keep(const Unit& u) const { return u.a == 0; }
    __device__ __forceinline__ void operator()(f32x4 (&acc)[2][2][4][2], const Unit& u, int wr, int wc, int fr, int fq) const {
        const int rowb = u.pm * BM + wr * 64 + fr, colb = u.pn * BM + wc * 32 + 8 * fq;
#pragma unroll
        for (int ai = 0; ai < 2; ++ai)
#pragma unroll
            for (int mp = 0; mp < 2; ++mp) {
                u32x4 gb_[2][2], ga_[2][2];
#pragma unroll
                for (int mm = 0; mm < 2; ++mm)
#pragma unroll
                    for (int bj = 0; bj < 2; ++bj) {
                        const bf16_t* gp = G + (size_t)(rowb + ai * HALF + (2 * mp + mm) * 16) * 4096 + colb + bj * HALF;
                        gb_[mm][bj] = *(const u32x4*)(gp + 2048);
                        ga_[mm][bj] = (u.a == 0) ? *(const u32x4*)gp : (u32x4){0u, 0u, 0u, 0u};
                    }
                __builtin_amdgcn_sched_barrier(0);
#pragma unroll
                for (int mm = 0; mm < 2; ++mm) {
                    const int m = 2 * mp + mm, row = rowb + ai * HALF + m * 16;
#pragma unroll
                    for (int bj = 0; bj < 2; ++bj) {
                        float sb[8]; unpack8(gb_[mm][bj], sb);
                        if (u.a == 0) {
                            float sa[8]; unpack8(ga_[mm][bj], sa);
#pragma unroll
                            for (int j = 0; j < 4; ++j) { acc[ai][bj][m][0][j] *= sa[j] * __builtin_amdgcn_rcpf(sb[j]); acc[ai][bj][m][1][j] *= sa[4 + j] * __builtin_amdgcn_rcpf(sb[4 + j]); }
                        } else {
                            const f32x4 v0 = acc[ai][bj][m][0], v1 = acc[ai][bj][m][1];
                            u32x4 w; w.x = cvt_pk_bf16(v0[0] * sb[0], v0[1] * sb[1]); w.y = cvt_pk_bf16(v0[2] * sb[2], v0[3] * sb[3]); w.z = cvt_pk_bf16(v1[0] * sb[4], v1[1] * sb[5]); w.w = cvt_pk_bf16(v1[2] * sb[6], v1[3] * sb[7]);
                            *(u32x4*)(MG + (size_t)row * ND + colb + bj * HALF) = w;
                        }
                    }
                }
                __builtin_amdgcn_sched_barrier(0);
            }
    }
};
struct EpiOut {
    static constexpr bool PERM = false;
    const float* x; const float* mod; float* xmid; float* ssq;
    __device__ __forceinline__ bool keep(const Unit&) const { return false; }
    __device__ __forceinline__ void operator()(f32x4 (&acc)[2][2][4][2], const Unit& u, int wr, int wc, int fr, int fq) const {
        const int rowb = u.pm * BM + wr * 64 + fr, colb = u.pn * BM + wc * 32 + 4 * fq, b = (u.pm * BM) / NS;
        f32x4 gt[2][2];
#pragma unroll
        for (int bj = 0; bj < 2; ++bj)
#pragma unroll
            for (int n = 0; n < 2; ++n) gt[bj][n] = *(const f32x4*)(mod + (size_t)b * 12288 + 4096 + colb + bj * HALF + n * 16);
#pragma unroll
        for (int ai = 0; ai < 2; ++ai)
#pragma unroll
            for (int mp = 0; mp < 2; ++mp) {
                float sq[2] = {0.f, 0.f};
                f32x4 xv[2][2][2];
#pragma unroll
                for (int mm = 0; mm < 2; ++mm)
#pragma unroll
                    for (int bj = 0; bj < 2; ++bj)
#pragma unroll
                        for (int n = 0; n < 2; ++n) xv[mm][bj][n] = *(const f32x4*)(x + (size_t)(rowb + ai * HALF + (2 * mp + mm) * 16) * ND + colb + bj * HALF + n * 16);
                __builtin_amdgcn_sched_barrier(0);
#pragma unroll
                for (int mm = 0; mm < 2; ++mm)
#pragma unroll
                    for (int bj = 0; bj < 2; ++bj)
#pragma unroll
                        for (int n = 0; n < 2; ++n) { const f32x4 o = xv[mm][bj][n] + gt[bj][n] * acc[ai][bj][2 * mp + mm][n];
                            *(f32x4*)(xmid + (size_t)(rowb + ai * HALF + (2 * mp + mm) * 16) * ND + colb + bj * HALF + n * 16) = o; sq[mm] += (o[0] * o[0] + o[1] * o[1]) + (o[2] * o[2] + o[3] * o[3]); }
#pragma unroll
                for (int mm = 0; mm < 2; ++mm) { float s = sq[mm]; s += __shfl_xor(s, 16); s += __shfl_xor(s, 32);
                    if (fq == 0) ssq[(size_t)(rowb + ai * HALF + (2 * mp + mm) * 16) * 32 + 4 * u.pn + wc] = s; }
                __builtin_amdgcn_sched_barrier(0);
            }
    }
};
struct EpiMoe1 {
    static constexpr bool PERM = true;
    bf16_t* ACT;
    __device__ __forceinline__ bool keep(const Unit&) const { return false; }
    __device__ __forceinline__ void operator()(f32x4 (&acc)[2][2][4][2], const Unit& u, int wr, int wc, int fr, int fq) const {
        const int rowb = u.b + u.pm * BM + wr * 64 + fr, j0 = u.pn * HALF + wc * 32 + 8 * fq;
#pragma unroll
        for (int ai = 0; ai < 2; ++ai)
#pragma unroll
            for (int m = 0; m < 4; ++m) {
                float o[8];
#pragma unroll
                for (int n = 0; n < 2; ++n)
#pragma unroll
                    for (int j = 0; j < 4; ++j) { const float g = acc[ai][0][m][n][j], up = acc[ai][1][m][n][j]; o[4 * n + j] = g * sigm(g) * up; }
                u32x4 w; w.x = cvt_pk_bf16(o[0], o[1]); w.y = cvt_pk_bf16(o[2], o[3]); w.z = cvt_pk_bf16(o[4], o[5]); w.w = cvt_pk_bf16(o[6], o[7]);
                *(u32x4*)(ACT + (size_t)(rowb + ai * HALF + m * 16) * DE + j0) = w;
            }
    }
};
struct EpiMoe2 {
    static constexpr bool PERM = true;
    bf16_t* Y; const float* slw;
    __device__ __forceinline__ bool keep(const Unit&) const { return false; }
    __device__ __forceinline__ void operator()(f32x4 (&acc)[2][2][4][2], const Unit& u, int wr, int wc, int fr, int fq) const {
        const int lrb = u.pm * BM + wr * 64 + fr, colb = u.pn * BM + wc * 32 + 8 * fq;
#pragma unroll
        for (int ai = 0; ai < 2; ++ai)
#pragma unroll
            for (int m = 0; m < 4; ++m) {
                const int lr = lrb + ai * HALF + m * 16;
                const float w8 = (lr < u.a) ? slw[(size_t)u.e * ECAP + lr] : 0.f;
#pragma unroll
                for (int bj = 0; bj < 2; ++bj) {
                    const f32x4 v0 = acc[ai][bj][m][0] * w8, v1 = acc[ai][bj][m][1] * w8;
                    u32x4 w; w.x = cvt_pk_bf16(v0[0], v0[1]); w.y = cvt_pk_bf16(v0[2], v0[3]); w.z = cvt_pk_bf16(v1[0], v1[1]); w.w = cvt_pk_bf16(v1[2], v1[3]);
                    *(u32x4*)(Y + (size_t)(u.b + lr) * ND + colb + bj * HALF) = w;
                }
            }
    }
};
}

constexpr int RING_BYTES = 131072, TBL_OFF = 159744 + 1024;
__device__ __forceinline__ void phase_inproj_fast(const Params& p, LAS unsigned char* lds) {
    pg8::SchedGrid S; S.go.init(NM / 256, IN_COLS / 256, gridDim.x, blockIdx.x); S.A = (const char*)(p.ws + WS_H); S.Bt = (const char*)(p.ws + WS_WINT); S.K = ND;
    pg8::EpiIn E{p.ws};
    pg8::gemm_phase<pg8::EpiIn, pg8::SchedGrid, true>(lds, ND, S, E);
#if LATE_COPIES
    {
        const int nun = (NM / 256) * (IN_COLS / 256), rem = nun % (int)gridDim.x, first = rem, nhelp = (int)gridDim.x - rem;
        if ((int)blockIdx.x >= first) late_weight_copies(p, lds, make_ctx(), first, nhelp);
    }
#endif
}
__device__ __forceinline__ void phase_branch_fast(const Params& p, LAS unsigned char* lds) {
    pg8::SchedBranch S; S.go.init(NM / 256, ND / 256, gridDim.x, blockIdx.x);
    S.A0 = (const char*)(p.ws + WS_OA); S.A1 = (const char*)(p.ws + WS_OB); S.B0 = (const char*)(p.ws + WS_WAT); S.B1 = (const char*)(p.ws + WS_WBT);
    pg8::EpiBranch E{(const bf16_t*)(p.ws + WS_G), (bf16_t*)(p.ws + WS_MERGED)};
    pg8::gemm_phase<pg8::EpiBranch, pg8::SchedBranch, true>(lds, 1024, S, E);
}
__device__ __forceinline__ void phase_out_fast(const Params& p, LAS unsigned char* lds) {
    pg8::SchedGrid S; S.go.init(NM / 256, ND / 256, gridDim.x, blockIdx.x); S.A = (const char*)(p.ws + WS_MERGED); S.Bt = (const char*)(p.ws + WS_WOUTT); S.K = ND;
    pg8::EpiOut E{p.x, (const float*)(p.ws + WS_MOD), (float*)(p.ws + WS_XMID), (float*)(p.ws + WS_SSQ)};
    pg8::gemm_phase<pg8::EpiOut, pg8::SchedGrid, true>(lds, ND, S, E);
}
__device__ __forceinline__ void moe_tables(const Params& p, LAS int* tb, int tid) {
    __syncthreads();
    if (tid == 0) {
        const unsigned* cnt = (const unsigned*)(p.ws + WS_CTL) + CW_CNT;
        const int x = blockIdx.x & 7; int ps = 0, up = 0;
        for (int e = 0; e < NE; ++e) { const int n = (int)__hip_atomic_load(cnt + e, __ATOMIC_RELAXED, __HIP_MEMORY_SCOPE_AGENT);
            if ((e & 7) == x) { const int q = e >> 3; tb[q] = n; tb[8 + q] = ps; tb[16 + q] = up; up += ((n + 255) / 256) * 8; }
            ps += (n + PADR - 1) / PADR * PADR; }
        tb[24] = up;
    }
    __syncthreads();
}
__device__ __forceinline__ void phase_moe1_fast(const Params& p, LAS unsigned char* lds, const Ctx& cx) {
    LAS int* tb = (LAS int*)(lds + TBL_OFF);
    moe_tables(p, tb, cx.tid);
    pg8::SchedMoe<true> S{tb, (int)(blockIdx.x & 7), (int)(blockIdx.x >> 3), (int)(gridDim.x >> 3), (const char*)(p.ws + WS_H), (const char*)(p.ws + WS_WGUT), (const int*)(p.ws + WS_LIST)};
    pg8::EpiMoe1 E{(bf16_t*)(p.ws + WS_ACT)};
    pg8::gemm_phase<pg8::EpiMoe1, pg8::SchedMoe<true>, true>(lds, ND, S, E);
}
__device__ __forceinline__ void phase_moe2_fast(const Params& p, LAS unsigned char* lds, const Ctx& cx) {
    LAS int* tb = (LAS int*)(lds + TBL_OFF);
    moe_tables(p, tb, cx.tid);
    pg8::SchedMoe<false> S{tb, (int)(blockIdx.x & 7), (int)(blockIdx.x >> 3), (int)(gridDim.x >> 3), (const char*)(p.ws + WS_ACT), (const char*)(p.ws + WS_WDNT), nullptr};
    pg8::EpiMoe2 E{(bf16_t*)(p.ws + WS_Y), (const float*)(p.ws + WS_SLW)};
    pg8::gemm_phase<pg8::EpiMoe2, pg8::SchedMoe<false>, true>(lds, DE, S, E);
}

__device__ __forceinline__ void phase_router(const Params& p, LAS unsigned char* lds, const Ctx& cx) {
    const float* xmid = (const float*)(p.ws + WS_XMID); const float* mod = (const float*)(p.ws + WS_MOD);
    bf16_t* H2 = (bf16_t*)(p.ws + WS_H);
    unsigned* cnt = (unsigned*)(p.ws + WS_CTL) + CW_CNT;
    int* toke = (int*)(p.ws + WS_TOKE); int* tokr = (int*)(p.ws + WS_TOKR); int* list = (int*)(p.ws + WS_LIST); float* slw = (float*)(p.ws + WS_SLW);
    LAS float* hrow = (LAS float*)(lds + cx.wave * 8192);
    for (int row = cx.gw; row < NM; row += cx.ngw) {
        const int b = row / NS;
        const f32x4* xr = (const f32x4*)(xmid + (size_t)row * ND) + cx.lane;
        f32x4 v[8]; float ss = 0.f;
#pragma unroll
        for (int j = 0; j < 8; ++j) { v[j] = xr[64 * j]; ss += (v[j].x * v[j].x + v[j].y * v[j].y) + (v[j].z * v[j].z + v[j].w * v[j].w); }
        const float rstd = 1.f / sqrtf(wave_sum(ss) * (1.f / ND) + RMS_EPS);
        u32x2* o8 = (u32x2*)(H2 + (size_t)row * ND) + cx.lane;
#pragma unroll
        for (int j = 0; j < 8; ++j) {
            const int col = 4 * cx.lane + 256 * j;
            const f32x4 g = *(const f32x4*)(p.g_ffn + col);
            const f32x4 sh = *(const f32x4*)(mod + (size_t)b * 12288 + 6144 + col), sc = *(const f32x4*)(mod + (size_t)b * 12288 + 8192 + col);
            const f32x4 y = v[j] * rstd * g * (sc + 1.f) + sh;
            u32x2 w; w.x = pk2(y.x, y.y); w.y = pk2(y.z, y.w); o8[64 * j] = w;
            *(LAS f32x4*)(hrow + col) = y;
        }
        LDS_WAIT(); asm volatile("" ::: "memory");
        float eacc = 0.f, gacc = 0.f;
        const float* wre = p.w_re + cx.lane; const float* wrg = p.w_rg + (cx.lane & 7);
#pragma unroll 2
        for (int k = 0; k < ND; k += 4) {
            const f32x4 hv = *(const LAS f32x4*)(hrow + k);
            eacc += hv.x * wre[(size_t)(k + 0) * 64]; eacc += hv.y * wre[(size_t)(k + 1) * 64]; eacc += hv.z * wre[(size_t)(k + 2) * 64]; eacc += hv.w * wre[(size_t)(k + 3) * 64];
            gacc += hv.x * wrg[(size_t)(k + 0) * 8]; gacc += hv.y * wrg[(size_t)(k + 1) * 8]; gacc += hv.z * wrg[(size_t)(k + 2) * 8]; gacc += hv.w * wrg[(size_t)(k + 3) * 8];
        }
        eacc += p.b_re[cx.lane]; gacc += p.b_rg[cx.lane & 7];
        float gl[8];
#pragma unroll
        for (int j = 0; j < 8; ++j) gl[j] = __shfl(gacc, j);
        int gsel = 0; float gmax = gl[0];
#pragma unroll
        for (int j = 1; j < 8; ++j) if (gl[j] > gmax) { gmax = gl[j]; gsel = j; }
        float gsum = 0.f;
#pragma unroll
        for (int j = 0; j < 8; ++j) gsum += expf(gl[j] - gmax);
        const float gweight = 1.f / gsum;
        float el[8];
#pragma unroll
        for (int j = 0; j < 8; ++j) el[j] = __shfl(eacc, gsel * 8 + j);
        int i0 = 0;
#pragma unroll
        for (int j = 1; j < 8; ++j) if (el[j] > el[i0]) i0 = j;
        int i1 = (i0 == 0) ? 1 : 0;
#pragma unroll
        for (int j = 0; j < 8; ++j) if (j != i0 && j != i1 && el[j] > el[i1]) i1 = j;
        const float t = expf(el[i1] - el[i0]);
        const float w0 = gweight / (1.f + t), w1 = gweight * t / (1.f + t);
        if (cx.lane == 0) {
            const int e0 = gsel * 8 + i0, e1 = gsel * 8 + i1;
            const unsigned r0 = atomicAdd(cnt + e0, 1u), r1 = atomicAdd(cnt + e1, 1u);
            toke[row * 2] = e0; toke[row * 2 + 1] = e1; tokr[row * 2] = (int)r0; tokr[row * 2 + 1] = (int)r1;
            list[(size_t)e0 * ECAP + r0] = row; list[(size_t)e1 * ECAP + r1] = row;
            slw[(size_t)e0 * ECAP + r0] = w0; slw[(size_t)e1 * ECAP + r1] = w1;
        }
        LDS_WAIT(); asm volatile("" ::: "memory");
    }
}


__device__ __forceinline__ void phase_router_fast(const Params& p, LAS unsigned char* lds, const Ctx& cx) {
    constexpr int TP = 516;
    LAS float* T = (LAS float*)lds;
    LAS float* LG = (LAS float*)(lds + 132096);
    const float* xmid = (const float*)(p.ws + WS_XMID); const float* mod = (const float*)(p.ws + WS_MOD); const float* wrt = (const float*)(p.ws + WS_WRT);
    bf16_t* H2 = (bf16_t*)(p.ws + WS_H);
    unsigned* cnt = (unsigned*)(p.ws + WS_CTL) + CW_CNT;
    int* toke = (int*)(p.ws + WS_TOKE); int* tokr = (int*)(p.ws + WS_TOKR); int* list = (int*)(p.ws + WS_LIST); float* slw = (float*)(p.ws + WS_SLW);
    const int w = cx.wave, lane = cx.lane, fr = lane & 15, kq = lane >> 4;
    for (int rb = blockIdx.x; rb < NM / 64; rb += gridDim.x) {
        const int row0 = rb * 64, b = row0 / NS;
        LAS float* RS = LG + 64 * 80;
        {
            const f32x4 v = *(const f32x4*)((const float*)(p.ws + WS_SSQ) + (size_t)(row0 + 8 * w + (lane >> 3)) * 32 + 4 * (lane & 7));
            float ss = (v.x + v.y) + (v.z + v.w);
            ss += __shfl_xor(ss, 1); ss += __shfl_xor(ss, 2); ss += __shfl_xor(ss, 4);
            if ((lane & 7) == 0) RS[8 * w + (lane >> 3)] = 1.f / sqrtf(ss * (1.f / ND) + RMS_EPS);
        }
        LDS_WAIT(); asm volatile("" ::: "memory");
        f32x4 acc[4][5];
#pragma unroll
        for (int m = 0; m < 4; ++m)
#pragma unroll
            for (int t = 0; t < 5; ++t) acc[m][t] = (f32x4){0.f, 0.f, 0.f, 0.f};
        for (int c = 0; c < 4; ++c) {
#pragma unroll
            for (int j = 0; j < 2; ++j) {
                const int col = 512 * c + 256 * j + 4 * lane;
                const f32x4 g = *(const f32x4*)(p.g_ffn + col);
                const f32x4 sh = *(const f32x4*)(mod + (size_t)b * 12288 + 6144 + col), sc = *(const f32x4*)(mod + (size_t)b * 12288 + 8192 + col);
                const f32x4 gs = g * (sc + 1.f);
#pragma unroll 4
                for (int rr = 0; rr < 8; ++rr) {
                    const int r = 8 * w + rr;
                    const f32x4 xv = *(const f32x4*)(xmid + (size_t)(row0 + r) * ND + col);
                    const f32x4 y = xv * RS[r] * gs + sh;
                    *(LAS f32x4*)(T + r * TP + 256 * j + 4 * lane) = y;
                    u32x2 o; o.x = pk2(y.x, y.y); o.y = pk2(y.z, y.w); *(u32x2*)(H2 + (size_t)(row0 + r) * ND + col) = o;
                }
            }
            __syncthreads();
            const LAS float* ta = T + fr * TP + 64 * w + 4 * kq;
            const float* wb = wrt + (size_t)fr * ND + 512 * c + 64 * w + 4 * kq;
#pragma unroll
            for (int s = 0; s < 4; ++s) {
                f32x4 b4[5];
#pragma unroll
                for (int t = 0; t < 5; ++t) b4[t] = *(const f32x4*)(wb + (size_t)(16 * t) * ND + 16 * s);
#pragma unroll
                for (int m = 0; m < 4; ++m) {
                    const f32x4 a4 = *(const LAS f32x4*)(ta + (16 * m) * TP + 16 * s);
#pragma unroll
                    for (int t = 0; t < 5; ++t) {
                        acc[m][t] = __builtin_amdgcn_mfma_f32_16x16x4f32(a4.x, b4[t].x, acc[m][t], 0, 0, 0);
                        acc[m][t] = __builtin_amdgcn_mfma_f32_16x16x4f32(a4.y, b4[t].y, acc[m][t], 0, 0, 0);
                        acc[m][t] = __builtin_amdgcn_mfma_f32_16x16x4f32(a4.z, b4[t].z, acc[m][t], 0, 0, 0);
                        acc[m][t] = __builtin_amdgcn_mfma_f32_16x16x4f32(a4.w, b4[t].w, acc[m][t], 0, 0, 0);
                    }
                }
            }
            __syncthreads();
        }
        LAS float* PB = T;
#pragma unroll
        for (int step = 4; step >= 1; step >>= 1) {
            if (w >= step && w < 2 * step) {
                LAS float* dstp = PB + (w - step) * (64 * 80);
#pragma unroll
                for (int m = 0; m < 4; ++m)
#pragma unroll
                    for (int t = 0; t < 5; ++t)
#pragma unroll
                        for (int r = 0; r < 4; ++r) dstp[(16 * m + 4 * kq + r) * 80 + 16 * t + fr] = acc[m][t][r];
            }
            __syncthreads();
            if (w < step) {
                const LAS float* srcp = PB + w * (64 * 80);
#pragma unroll
                for (int m = 0; m < 4; ++m)
#pragma unroll
                    for (int t = 0; t < 5; ++t)
#pragma unroll
                        for (int r = 0; r < 4; ++r) acc[m][t][r] += srcp[(16 * m + 4 * kq + r) * 80 + 16 * t + fr];
            }
            __syncthreads();
        }
        if (w == 0) {
#pragma unroll
            for (int t = 0; t < 5; ++t) { const int colj = 16 * t + fr; const float bias = (colj < 64) ? p.b_re[colj] : (colj < 72) ? p.b_rg[colj - 64] : 0.f;
#pragma unroll
                for (int m = 0; m < 4; ++m)
#pragma unroll
                    for (int r = 0; r < 4; ++r) LG[(16 * m + 4 * kq + r) * 80 + colj] = acc[m][t][r] + bias; }
        }
        __syncthreads();
        if (cx.tid < 64) {
            const LAS float* lg = LG + cx.tid * 80; const int row = row0 + cx.tid;
            int gsel = 0; float gmax = lg[64];
            for (int j = 1; j < 8; ++j) { const float v = lg[64 + j]; if (v > gmax) { gmax = v; gsel = j; } }
            float gsum = 0.f;
            for (int j = 0; j < 8; ++j) gsum += expf(lg[64 + j] - gmax);
            const float gweight = 1.f / gsum;
            const LAS float* el = lg + gsel * 8;
            int i0 = 0; float v0 = el[0];
            for (int j = 1; j < 8; ++j) { const float v = el[j]; if (v > v0) { v0 = v; i0 = j; } }
            int i1 = (i0 == 0) ? 1 : 0; float v1 = el[i1];
            for (int j = 0; j < 8; ++j) { const float v = el[j]; if (j != i0 && j != i1 && v > v1) { v1 = v; i1 = j; } }
            const float tt = expf(v1 - v0);
            const float w0 = gweight / (1.f + tt), w1 = gweight * tt / (1.f + tt);
            const int e0 = gsel * 8 + i0, e1 = gsel * 8 + i1;
            const unsigned r0 = atomicAdd(cnt + e0, 1u), r1 = atomicAdd(cnt + e1, 1u);
            toke[row * 2] = e0; toke[row * 2 + 1] = e1; tokr[row * 2] = (int)r0; tokr[row * 2 + 1] = (int)r1;
            list[(size_t)e0 * ECAP + r0] = row; list[(size_t)e1 * ECAP + r1] = row;
            slw[(size_t)e0 * ECAP + r0] = w0; slw[(size_t)e1 * ECAP + r1] = w1;
        }
        __syncthreads();
    }
}

__device__ __forceinline__ void expert_tables(const Params& p, LAS int* tb, int tid) {
    __syncthreads();
    if (tid < 64) {
        const unsigned* cnt = (const unsigned*)(p.ws + WS_CTL) + CW_CNT;
        const int n = (int)__hip_atomic_load(cnt + tid, __ATOMIC_RELAXED, __HIP_MEMORY_SCOPE_AGENT);
        const int pad = (n + PADR - 1) / PADR * PADR, t64 = (n + 63) / 64;
        int ps = pad, tp = t64;
#pragma unroll
        for (int o = 1; o < 64; o <<= 1) { const int a = __shfl_up(ps, o), b = __shfl_up(tp, o); if (tid >= o) { ps += a; tp += b; } }
        tb[tid] = n; tb[64 + tid] = ps - pad; tb[192 + tid] = tp - t64;
        if (tid == 63) { tb[64 + NE] = ps; tb[192 + NE] = tp; }
    }
    __syncthreads();
}

namespace moe {
typedef short bf16x8 __attribute__((ext_vector_type(8)));
typedef short v4i16_t __attribute__((ext_vector_type(4)));
constexpr int NBMAX = 3, A_SLOT = NBMAX * 8 * 2048, NAS = 2, B_OFF = NAS * A_SLOT, B_PITCH = 288, B_SLOT = 32 * B_PITCH, RING_END = B_OFF + 3 * B_SLOT;
constexpr int UROWS = NBMAX * 128;
__host__ __device__ constexpr int rho(int k) { return (k & 3) | (((k >> 3) & 1) << 2) | (((k >> 2) & 1) << 3) | (k & 16); }
#define MOE_WAITV(n) asm volatile("s_waitcnt vmcnt(%0)" :: "n"(n) : "memory")
__device__ __forceinline__ void dma16(unsigned voff, const char* sbase, unsigned lds_dst) {
    unsigned keep; asm volatile("s_mov_b32 %0, m0\n\ts_mov_b32 m0, %3\n\ts_nop 0\n\tglobal_load_lds_dwordx4 %1, %2\n\ts_mov_b32 m0, %0" : "=&s"(keep) : "v"(voff), "s"(sbase), "s"(lds_dst) : "memory"); }
__device__ __forceinline__ void ldw16(f32x4& d, unsigned voff, const char* sbase) { asm volatile("global_load_dwordx4 %0, %1, %2 nt" : "=v"(d) : "v"(voff), "s"(sbase) : "memory"); }

template <bool FIRST, int NBC>
__device__ __forceinline__ void unit_lc(LAS unsigned char* lds, const Params& p, const int e, const int u, const int ps, const int r0, const int r1) {
    constexpr int K = FIRST ? 2048 : 1024, NT = K / 32, KSTART = FIRST ? -8 : -10, NP = 2 * NBC;
    static_assert((NT - KSTART) % 6 == 0 && KSTART <= -8 && (KSTART & 1) == 0, "six register sets rotate over the unrolled iterations; weight tile 0 is issued at iteration -7; iterations pair up");
    int tid_ = threadIdx.x; asm volatile("" : "+v"(tid_));
    const int tid = tid_, lane = tid & 63, w = __builtin_amdgcn_readfirstlane(tid >> 6), fr = lane & 15, fq = lane >> 4;
    const int rot = u * (NT / 16);
#define MOE_BAR() do { asm volatile("s_waitcnt lgkmcnt(0)" ::: "memory"); __builtin_amdgcn_s_barrier(); asm volatile("" ::: "memory"); } while (0)
    if (w < 4) {
        const char* Abase = (const char*)(p.ws + (FIRST ? WS_H : WS_ACT));
        unsigned aoff[NP];
#pragma unroll
        for (int i = 0; i < NP; ++i) {
            const int mt = (w * NP + i) >> 1, h = i & 1, rt = 8 * h + (lane >> 3);
            int lr = r0 + 16 * mt + rt; lr = lr < r1 ? lr : r1 - 1;
            const unsigned cb = (unsigned)(((lane & 7) ^ ((rt >> 1) & 7)) * 16);
            if (FIRST) aoff[i] = (unsigned)((const int*)(p.ws + WS_LIST))[(size_t)e * ECAP + lr] * (unsigned)(ND * 2) + cb;
            else aoff[i] = (unsigned)(ps + lr) * (unsigned)(DE * 2) + cb;
        }
#pragma unroll
        for (int i = 0; i < NP; ++i) asm volatile("" : "+v"(aoff[i]));
        const int t = 64 * w + lane, krow = t >> 5, c4 = t & 31, gi = c4 >> 3, cg = c4 & 7;
        const int gcol = FIRST ? ((c4 < 16 ? 0 : 1024) + 64 * u + 4 * (c4 & 15)) : (128 * u + 4 * c4);
        const char* wbase = (const char*)(FIRST ? p.w_gu + (size_t)e * 2048 * 2048 : p.w_dn + (size_t)e * 1024 * 2048);
        const unsigned woff = (unsigned)(krow * 2048 + gcol) * 4u;
        const int npos = 32 * gi + 4 * (4 * (cg & 1) + (cg >> 1));
        const unsigned bw = (unsigned)(rho(krow) * B_PITCH + 2 * npos);
        const unsigned lds0 = (unsigned)(uintptr_t)lds;
        f32x4 breg[6][4];
#pragma unroll
        for (int s = 0; s < 6; ++s)
#pragma unroll
            for (int i = 0; i < 4; ++i) breg[s][i] = (f32x4){0.f, 0.f, 0.f, 0.f};
        asm volatile("s_waitcnt vmcnt(0)" ::: "memory");
        int kt = KSTART; asm volatile("" : "+s"(kt));
#define MOE_LD_ITER(SET, ODD) do { \
            if (kt >= 0) MOE_BAR(); \
            if ((ODD) && kt >= -1) MOE_WAITV(4);        \
            if (kt + 1 >= 0) { \
                asm volatile("" : "+v"(breg[SET][0]), "+v"(breg[SET][1]), "+v"(breg[SET][2]), "+v"(breg[SET][3]) :: "memory"); \
                if (kt + 1 < NT) { LAS unsigned char* bs = lds + B_OFF + ((kt + 1) % 3) * B_SLOT + bw; \
                    _Pragma("unroll") for (int i = 0; i < 4; ++i) { u32x2 wv; wv.x = pg8::cvt_pk_bf16(breg[SET][i].x, breg[SET][i].y); wv.y = pg8::cvt_pk_bf16(breg[SET][i].z, breg[SET][i].w); \
                        *(LAS u32x2*)(bs + ((i & 1) * 4 + (i >> 1) * 16) * B_PITCH) = wv; } } \
            } \
            if (!(ODD)) { int tt = (kt >> 1) + 1; tt = tt < 0 ? 0 : (tt < NT / 2 ? tt : NT / 2 - 1); const int ta = (2 * tt + rot) & (NT - 1); \
                const unsigned dst = lds0 + (unsigned)((((kt >> 1) + 1) & 1) * A_SLOT + w * NP * 1024); \
                _Pragma("unroll") for (int i = 0; i < NP; ++i) dma16(aoff[i], Abase + ta * 64, dst + i * 1024); } \
            { const int tb_ = (((kt + 7 < 0) ? 0 : (kt + 7 < NT) ? kt + 7 : NT - 1) + rot) & (NT - 1); const char* wb = wbase + (size_t)tb_ * (32 * 2048 * 4); \
                _Pragma("unroll") for (int i = 0; i < 4; ++i) ldw16(breg[SET][i], woff, wb + i * (8 * 2048 * 4)); } \
            ++kt; } while (0)
        for (; kt < NT;) { MOE_LD_ITER(0, 0); MOE_LD_ITER(1, 1); MOE_LD_ITER(2, 0); MOE_LD_ITER(3, 1); MOE_LD_ITER(4, 0); MOE_LD_ITER(5, 1); }
#undef MOE_LD_ITER
        MOE_BAR();
        asm volatile("s_waitcnt vmcnt(0)" : "+v"(breg[0][0]), "+v"(breg[0][1]), "+v"(breg[0][2]), "+v"(breg[0][3]), "+v"(breg[1][0]), "+v"(breg[1][1]), "+v"(breg[1][2]), "+v"(breg[1][3]),
                     "+v"(breg[2][0]), "+v"(breg[2][1]), "+v"(breg[2][2]), "+v"(breg[2][3]) :: "memory");
        asm volatile("" : "+v"(breg[3][0]), "+v"(breg[3][1]), "+v"(breg[3][2]), "+v"(breg[3][3]), "+v"(breg[4][0]), "+v"(breg[4][1]), "+v"(breg[4][2]), "+v"(breg[4][3]),
                     "+v"(breg[5][0]), "+v"(breg[5][1]), "+v"(breg[5][2]), "+v"(breg[5][3]) :: "memory");
    } else {
        const int c = w - 4;
        const int q = (lane & 15) >> 2, pp = lane & 3;
        const unsigned br0 = (unsigned)(rho(8 * fq + q) * B_PITCH + 8 * pp);
        const unsigned ar0 = (unsigned)(c * 2048 + fr * 128 + ((fq ^ ((fr >> 1) & 7)) << 4));
        f32x4 acc[NBC][8];
#pragma unroll
        for (int mi = 0; mi < NBC; ++mi)
#pragma unroll
            for (int j = 0; j < 8; ++j) acc[mi][j] = (f32x4){0.f, 0.f, 0.f, 0.f};
#define MOE_CS_ITER(KT, ODD) do { \
            MOE_BAR(); \
            const LAS unsigned char* as = lds + (((KT) >> 1) & 1) * A_SLOT + ((ODD) ? (ar0 ^ 64u) : ar0); const LAS unsigned char* bs = lds + B_OFF + ((KT) % 3) * B_SLOT + br0; \
            bf16x8 af[NBC]; \
            _Pragma("unroll") for (int mi = 0; mi < NBC; ++mi) af[mi] = *(const LAS bf16x8*)(as + mi * 8192); \
            v4i16_t t0 = __builtin_amdgcn_ds_read_tr16_b64_v4i16((LAS v4i16_t*)(bs)), t1 = __builtin_amdgcn_ds_read_tr16_b64_v4i16((LAS v4i16_t*)(bs + 8 * B_PITCH)); \
            _Pragma("unroll") for (int j = 0; j < 8; ++j) { \
                const bf16x8 wf = (bf16x8){t0[0], t0[1], t0[2], t0[3], t1[0], t1[1], t1[2], t1[3]}; \
                if (j < 7) { t0 = __builtin_amdgcn_ds_read_tr16_b64_v4i16((LAS v4i16_t*)(bs + 32 * (j + 1))); t1 = __builtin_amdgcn_ds_read_tr16_b64_v4i16((LAS v4i16_t*)(bs + 32 * (j + 1) + 8 * B_PITCH)); } \
                __builtin_amdgcn_sched_barrier(0); \
                _Pragma("unroll") for (int mi = 0; mi < NBC; ++mi) acc[mi][j] = __builtin_amdgcn_mfma_f32_16x16x32_bf16(wf, af[mi], acc[mi][j], 0, 0, 0); \
                __builtin_amdgcn_sched_barrier(0); } \
        } while (0)
        for (int kt = 0; kt < NT; kt += 2) { MOE_CS_ITER(kt, 0); MOE_CS_ITER(kt + 1, 1); }
#undef MOE_CS_ITER
        MOE_BAR();
#pragma unroll
        for (int mi = 0; mi < NBC; ++mi) {
            const int lr = r0 + 16 * (4 * mi + c) + fr;
            if (lr < r1) {
                if (FIRST) {
                    bf16_t* dst = (bf16_t*)(p.ws + WS_ACT) + (size_t)(ps + lr) * DE + 64 * u + 8 * fq;
#pragma unroll
                    for (int t = 0; t < 2; ++t) { float o[8];
#pragma unroll
                        for (int jj = 0; jj < 2; ++jj)
#pragma unroll
                            for (int r = 0; r < 4; ++r) { const float g = acc[mi][2 * t + jj][r], up = acc[mi][4 + 2 * t + jj][r]; o[4 * jj + r] = g * pg8::sigm(g) * up; }
                        u32x4 wv; wv.x = pg8::cvt_pk_bf16(o[0], o[1]); wv.y = pg8::cvt_pk_bf16(o[2], o[3]); wv.z = pg8::cvt_pk_bf16(o[4], o[5]); wv.w = pg8::cvt_pk_bf16(o[6], o[7]);
                        *(u32x4*)(dst + 32 * t) = wv; }
                } else {
                    const float rw = ((const float*)(p.ws + WS_SLW))[(size_t)e * ECAP + lr];
                    bf16_t* dst = (bf16_t*)(p.ws + WS_Y) + (size_t)(ps + lr) * ND + 128 * u + 8 * fq;
#pragma unroll
                    for (int t = 0; t < 4; ++t) { const f32x4 v0 = acc[mi][2 * t] * rw, v1 = acc[mi][2 * t + 1] * rw;
                        u32x4 wv; wv.x = pg8::cvt_pk_bf16(v0[0], v0[1]); wv.y = pg8::cvt_pk_bf16(v0[2], v0[3]); wv.z = pg8::cvt_pk_bf16(v1[0], v1[1]); wv.w = pg8::cvt_pk_bf16(v1[2], v1[3]);
                        *(u32x4*)(dst + 32 * t) = wv; }
                }
            }
        }
    }
#undef MOE_BAR
}
struct Pass { int e, u, ps, r0, r1; };
struct PassIt { int i, r0, re, e, u, ps; };
__device__ __forceinline__ bool pass_next(PassIt& it, const LAS int* tb, Pass& P) {
    for (;;) {
        if (it.r0 < it.re) { P.e = it.e; P.u = it.u; P.ps = it.ps; P.r0 = it.r0; P.r1 = (it.re - it.r0 > UROWS) ? it.r0 + UROWS : it.re; it.r0 += UROWS; return true; }
        const int L = it.i * (int)gridDim.x + (int)blockIdx.x; if (L >= NE * 32) return false; ++it.i;
        const int rr = L >> 3; it.e = (L & 7) + 8 * (rr >> 5); it.u = (rr >> 1) & 15; const int half = rr & 1;
        const int n_e = __builtin_amdgcn_readfirstlane(tb[it.e]); it.ps = __builtin_amdgcn_readfirstlane(tb[64 + it.e]);
        const int hr = (n_e + 1) >> 1; it.r0 = half ? hr : 0; it.re = half ? n_e : hr;
    }
}
__device__ __forceinline__ void dma4(unsigned voff, const char* sbase, unsigned lds_dst) {
    unsigned keep; asm volatile("s_mov_b32 %0, m0\n\ts_mov_b32 m0, %3\n\ts_nop 0\n\tglobal_load_lds_dword %1, %2\n\ts_mov_b32 m0, %0" : "=&s"(keep) : "v"(voff), "s"(sbase), "s"(lds_dst) : "memory"); }
constexpr int TOK_OFF = 135168;

template <bool FIRST>
__device__ __forceinline__ void stream_loader(LAS unsigned char* lds, const Params& p, const LAS int* tb) {
    constexpr int K = FIRST ? 2048 : 1024, NT = K / 32, NP = 12;
    static_assert(NT % 8 == 0, "eight register sets");
    int tid_ = threadIdx.x; asm volatile("" : "+v"(tid_));
    const int tid = tid_, lane = tid & 63, w = __builtin_amdgcn_readfirstlane(tid >> 6);
    PassIt it{0, 0, 0, 0, 0, 0}; Pass cur, nxt;
    if (!pass_next(it, tb, cur)) return;
    bool has_nxt = pass_next(it, tb, nxt);
    const char* Abase = (const char*)(p.ws + (FIRST ? WS_H : WS_ACT));
    const char* listb = (const char*)(p.ws + WS_LIST);
    const int t = 64 * w + lane, krow = t >> 5, c4 = t & 31, gi = c4 >> 3, cg = c4 & 7;
    const int npos = 32 * gi + 4 * (4 * (cg & 1) + (cg >> 1));
    const unsigned bw = (unsigned)(rho(krow) * B_PITCH + 2 * npos);
    const unsigned lds0 = (unsigned)(uintptr_t)lds;
    const unsigned wrow = (unsigned)(krow * 2048) * 4u;
#define MOE_GCOL(U) (FIRST ? ((c4 < 16 ? 0 : 1024) + 64 * (U) + 4 * (c4 & 15)) : (128 * (U) + 4 * c4))
#define MOE_WBASE(E) ((const char*)(FIRST ? p.w_gu + (size_t)(E) * 2048 * 2048 : p.w_dn + (size_t)(E) * 1024 * 2048))
    unsigned aoff[NP];
#pragma unroll
    for (int i = 0; i < NP; ++i) {
        const int q_ = 4 * i + w, mt = q_ >> 1, rt = 8 * (q_ & 1) + (lane >> 3);
        int lr = cur.r0 + 16 * mt + rt; lr = lr < cur.r1 ? lr : cur.r1 - 1;
        const unsigned cb = (unsigned)(((lane & 7) ^ ((rt >> 1) & 7)) * 16);
        if (FIRST) aoff[i] = (unsigned)((const int*)listb)[(size_t)cur.e * ECAP + lr] * (unsigned)(ND * 2) + cb;
        else aoff[i] = (unsigned)(cur.ps + lr) * (unsigned)(DE * 2) + cb;
    }
#pragma unroll
    for (int i = 0; i < NP; ++i) asm volatile("" : "+v"(aoff[i]));
    int npieces = (((cur.r1 - cur.r0 + 15) >> 4) * 2 - w + 3) >> 2;
    const char* wbase = MOE_WBASE(cur.e); unsigned woff = wrow + (unsigned)MOE_GCOL(cur.u) * 4u;
    const char* wbaseN = wbase; unsigned woffN = woff; int npiecesN = 0;
    f32x4 breg[8][4];
#pragma unroll
    for (int s = 0; s < 8; ++s)
#pragma unroll
        for (int i = 0; i < 4; ++i) breg[s][i] = (f32x4){0.f, 0.f, 0.f, 0.f};
    asm volatile("s_waitcnt vmcnt(0)" ::: "memory");
    int g0 = 0;
    int kstart = -16;
#define MOE_BAR() do { asm volatile("s_waitcnt lgkmcnt(0)" ::: "memory"); __builtin_amdgcn_s_barrier(); asm volatile("" ::: "memory"); } while (0)
#define MOE_SL_ITER(SET, ODD) do {        \
      if (!(ODD)) { \
          \
        if (kt >= 0) { if (FIRST && kt == 0 && kstart == 0) MOE_WAITV(20); else MOE_WAITV(8); } \
        else if (kt >= -8) MOE_WAITV(24);        \
        if (kt >= 0) MOE_BAR(); \
        if (kt + 3 >= 0) {        \
            _Pragma("unroll") for (int h_ = 0; h_ < 2; ++h_) { \
                asm volatile("" : "+v"(breg[((SET) + 1 + h_) & 7][0]), "+v"(breg[((SET) + 1 + h_) & 7][1]), "+v"(breg[((SET) + 1 + h_) & 7][2]), "+v"(breg[((SET) + 1 + h_) & 7][3]) :: "memory"); \
                if (kt + 2 + h_ >= 0 && (kt + 2 + h_ < NT || has_nxt)) { LAS unsigned char* bs = lds + B_OFF + ((kt + 2 + h_) & 3) * B_SLOT + bw; \
                    _Pragma("unroll") for (int i = 0; i < 4; ++i) { u32x2 wv; wv.x = pg8::cvt_pk_bf16(breg[((SET) + 1 + h_) & 7][i].x, breg[((SET) + 1 + h_) & 7][i].y); wv.y = pg8::cvt_pk_bf16(breg[((SET) + 1 + h_) & 7][i].z, breg[((SET) + 1 + h_) & 7][i].w); \
                        *(LAS u32x2*)(bs + ((i & 1) * 4 + (i >> 1) * 16) * B_PITCH) = wv; } } } \
        } \
        { \
            const int T1 = (kt >> 1) + 1; const unsigned dst = lds0 + (unsigned)((((g0 >> 1) + T1) & 1) * A_SLOT + w * 1024); \
            if (T1 < NT / 2) { if (T1 >= 0) { _Pragma("unroll") for (int i = 0; i < NP; ++i) if (i < npieces) dma16(aoff[i], Abase + T1 * 128, dst + i * 4096); } } \
            else if (has_nxt) { \
                _Pragma("unroll") for (int i = 0; i < NP; ++i) { const int q_ = 4 * i + w, rt = 8 * (q_ & 1) + (lane >> 3); const unsigned cb = (unsigned)(((lane & 7) ^ ((rt >> 1) & 7)) * 16); \
                    if (FIRST) aoff[i] = *(const LAS unsigned*)(lds + TOK_OFF + q_ * 256 + lane * 4) * (unsigned)(ND * 2) + cb; \
                    else { const int mt = q_ >> 1; int lr = nxt.r0 + 16 * mt + rt; lr = lr < nxt.r1 ? lr : nxt.r1 - 1; aoff[i] = (unsigned)(nxt.ps + lr) * (unsigned)(DE * 2) + cb; } } \
                _Pragma("unroll") for (int i = 0; i < NP; ++i) if (i < npiecesN) dma16(aoff[i], Abase, dst + i * 4096); }        \
        } \
        _Pragma("unroll") for (int h_ = 0; h_ < 2; ++h_) { \
            const int tb_ = kt + 10 + h_; const bool nx_ = (tb_ >= NT) && has_nxt;        \
            const int tile_ = nx_ ? tb_ - NT : (tb_ < 0 ? 0 : (tb_ < NT ? tb_ : NT - 1)); \
            const char* wb = (nx_ ? wbaseN : wbase) + (size_t)tile_ * (32 * 2048 * 4); const unsigned wo = nx_ ? woffN : woff; \
            _Pragma("unroll") for (int i = 0; i < 4; ++i) ldw16(breg[((SET) + 1 + h_) & 7][i], wo, wb + i * (8 * 2048 * 4)); } \
      } \
        ++kt; } while (0)
    for (;;) {
        if (has_nxt) { wbaseN = MOE_WBASE(nxt.e); woffN = wrow + (unsigned)MOE_GCOL(nxt.u) * 4u; npiecesN = (((nxt.r1 - nxt.r0 + 15) >> 4) * 2 - w + 3) >> 2; }
        if (FIRST) {
            const int qe = __builtin_amdgcn_readfirstlane(has_nxt ? nxt.e : cur.e), qr0 = __builtin_amdgcn_readfirstlane(has_nxt ? nxt.r0 : cur.r0), qr1 = __builtin_amdgcn_readfirstlane(has_nxt ? nxt.r1 : cur.r1);
            const char* lb = listb + (size_t)qe * ECAP * 4;
#pragma unroll
            for (int i = 0; i < NP; ++i) { const int q_ = 4 * i + w, mt = q_ >> 1, rt = 8 * (q_ & 1) + (lane >> 3); int lr = qr0 + 16 * mt + rt; lr = lr < qr1 ? lr : qr1 - 1;
                dma4((unsigned)lr * 4u, lb, lds0 + (unsigned)(TOK_OFF + q_ * 256)); }
        }
        int kt = kstart; asm volatile("" : "+s"(kt));
        for (; kt < NT;) { MOE_SL_ITER(0, 0); MOE_SL_ITER(1, 1); MOE_SL_ITER(2, 0); MOE_SL_ITER(3, 1); MOE_SL_ITER(4, 0); MOE_SL_ITER(5, 1); MOE_SL_ITER(6, 0); MOE_SL_ITER(7, 1); }
        if (!has_nxt) break;
        cur = nxt; wbase = wbaseN; woff = woffN; npieces = npiecesN; g0 += NT; kstart = 0;
        has_nxt = pass_next(it, tb, nxt);
    }
#undef MOE_SL_ITER
#undef MOE_GCOL
#undef MOE_WBASE
    asm volatile("s_waitcnt vmcnt(0)" : "+v"(breg[0][0]), "+v"(breg[0][1]), "+v"(breg[0][2]), "+v"(breg[0][3]), "+v"(breg[1][0]), "+v"(breg[1][1]), "+v"(breg[1][2]), "+v"(breg[1][3]),
                 "+v"(breg[2][0]), "+v"(breg[2][1]), "+v"(breg[2][2]), "+v"(breg[2][3]) :: "memory");
    asm volatile("" : "+v"(breg[3][0]), "+v"(breg[3][1]), "+v"(breg[3][2]), "+v"(breg[3][3]), "+v"(breg[4][0]), "+v"(breg[4][1]), "+v"(breg[4][2]), "+v"(breg[4][3]),
                 "+v"(breg[5][0]), "+v"(breg[5][1]), "+v"(breg[5][2]), "+v"(breg[5][3]) :: "memory");
    asm volatile("" : "+v"(breg[6][0]), "+v"(breg[6][1]), "+v"(breg[6][2]), "+v"(breg[6][3]), "+v"(breg[7][0]), "+v"(breg[7][1]), "+v"(breg[7][2]), "+v"(breg[7][3]) :: "memory");
}

template <bool FIRST, int NBC>
__device__ __forceinline__ void consumer_pass(LAS unsigned char* lds, const Params& p, const Pass& P, const int g0) {
    constexpr int K = FIRST ? 2048 : 1024, NT = K / 32;
    int tid_ = threadIdx.x; asm volatile("" : "+v"(tid_));
    const int tid = tid_, lane = tid & 63, w = __builtin_amdgcn_readfirstlane(tid >> 6), fr = lane & 15, fq = lane >> 4, c = w - 4;
    const int q = (lane & 15) >> 2, pp = lane & 3;
    const unsigned br0 = (unsigned)(rho(8 * fq + q) * B_PITCH + 8 * pp);
    const unsigned ar0 = (unsigned)(c * 2048 + fr * 128 + ((fq ^ ((fr >> 1) & 7)) << 4));
    f32x4 acc[NBC][8];
#pragma unroll
    for (int mi = 0; mi < NBC; ++mi)
#pragma unroll
        for (int j = 0; j < 8; ++j) acc[mi][j] = (f32x4){0.f, 0.f, 0.f, 0.f};
    int sl = g0 & 3;
    bf16x8 af[NBC]; v4i16_t pt0, pt1, pu0, pu1;
#define MOE_CS_ITER(KT, ODD) do {        \
        asm volatile("" : "+s"(sl));        \
        const int sn = (sl + 1) & 3; \
        const LAS unsigned char* as = lds + (((g0 + (KT)) >> 1) & 1) * A_SLOT + ((ODD) ? (ar0 ^ 64u) : ar0); const LAS unsigned char* bs = lds + B_OFF + sl * B_SLOT + br0; \
        if (!(ODD) || NBC > 6) { _Pragma("unroll") for (int mi = 0; mi < NBC; ++mi) af[mi] = *(const LAS bf16x8*)(as + mi * 8192); }        \
        v4i16_t t0 = pt0, t1 = pt1; const LAS unsigned char* bn = lds + B_OFF + sn * B_SLOT + br0; \
        _Pragma("unroll") for (int j = 0; j < 8; ++j) { \
            const bf16x8 wf = (bf16x8){t0[0], t0[1], t0[2], t0[3], t1[0], t1[1], t1[2], t1[3]}; \
            if (j == 0) { t0 = pu0; t1 = pu1; } \
            else if (j < 7) { t0 = __builtin_amdgcn_ds_read_tr16_b64_v4i16((LAS v4i16_t*)(bs + 32 * (j + 1))); t1 = __builtin_amdgcn_ds_read_tr16_b64_v4i16((LAS v4i16_t*)(bs + 32 * (j + 1) + 8 * B_PITCH)); } \
            if (j == 3 && !(ODD)) { pt0 = __builtin_amdgcn_ds_read_tr16_b64_v4i16((LAS v4i16_t*)(bn)); pt1 = __builtin_amdgcn_ds_read_tr16_b64_v4i16((LAS v4i16_t*)(bn + 8 * B_PITCH)); } \
            if (j == 5 && !(ODD)) { pu0 = __builtin_amdgcn_ds_read_tr16_b64_v4i16((LAS v4i16_t*)(bn + 32)); pu1 = __builtin_amdgcn_ds_read_tr16_b64_v4i16((LAS v4i16_t*)(bn + 32 + 8 * B_PITCH)); }        \
            __builtin_amdgcn_sched_barrier(0); \
            _Pragma("unroll") for (int mi = 0; mi < NBC; ++mi) acc[mi][j] = __builtin_amdgcn_mfma_f32_16x16x32_bf16(wf, af[mi], acc[mi][j], 0, 0, 0); \
            __builtin_amdgcn_sched_barrier(0); } \
        {        \
          if (!(ODD) && NBC <= 6) { const LAS unsigned char* an = lds + (((g0 + (KT)) >> 1) & 1) * A_SLOT + (ar0 ^ 64u); _Pragma("unroll") for (int mi = 0; mi < NBC; ++mi) af[mi] = *(const LAS bf16x8*)(an + mi * 8192); } } \
        sl = sn; \
        __builtin_amdgcn_sched_barrier(0); \
    } while (0)
    for (int kt = 0; kt < NT; kt += 2) {
        MOE_BAR();
        { asm volatile("" : "+s"(sl)); const LAS unsigned char* b0_ = lds + B_OFF + sl * B_SLOT + br0; pt0 = __builtin_amdgcn_ds_read_tr16_b64_v4i16((LAS v4i16_t*)(b0_)); pt1 = __builtin_amdgcn_ds_read_tr16_b64_v4i16((LAS v4i16_t*)(b0_ + 8 * B_PITCH));
          pu0 = __builtin_amdgcn_ds_read_tr16_b64_v4i16((LAS v4i16_t*)(b0_ + 32)); pu1 = __builtin_amdgcn_ds_read_tr16_b64_v4i16((LAS v4i16_t*)(b0_ + 32 + 8 * B_PITCH)); }
        MOE_CS_ITER(kt, 0); MOE_CS_ITER(kt + 1, 1);
    }
#undef MOE_CS_ITER
#undef MOE_BAR
    const int e = P.e, u = P.u, ps = P.ps, r0 = P.r0, r1 = P.r1;
#pragma unroll
    for (int mi = 0; mi < NBC; ++mi) {
        const int lr = r0 + 16 * (4 * mi + c) + fr;
        if (lr < r1) {
            if (FIRST) {
                bf16_t* dst = (bf16_t*)(p.ws + WS_ACT) + (size_t)(ps + lr) * DE + 64 * u + 8 * fq;
#pragma unroll
                for (int t = 0; t < 2; ++t) { float o[8];
#pragma unroll
                    for (int jj = 0; jj < 2; ++jj)
#pragma unroll
                        for (int r = 0; r < 4; ++r) { const float g = acc[mi][2 * t + jj][r], up = acc[mi][4 + 2 * t + jj][r]; o[4 * jj + r] = g * pg8::sigm(g) * up; }
                    u32x4 wv; wv.x = pg8::cvt_pk_bf16(o[0], o[1]); wv.y = pg8::cvt_pk_bf16(o[2], o[3]); wv.z = pg8::cvt_pk_bf16(o[4], o[5]); wv.w = pg8::cvt_pk_bf16(o[6], o[7]);
                    *(u32x4*)(dst + 32 * t) = wv; }
            } else {
                const float rw = ((const float*)(p.ws + WS_SLW))[(size_t)e * ECAP + lr];
                bf16_t* dst = (bf16_t*)(p.ws + WS_Y) + (size_t)(ps + lr) * ND + 128 * u + 8 * fq;
#pragma unroll
                for (int t = 0; t < 4; ++t) { const f32x4 v0 = acc[mi][2 * t] * rw, v1 = acc[mi][2 * t + 1] * rw;
                    u32x4 wv; wv.x = pg8::cvt_pk_bf16(v0[0], v0[1]); wv.y = pg8::cvt_pk_bf16(v0[2], v0[3]); wv.z = pg8::cvt_pk_bf16(v1[0], v1[1]); wv.w = pg8::cvt_pk_bf16(v1[2], v1[3]);
                    *(u32x4*)(dst + 32 * t) = wv; }
            }
        }
    }
}
#undef MOE_WAITV
static_assert(B_OFF + 4 * B_SLOT <= TOK_OFF && TOK_OFF + 12288 <= 159744, "expert engine ring (four weight-image slots) vs LDS map");
}

#ifndef MOE_CONT
#define MOE_CONT 3
#endif
template <bool FIRST>
__device__ __forceinline__ void phase_moe_stream(const Params& p, LAS unsigned char* lds, int tid) {
    LAS int* tb = (LAS int*)(lds + TBL_OFF);
    expert_tables(p, tb, tid);
#if MOE_CONT
  if (MOE_CONT == 3 || (MOE_CONT == 1 && FIRST) || (MOE_CONT == 2 && !FIRST)) {
    if (__builtin_amdgcn_readfirstlane(tid >> 6) < 4) moe::stream_loader<FIRST>(lds, p, tb);
    else {
        constexpr int NT = (FIRST ? 2048 : 1024) / 32;
        moe::PassIt it{0, 0, 0, 0, 0, 0}; moe::Pass P; int g0 = 0;
        while (moe::pass_next(it, tb, P)) {
            const int n = P.r1 - P.r0;
            if (n > 320) moe::consumer_pass<FIRST, 6>(lds, p, P, g0);
            else if (n > 256) moe::consumer_pass<FIRST, 5>(lds, p, P, g0);
            else if (n > 192) moe::consumer_pass<FIRST, 4>(lds, p, P, g0);
            else if (n > 128) moe::consumer_pass<FIRST, 3>(lds, p, P, g0);
            else moe::consumer_pass<FIRST, 2>(lds, p, P, g0);
            g0 += NT;
        }
    }
    return;
  }
#endif
    const int G = gridDim.x;
    for (int i = 0;; ++i) {
        const int L = i * G + (int)blockIdx.x; if (L >= NE * 32) break;
        const int rr = L >> 3, e = (L & 7) + 8 * (rr >> 5), u = (rr >> 1) & 15, half = rr & 1;
        const int n_e = __builtin_amdgcn_readfirstlane(tb[e]), ps = __builtin_amdgcn_readfirstlane(tb[64 + e]);
        const int hr = (n_e + 1) >> 1, rb = half ? hr : 0, re = half ? n_e : hr;
        for (int r0 = rb; r0 < re; r0 += moe::UROWS) {
            const int r1 = (re - r0 > moe::UROWS) ? r0 + moe::UROWS : re, n = r1 - r0;
            if (n > 256) moe::unit_lc<FIRST, 6>(lds, p, e, u, ps, r0, r1);
            else if (n > 128) moe::unit_lc<FIRST, 4>(lds, p, e, u, ps, r0, r1);
            else moe::unit_lc<FIRST, 2>(lds, p, e, u, ps, r0, r1);
        }
    }
}

struct Mo1A { const bf16_t* H2; const int* list; int n_e, r0; __device__ __forceinline__ const bf16_t* operator()(int r, int k0) const { const int lr = r0 + r; if (lr >= n_e) return nullptr; return H2 + (size_t)list[lr] * ND + k0; } };
struct Mo1B { const bf16_t* W; int v0; __device__ __forceinline__ const bf16_t* operator()(int n, int k0) const { const int v = v0 + n, j = v >> 1, isu = v & 1; return W + (size_t)((j >> 7) * 256 + isu * 128 + (j & 127)) * ND + k0; } };
struct Mo1Epi { bf16_t* ACT; int prow0, v0;
    __device__ __forceinline__ void operator()(int r, int c, f32x4& v) const { const int j = (v0 + c) >> 1;
        const float a0 = v.x / (1.f + __expf(-v.x)) * v.y, a1 = v.z / (1.f + __expf(-v.z)) * v.w;
        *(unsigned*)(ACT + (size_t)(prow0 + r) * DE + j) = pk2(a0, a1); } };
__device__ __forceinline__ void phase_moe1_naive(const Params& p, LAS unsigned char* lds, const Ctx& cx) {
    LAS int* tb = (LAS int*)(lds + 32768);
    expert_tables(p, tb, cx.tid);
    const int ntile = tb[192 + NE] * 32;
    for (int t = blockIdx.x; t < ntile; t += gridDim.x) {
        const int ct = t & 31, rtg = t >> 5;
        int e = 0; while (tb[192 + e + 1] <= rtg) ++e;
        const int rt = rtg - tb[192 + e], n_e = tb[e], ps = tb[64 + e];
        Mo1A af{(const bf16_t*)(p.ws + WS_H), (const int*)(p.ws + WS_LIST) + (size_t)e * ECAP, n_e, rt * 64};
        Mo1B bf{(const bf16_t*)(p.ws + WS_WGUT) + (size_t)e * 2048 * ND, ct * 64};
        Mo1Epi ef{(bf16_t*)(p.ws + WS_ACT), ps + rt * 64, ct * 64};
        ngemm_tile(lds, ND, -1, af, bf, NoMid(), ef, cx.tid);
    }
}
struct Mo2A { const bf16_t* ACT; int prow0; __device__ __forceinline__ const bf16_t* operator()(int r, int k0) const { return ACT + (size_t)(prow0 + r) * DE + k0; } };
struct Mo2B { const bf16_t* W; int col0; __device__ __forceinline__ const bf16_t* operator()(int n, int k0) const { return W + (size_t)(col0 + n) * DE + k0; } };
struct Mo2Epi { bf16_t* Y; const float* slw; int prow0, r0, n_e, col0;
    __device__ __forceinline__ void operator()(int r, int c, f32x4& v) const { const int lr = r0 + r; if (lr >= n_e) return; const float w = slw[lr];
        u32x2 o; o.x = pk2(v.x * w, v.y * w); o.y = pk2(v.z * w, v.w * w); *(u32x2*)(Y + (size_t)(prow0 + lr) * ND + col0 + c) = o; } };
__device__ __forceinline__ void phase_moe2_naive(const Params& p, LAS unsigned char* lds, const Ctx& cx) {
    LAS int* tb = (LAS int*)(lds + 32768);
    expert_tables(p, tb, cx.tid);
    const int ntile = tb[192 + NE] * 32;
    for (int t = blockIdx.x; t < ntile; t += gridDim.x) {
        const int ct = t & 31, rtg = t >> 5;
        int e = 0; while (tb[192 + e + 1] <= rtg) ++e;
        const int rt = rtg - tb[192 + e], n_e = tb[e], ps = tb[64 + e];
        Mo2A af{(const bf16_t*)(p.ws + WS_ACT), ps + rt * 64};
        Mo2B bf{(const bf16_t*)(p.ws + WS_WDNT) + (size_t)e * ND * DE, ct * 64};
        Mo2Epi ef{(bf16_t*)(p.ws + WS_Y), (const float*)(p.ws + WS_SLW) + (size_t)e * ECAP, ps, rt * 64, n_e, ct * 64};
        ngemm_tile(lds, DE, -1, af, bf, NoMid(), ef, cx.tid);
    }
}

__device__ __forceinline__ void phase_final(const Params& p, LAS unsigned char* lds, const Ctx& cx) {
    LAS int* tb = (LAS int*)(lds + 32768);
    expert_tables(p, tb, cx.tid);
    const float* xmid = (const float*)(p.ws + WS_XMID); const float* mod = (const float*)(p.ws + WS_MOD);
    const int* toke = (const int*)(p.ws + WS_TOKE); const int* tokr = (const int*)(p.ws + WS_TOKR); const bf16_t* Y = (const bf16_t*)(p.ws + WS_Y);
    f32x4 gfin[8];
#pragma unroll
    for (int j = 0; j < 8; ++j) gfin[j] = *(const f32x4*)(p.g_final + 4 * cx.lane + 256 * j);
    for (int row = cx.gw; row + cx.ngw < NM + cx.ngw; row += 2 * cx.ngw) {
        const int rowa = row, rowb = (row + cx.ngw < NM) ? row + cx.ngw : row; const bool hasb = row + cx.ngw < NM;
        const int ba = rowa / NS, bb = rowb / NS;
        const int sa0 = tb[64 + toke[rowa * 2]] + tokr[rowa * 2], sa1 = tb[64 + toke[rowa * 2 + 1]] + tokr[rowa * 2 + 1];
        const int sb0 = tb[64 + toke[rowb * 2]] + tokr[rowb * 2], sb1 = tb[64 + toke[rowb * 2 + 1]] + tokr[rowb * 2 + 1];
        const f32x4* xa = (const f32x4*)(xmid + (size_t)rowa * ND) + cx.lane; const f32x4* xb = (const f32x4*)(xmid + (size_t)rowb * ND) + cx.lane;
        const u32x2* ya0 = (const u32x2*)(Y + (size_t)sa0 * ND) + cx.lane; const u32x2* ya1 = (const u32x2*)(Y + (size_t)sa1 * ND) + cx.lane;
        const u32x2* yb0 = (const u32x2*)(Y + (size_t)sb0 * ND) + cx.lane; const u32x2* yb1 = (const u32x2*)(Y + (size_t)sb1 * ND) + cx.lane;
        f32x4 va[8], vb[8]; float ssa = 0.f, ssb = 0.f;
#pragma unroll
        for (int j = 0; j < 8; ++j) {
            const int col = 4 * cx.lane + 256 * j;
            const f32x4 gta = *(const f32x4*)(mod + (size_t)ba * 12288 + 10240 + col), gtb = *(const f32x4*)(mod + (size_t)bb * 12288 + 10240 + col);
            const u32x2 a0 = __builtin_nontemporal_load(ya0 + 64 * j), a1 = __builtin_nontemporal_load(ya1 + 64 * j), b0 = __builtin_nontemporal_load(yb0 + 64 * j), b1 = __builtin_nontemporal_load(yb1 + 64 * j);
            f32x4 fa, fb;
            fa.x = bf2f(a0.x & 0xffffu) + bf2f(a1.x & 0xffffu); fa.y = bf2f(a0.x >> 16) + bf2f(a1.x >> 16); fa.z = bf2f(a0.y & 0xffffu) + bf2f(a1.y & 0xffffu); fa.w = bf2f(a0.y >> 16) + bf2f(a1.y >> 16);
            fb.x = bf2f(b0.x & 0xffffu) + bf2f(b1.x & 0xffffu); fb.y = bf2f(b0.x >> 16) + bf2f(b1.x >> 16); fb.z = bf2f(b0.y & 0xffffu) + bf2f(b1.y & 0xffffu); fb.w = bf2f(b0.y >> 16) + bf2f(b1.y >> 16);
            va[j] = __builtin_nontemporal_load(xa + 64 * j) + gta * fa; vb[j] = __builtin_nontemporal_load(xb + 64 * j) + gtb * fb;
            ssa += (va[j].x * va[j].x + va[j].y * va[j].y) + (va[j].z * va[j].z + va[j].w * va[j].w);
            ssb += (vb[j].x * vb[j].x + vb[j].y * vb[j].y) + (vb[j].z * vb[j].z + vb[j].w * vb[j].w);
        }
        const float ra = 1.f / sqrtf(wave_sum(ssa) * (1.f / ND) + RMS_EPS), rbv = 1.f / sqrtf(wave_sum(ssb) * (1.f / ND) + RMS_EPS);
        f32x4* oa = (f32x4*)(p.out + (size_t)rowa * ND) + cx.lane; f32x4* ob = (f32x4*)(p.out + (size_t)rowb * ND) + cx.lane;
#pragma unroll
        for (int j = 0; j < 8; ++j) __builtin_nontemporal_store(va[j] * ra * gfin[j], oa + 64 * j);
        if (hasb) {
#pragma unroll
            for (int j = 0; j < 8; ++j) __builtin_nontemporal_store(vb[j] * rbv * gfin[j], ob + 64 * j);
        }
    }
}

#ifndef FAST_ATTN
#define FAST_ATTN 1
#endif
#ifndef FAST_ROUTER
#define FAST_ROUTER 1
#endif
#ifndef FAST_INPROJ
#define FAST_INPROJ 1
#endif
#ifndef FAST_BRANCH
#define FAST_BRANCH 1
#endif
#ifndef FAST_OUT
#define FAST_OUT 1
#endif
#ifndef FAST_MOE1
#define FAST_MOE1 1
#endif
#ifndef FAST_MOE2
#define FAST_MOE2 1
#endif
__global__ void __launch_bounds__(NTHR, 2) fwd(Params p) {
    extern __shared__ __attribute__((aligned(16))) unsigned char lds_raw[];
    LAS unsigned char* lds = (LAS unsigned char*)lds_raw;
    volatile LAS unsigned* MISC = (volatile LAS unsigned*)(lds + MISC_OFF);
    if (threadIdx.x < 32) MISC[threadIdx.x] = 0u;
    __syncthreads();
    XcdBarrier bar = xcd_barrier_post((unsigned*)(p.ws + WS_CTL) + CW_BAR, MISC + 8);

#ifndef REP_MASK
#define REP_MASK 0
#endif
#define REPS(k) (((REP_MASK >> (k)) & 1) ? 2 : 1)
    for (int rep = 0; rep < REPS(0); ++rep) { phase_prologue(p, lds, make_ctx());        xcd_barrier(bar); }
    for (int rep = 0; rep < REPS(1); ++rep) { phase_h(p, lds, make_ctx());               xcd_barrier(bar); }
    for (int rep = 0; rep < REPS(2); ++rep) {
#if FAST_INPROJ
    phase_inproj_fast(p, lds);         xcd_barrier(bar);
#else
    phase_inproj_naive(p, lds, make_ctx());    xcd_barrier(bar);
#endif
    }
    for (int rep = 0; rep < REPS(3); ++rep) {
#if FAST_ATTN
    phase_attn_fast(p, (char*)lds_raw);        xcd_barrier(bar);
#else
    phase_swa_naive(p, make_ctx());
    phase_diff_naive(p, make_ctx());           xcd_barrier(bar);
#endif
    }
    for (int rep = 0; rep < REPS(4); ++rep) {
#if FAST_BRANCH
    phase_branch_fast(p, lds);         xcd_barrier(bar);
#else
    phase_branch_naive(p, lds, make_ctx());    xcd_barrier(bar);
#endif
    }
    for (int rep = 0; rep < REPS(5); ++rep) {
#if FAST_OUT
    phase_out_fast(p, lds);            xcd_barrier(bar);
#else
    phase_out_naive(p, lds, make_ctx());       xcd_barrier(bar);
#endif
    }
#if FAST_ROUTER
    phase_router_fast(p, lds, make_ctx());     xcd_barrier(bar);
#else
    phase_router(p, lds, make_ctx());          xcd_barrier(bar);
#endif
    for (int rep = 0; rep < REPS(7); ++rep) {
#if MOE_STREAM
    phase_moe_stream<true>(p, lds, threadIdx.x);   xcd_barrier(bar);
#elif FAST_MOE1
    phase_moe1_fast(p, lds, make_ctx());       xcd_barrier(bar);
#else
    phase_moe1_naive(p, lds, make_ctx());      xcd_barrier(bar);
#endif
    }
    for (int rep = 0; rep < REPS(8); ++rep) {
#if MOE_STREAM
    phase_moe_stream<false>(p, lds, threadIdx.x);  xcd_barrier(bar);
#elif FAST_MOE2
    phase_moe2_fast(p, lds, make_ctx());       xcd_barrier(bar);
#else
    phase_moe2_naive(p, lds, make_ctx());      xcd_barrier(bar);
#endif
    }
    for (int rep = 0; rep < REPS(9); ++rep) { if (rep) xcd_barrier(bar); phase_final(p, lds, make_ctx()); }
}

extern "C" void kernel_launch(void* const* d_in, const int* in_sizes, int n_in, void* d_out, int out_size, void* d_ws, size_t ws_size, hipStream_t stream) {
    static int grid = 0;
    if (grid == 0) {
        if (n_in != 24 || in_sizes[0] != NM * ND || out_size != NM * ND || ws_size < WS_END) { fprintf(stderr, "kernel_launch: unexpected shapes (n_in %d, in0 %d, out %d, ws %zu)\n", n_in, n_in > 0 ? in_sizes[0] : -1, out_size, ws_size); grid = -1; return; }
        int dev = 0, cus = 0, per_cu = 0;
        if (hipGetDevice(&dev) != hipSuccess || hipDeviceGetAttribute(&cus, hipDeviceAttributeMultiprocessorCount, dev) != hipSuccess) { grid = -1; return; }
        if (hipFuncSetAttribute((const void*)fwd, hipFuncAttributeMaxDynamicSharedMemorySize, LDS_BYTES) != hipSuccess) { fprintf(stderr, "kernel_launch: hipFuncSetAttribute failed\n"); grid = -1; return; }
        if (hipOccupancyMaxActiveBlocksPerMultiprocessor(&per_cu, (const void*)fwd, NTHR, LDS_BYTES) != hipSuccess || per_cu < 1) fprintf(stderr, "kernel_launch: occupancy query says %d\n", per_cu);
        (void)hipGetLastError();
        grid = cus;
    }
    if (grid < 0) return;
    (void)hipMemsetAsync((char*)d_ws + WS_CTL, 0, CTL_ZERO_BYTES, stream);
    Params p{};
    p.x = (const float*)d_in[0]; p.c = (const float*)d_in[1]; p.pos = (const int*)d_in[2]; p.w_ada = (const float*)d_in[3]; p.b_ada = (const float*)d_in[4];
    p.g_mix = (const float*)d_in[5]; p.w_in = (const float*)d_in[6]; p.sinks = (const float*)d_in[7]; p.lq1 = (const float*)d_in[8]; p.lk1 = (const float*)d_in[9];
    p.lq2 = (const float*)d_in[10]; p.lk2 = (const float*)d_in[11]; p.subln = (const float*)d_in[12]; p.w_a = (const float*)d_in[13]; p.w_b = (const float*)d_in[14];
    p.w_out = (const float*)d_in[15]; p.g_ffn = (const float*)d_in[16]; p.w_rg = (const float*)d_in[17]; p.b_rg = (const float*)d_in[18]; p.w_re = (const float*)d_in[19];
    p.b_re = (const float*)d_in[20]; p.w_gu = (const float*)d_in[21]; p.w_dn = (const float*)d_in[22]; p.g_final = (const float*)d_in[23];
    p.out = (float*)d_out; p.ws = (unsigned char*)d_ws;
    hipLaunchKernelGGL(fwd, dim3(grid), dim3(NTHR), LDS_BYTES, stream, p);
}
```

```cpp
#include <hip/hip_runtime.h>
#include <cstdio>
#include <cstdint>

#ifndef LATE_COPIES
#define LATE_COPIES 1
#endif
#ifndef DIFF128
#define DIFF128 1
#endif
#ifndef MOE_STREAM
#define MOE_STREAM 1
#endif
#define LAS __attribute__((address_space(3)))
#define GAS __attribute__((address_space(1)))
typedef unsigned short bf16_t;
typedef float f32x4 __attribute__((ext_vector_type(4)));
typedef float f32x2 __attribute__((ext_vector_type(2)));
typedef unsigned u32x4 __attribute__((ext_vector_type(4)));
typedef unsigned u32x2 __attribute__((ext_vector_type(2)));

constexpr int NB = 8, NS = 2048, ND = 2048, NM = NB * NS;
constexpr int IN_COLS = 8448;
constexpr int C_KA = 1024, C_VA = 1152, C_QD = 1280, C_KD = 2304, C_VD = 3328, C_GA = 4352;
constexpr int NE = 64, DE = 1024;
constexpr int ECAP = 16384;
constexpr int PADR = 256;
constexpr int PMAX = 49152;
constexpr int KS_ADA = 32, KCH_ADA = ND / KS_ADA;
constexpr float RMS_EPS = 1e-6f;
constexpr float LOG2E = 1.4426950408889634f;
constexpr float C2 = 0.125f * LOG2E;
constexpr int NTHR = 512, NWAVES = 8;

constexpr size_t MiB = 1u << 20;
constexpr size_t WS_CTL = 0, CTL_ZERO_BYTES = 1 * MiB;
constexpr size_t WS_MOD = 1 * MiB;
constexpr size_t WS_MODP = 2 * MiB;
constexpr size_t WS_COS = 16 * MiB, WS_SIN = 18 * MiB;
constexpr size_t WS_TOKE = 20 * MiB;
constexpr size_t WS_TOKR = 21 * MiB;
constexpr size_t WS_LIST = 22 * MiB;
constexpr size_t WS_SLW = 26 * MiB;
constexpr size_t WS_WRT = 30 * MiB;
constexpr size_t WS_SSQ = 14 * MiB;
constexpr size_t WS_WINT = 32 * MiB;
constexpr size_t WS_WAT = 66 * MiB;
constexpr size_t WS_WBT = 70 * MiB;
constexpr size_t WS_WOUTT = 74 * MiB;
constexpr size_t WS_H = 96 * MiB;
constexpr size_t WS_QA = 160 * MiB;
constexpr size_t WS_KA = 192 * MiB;
constexpr size_t WS_VA = 196 * MiB;
constexpr size_t WS_QD = 200 * MiB, WS_KD = 232 * MiB, WS_VD = 264 * MiB;
constexpr size_t WS_G = 296 * MiB;
constexpr size_t WS_TMP = 424 * MiB;
constexpr size_t WS_OA = 488 * MiB, WS_OB = 520 * MiB;
constexpr size_t WS_MERGED = 552 * MiB;
constexpr size_t WS_XMID = 616 * MiB;
constexpr size_t WS_ACT = 744 * MiB;
constexpr size_t WS_Y = 840 * MiB;
constexpr size_t WS_WGUT = 1032 * MiB;
constexpr size_t WS_WDNT = 1544 * MiB;
constexpr size_t WS_END = 1800 * MiB;
constexpr int CW_CNT = 1024;
constexpr int CW_BAR = 4096;

constexpr int LDS_BYTES = 163840;
constexpr int MISC_OFF = 159744 + 64;

__device__ __forceinline__ float bf2f(unsigned v) { return __uint_as_float(v << 16); }
__device__ __forceinline__ unsigned f2bf(float f) { unsigned u = __float_as_uint(f); return (u + 0x7fffu + ((u >> 16) & 1u)) >> 16; }
__device__ __forceinline__ unsigned pk2(float lo, float hi) { return f2bf(lo) | (f2bf(hi) << 16); }
__device__ __forceinline__ float wave_sum(float v) {
#pragma unroll
    for (int o = 1; o < 64; o <<= 1) v += __shfl_xor(v, o);
    return v;
}
#define LDS_WAIT() asm volatile("s_waitcnt lgkmcnt(0)" ::: "memory")

__device__ const float INVF[32] = {
    1.000000000e+00f, 7.498942614e-01f, 5.623413324e-01f, 4.216965139e-01f, 3.162277639e-01f, 2.371373773e-01f, 1.778279394e-01f, 1.333521307e-01f,
    1.000000015e-01f, 7.498941571e-02f, 5.623413250e-02f, 4.216965288e-02f, 3.162277490e-02f, 2.371373773e-02f, 1.778279431e-02f, 1.333521493e-02f,
    9.999999776e-03f, 7.498941850e-03f, 5.623413250e-03f, 4.216964822e-03f, 3.162277630e-03f, 2.371373586e-03f, 1.778279431e-03f, 1.333521446e-03f,
    1.000000047e-03f, 7.498942432e-04f, 5.623413017e-04f, 4.216965172e-04f, 3.162277571e-04f, 2.371373703e-04f, 1.778279402e-04f, 1.333521504e-04f};

__device__ __forceinline__ void sincos_d(double a, double& s, double& c) {
    const double n = __builtin_rint(a * 0.63661977236758134308);
    double r = __builtin_fma(-n, 1.5707963267948966, a);
    r = __builtin_fma(-n, 6.123233995736766e-17, r);
    const double r2 = r * r;
    double ps = -1.0 / 1307674368000.0;
    ps = ps * r2 + 1.0 / 6227020800.0; ps = ps * r2 - 1.0 / 39916800.0; ps = ps * r2 + 1.0 / 362880.0; ps = ps * r2 - 1.0 / 5040.0; ps = ps * r2 + 1.0 / 120.0; ps = ps * r2 - 1.0 / 6.0;
    const double sr = r + r * r2 * ps;
    double pc = 1.0 / 87178291200.0;
    pc = pc * r2 - 1.0 / 479001600.0; pc = pc * r2 + 1.0 / 3628800.0; pc = pc * r2 - 1.0 / 40320.0; pc = pc * r2 + 1.0 / 720.0; pc = pc * r2 - 1.0 / 24.0; pc = pc * r2 + 0.5;
    const double cr = 1.0 - r2 * pc;
    const int q = ((int)n) & 3;
    s = (q == 0) ? sr : (q == 1) ? cr : (q == 2) ? -sr : -cr;
    c = (q == 0) ? cr : (q == 1) ? -sr : (q == 2) ? -cr : sr;
}

#define XB_TMO      128
#define XB_XCNT(j)  (256  + 64 * (j))
#define XB_XSUB(j)  (1280 + 64 * (j))
#define XB_XGEN(j)  (2304 + 64 * (j))
#define XB_TOP      3328
#define XB_TOPGEN   3392
#define XCD_BAR_WORDS 3456
#define XB_SPIN_CAP (1u << 18)

__device__ __forceinline__ unsigned xb_ld(unsigned* p)              { return __hip_atomic_load(p, __ATOMIC_RELAXED, __HIP_MEMORY_SCOPE_AGENT); }
__device__ __forceinline__ unsigned xb_add(unsigned* p, unsigned v) { return __hip_atomic_fetch_add(p, v, __ATOMIC_RELAXED, __HIP_MEMORY_SCOPE_AGENT); }
__device__ __forceinline__ unsigned xb_xcc_id() { return (unsigned)__builtin_amdgcn_s_getreg((3 << 11) | 20) & 0xFu; }
#define XB_SPIN(cond, bar) do { unsigned _sp = 0; while (cond) { __builtin_amdgcn_s_sleep(1); \
    if ((++_sp & 255u) == 0u) { if (xb_ld(&(bar)[XB_TMO])) break; if (_sp > XB_SPIN_CAP) { atomicAdd(&(bar)[XB_TMO], 1u); break; } } } } while (0)

struct XcdBarrier {
    unsigned* bar; unsigned x;
    volatile LAS unsigned* st;
};
__device__ __forceinline__ XcdBarrier xcd_barrier_post(unsigned* bar, volatile LAS unsigned* st) {
    XcdBarrier b; b.bar = bar; b.x = xb_xcc_id(); b.st = st;
    if (threadIdx.x == 0) (void)xb_add(&bar[XB_XCNT(b.x)], 1u);
    return b;
}
__device__ __forceinline__ void xcd_barrier_complete(unsigned* bar, unsigned x, unsigned& nloc, unsigned& nx) {
    const unsigned G = gridDim.x * gridDim.y * gridDim.z;
    unsigned sum, cnt, mine, sp = 0u;
    for (;;) {
        sum = 0u; cnt = 0u; mine = 0u;
#pragma unroll
        for (unsigned j = 0; j < 16; ++j) { const unsigned c = xb_ld(&bar[XB_XCNT(j)]); sum += c; cnt += (c > 0u) ? 1u : 0u; mine = (j == x) ? c : mine; }
        if (sum == G) break;
        __builtin_amdgcn_s_sleep(1);
        if ((++sp & 255u) == 0u) { if (xb_ld(&bar[XB_TMO])) break; if (sp > XB_SPIN_CAP) { atomicAdd(&bar[XB_TMO], 1u); break; } }
    }
    nloc = mine > 0u ? mine : 1u; nx = cnt > 0u ? cnt : 1u;
}
__device__ __forceinline__ void xcd_barrier(const XcdBarrier& b) {
    asm volatile("s_waitcnt vmcnt(0)" ::: "memory");
    __syncthreads();
    if (threadIdx.x == 0) {
        unsigned* bar = b.bar;
        __builtin_amdgcn_s_waitcnt(0);
        unsigned nloc = b.st[0], nx = b.st[1];
        if (nloc == 0u) { xcd_barrier_complete(bar, b.x, nloc, nx); b.st[0] = nloc; b.st[1] = nx; }
        const unsigned old = xb_add(&bar[XB_XSUB(b.x)], 1u);
        const unsigned gen = old / nloc;
        if (old + 1u == (gen + 1u) * nloc) {
            __builtin_amdgcn_fence(__ATOMIC_RELEASE, "agent");
            asm volatile("s_waitcnt vmcnt(0)" ::: "memory");
            const unsigned og = xb_add(&bar[XB_TOP], 1u);
            const unsigned tg = og / nx;
            if (og + 1u == (tg + 1u) * nx) xb_add(&bar[XB_TOPGEN], 1u);
            else XB_SPIN(xb_ld(&bar[XB_TOPGEN]) == tg, bar);
            __builtin_amdgcn_fence(__ATOMIC_ACQUIRE, "agent");
            xb_add(&bar[XB_XGEN(b.x)], 1u);
            asm volatile("s_waitcnt vmcnt(0)" ::: "memory");
        } else {
            XB_SPIN(xb_ld(&bar[XB_XGEN(b.x)]) == gen, bar);
            __builtin_amdgcn_fence(__ATOMIC_ACQUIRE, "agent");
            asm volatile("s_waitcnt vmcnt(0)" ::: "memory");
        }
    }
    __syncthreads();
}

struct Params {
    const float* x; const float* c; const int* pos; const float* w_ada; const float* b_ada; const float* g_mix; const float* w_in;
    const float* sinks; const float* lq1; const float* lk1; const float* lq2; const float* lk2; const float* subln;
    const float* w_a; const float* w_b; const float* w_out; const float* g_ffn; const float* w_rg; const float* b_rg;
    const float* w_re; const float* b_re; const float* w_gu; const float* w_dn; const float* g_final;
    float* out; unsigned char* ws;
};

struct Ctx { int tid, lane, wave, gw, ngw, gtid, ngt; };
__device__ __forceinline__ Ctx make_ctx() {
    Ctx cx; int t = threadIdx.x; asm volatile("" : "+v"(t));
    cx.tid = t; cx.lane = t & 63; cx.wave = __builtin_amdgcn_readfirstlane(t >> 6);
    cx.gw = blockIdx.x * NWAVES + cx.wave; cx.ngw = gridDim.x * NWAVES; cx.gtid = blockIdx.x * NTHR + t; cx.ngt = gridDim.x * NTHR;
    return cx;
}

template <int MODE> __device__ __forceinline__ int dest_row(int n) {
    if (MODE == 1) {
        const bool rope = (n < C_VA) || (n >= C_QD && n < C_VD);
        if (!rope) return n;
        const int hb = n & ~63, d = n & 63;
        return hb + ((d < 32) ? 2 * d : 2 * (d - 32) + 1);
    }
    if (MODE == 2) {
        const int j = n & 1023, isu = n >> 10;
        return (j >> 7) * 256 + isu * 128 + (j & 127);
    }
    return n;
}
template <int MODE>
__device__ __forceinline__ void transpose_item(const float* W, int K, int N, bf16_t* WT, LAS float* scr, int item, int lane) {
    const int nblk = N / 32, kb = item / nblk, nb = item % nblk, k0 = 64 * kb, n0 = 32 * nb;
    {
        f32x4 v[8];
#pragma unroll
        for (int i = 0; i < 8; ++i) v[i] = *(const f32x4*)(W + (size_t)(k0 + 8 * i + (lane >> 3)) * N + n0 + 4 * (lane & 7));
        __builtin_amdgcn_sched_barrier(0);
#pragma unroll
        for (int i = 0; i < 8; ++i) { LAS float* d = scr + (8 * i + (lane >> 3)) * 33 + 4 * (lane & 7); d[0] = v[i].x; d[1] = v[i].y; d[2] = v[i].z; d[3] = v[i].w; }
    }
    LDS_WAIT(); asm volatile("" ::: "memory");
    const int c = lane & 7;
#pragma unroll
    for (int j = 0; j < 4; ++j) { const int n = (lane >> 3) + 8 * j; const LAS float* s = scr + (8 * c) * 33 + n;
        u32x4 o; o.x = pk2(s[0 * 33], s[1 * 33]); o.y = pk2(s[2 * 33], s[3 * 33]); o.z = pk2(s[4 * 33], s[5 * 33]); o.w = pk2(s[6 * 33], s[7 * 33]);
        *(u32x4*)(WT + (size_t)dest_row<MODE>(n0 + n) * K + k0 + 8 * c) = o; }
    LDS_WAIT(); asm volatile("" ::: "memory");
}

__device__ __forceinline__ void phase_prologue(const Params& p, LAS unsigned char* lds, const Ctx& cx) {
    unsigned char* ws = p.ws;
    LAS float* cact = (LAS float*)lds;
    for (int i = cx.tid; i < NB * ND; i += NTHR) { const float v = p.c[i]; cact[i] = v / (1.f + __expf(-v)); }
    __syncthreads();
    {
        float* mod = (float*)(ws + WS_MOD);
        LAS float* part = (LAS float*)(lds + 65536);
        for (int cb = blockIdx.x; cb < 12288 / 48; cb += gridDim.x) {
            const int cq = cx.lane % 12, kr = cx.lane / 12;
            f32x4 acc[8];
#pragma unroll
            for (int b = 0; b < 8; ++b) acc[b] = (f32x4){0.f, 0.f, 0.f, 0.f};
            if (kr < 5) {
                const float* wp = p.w_ada + 48 * cb + 4 * cq;
#pragma unroll 13
                for (int i = 0; i < 52; ++i) {
                    const int kl = 5 * i + kr;
                    if (kl < 256) {
                        const int k = cx.wave * 256 + kl;
                        const f32x4 wv = *(const f32x4*)(wp + (size_t)k * 12288);
#pragma unroll
                        for (int b = 0; b < 8; ++b) acc[b] += cact[b * ND + k] * wv;
                    }
                }
#pragma unroll
                for (int b = 0; b < 8; ++b) *(LAS f32x4*)(part + ((cx.wave * 5 + kr) * 8 + b) * 48 + 4 * cq) = acc[b];
            }
            __syncthreads();
            if (cx.tid < 384) {
                const int b = cx.tid / 48, j = cx.tid % 48;
                float s = p.b_ada[48 * cb + j];
                for (int q = 0; q < 40; ++q) s += part[(q * 8 + b) * 48 + j];
                mod[(size_t)b * 12288 + 48 * cb + j] = s;
            }
            __syncthreads();
        }
    }
    __syncthreads();
    LAS float* scr = (LAS float*)(lds + cx.wave * 8448);
    constexpr int I_IN = (ND / 64) * (IN_COLS / 32), I_AB = (1024 / 64) * (ND / 32), I_OUT = (ND / 64) * (ND / 32), I_GU = (ND / 64) * (2048 / 32), I_DN = (DE / 64) * (ND / 32);
#if LATE_COPIES
    for (int it = cx.gw; it < I_IN; it += cx.ngw) transpose_item<1>(p.w_in, ND, IN_COLS, (bf16_t*)(ws + WS_WINT), scr, it, cx.lane);
#else
    constexpr int NITEMS = MOE_STREAM ? (I_IN + 2 * I_AB + I_OUT) : (I_IN + 2 * I_AB + I_OUT + NE * I_GU + NE * I_DN);
    for (int it = cx.gw; it < NITEMS; it += cx.ngw) {
        int r = it;
        if (r < I_IN) { transpose_item<1>(p.w_in, ND, IN_COLS, (bf16_t*)(ws + WS_WINT), scr, r, cx.lane); continue; } r -= I_IN;
        if (r < I_AB) { transpose_item<0>(p.w_a, 1024, ND, (bf16_t*)(ws + WS_WAT), scr, r, cx.lane); continue; } r -= I_AB;
        if (r < I_AB) { transpose_item<0>(p.w_b, 1024, ND, (bf16_t*)(ws + WS_WBT), scr, r, cx.lane); continue; } r -= I_AB;
        if (r < I_OUT) { transpose_item<0>(p.w_out, ND, ND, (bf16_t*)(ws + WS_WOUTT), scr, r, cx.lane); continue; } r -= I_OUT;
#if !MOE_STREAM
        if (r < NE * I_GU) { const int e = r / I_GU; transpose_item<2>(p.w_gu + (size_t)e * ND * 2048, ND, 2048, (bf16_t*)(ws + WS_WGUT) + (size_t)e * 2048 * ND, scr, r % I_GU, cx.lane); continue; } r -= NE * I_GU;
        { const int e = r / I_DN; transpose_item<0>(p.w_dn + (size_t)e * DE * ND, DE, ND, (bf16_t*)(ws + WS_WDNT) + (size_t)e * ND * DE, scr, r % I_DN, cx.lane); }
#endif
    }
    { float* wrt = (float*)(ws + WS_WRT);
      for (int i = cx.gtid; i < 80 * ND; i += cx.ngt) { const int j = i >> 11, k = i & (ND - 1); wrt[i] = (j < 64) ? p.w_re[(size_t)k * 64 + j] : (j < 72) ? p.w_rg[(size_t)k * 8 + (j - 64)] : 0.f; } }
#endif
    float* cosT = (float*)(ws + WS_COS); float* sinT = (float*)(ws + WS_SIN);
    for (int i = cx.gtid; i < NM * 32; i += cx.ngt) {
        const int row = i >> 5, fi = i & 31;
        const float ang = (float)p.pos[row] * INVF[fi];
        double s, c; sincos_d((double)ang, s, c);
        cosT[i] = (float)c; sinT[i] = (float)s;
    }
}

__device__ __forceinline__ void late_weight_copies(const Params& p, LAS unsigned char* lds, const Ctx& cx, int first, int nhelp) {
    unsigned char* ws = p.ws;
    LAS float* scr = (LAS float*)(lds + cx.wave * 8448);
    constexpr int I_AB = (1024 / 64) * (ND / 32), I_OUT = (ND / 64) * (ND / 32);
    const int hw = ((int)blockIdx.x - first) * NWAVES + cx.wave, nhw = nhelp * NWAVES;
    for (int it = hw; it < 2 * I_AB + I_OUT; it += nhw) {
        int r = it;
        if (r < I_AB) { transpose_item<0>(p.w_a, 1024, ND, (bf16_t*)(ws + WS_WAT), scr, r, cx.lane); continue; } r -= I_AB;
        if (r < I_AB) { transpose_item<0>(p.w_b, 1024, ND, (bf16_t*)(ws + WS_WBT), scr, r, cx.lane); continue; } r -= I_AB;
        transpose_item<0>(p.w_out, ND, ND, (bf16_t*)(ws + WS_WOUTT), scr, r, cx.lane);
    }
    float* wrt = (float*)(ws + WS_WRT);
    for (int i = ((int)blockIdx.x - first) * NTHR + cx.tid; i < 80 * ND; i += nhelp * NTHR) { const int j = i >> 11, k = i & (ND - 1); wrt[i] = (j < 64) ? p.w_re[(size_t)k * 64 + j] : (j < 72) ? p.w_rg[(size_t)k * 8 + (j - 64)] : 0.f; }
}

__device__ __forceinline__ void phase_h(const Params& p, LAS unsigned char* lds, const Ctx& cx) {
    const float* mod = (const float*)(p.ws + WS_MOD);
    LAS float* shsc = (LAS float*)lds;
    bf16_t* H = (bf16_t*)(p.ws + WS_H);
    f32x4 gmix[8];
#pragma unroll
    for (int j = 0; j < 8; ++j) gmix[j] = *(const f32x4*)(p.g_mix + 4 * cx.lane + 256 * j);
    for (int rb = blockIdx.x; rb < NM / 64; rb += gridDim.x) {
        const int b = rb / (NS / 64);
        __syncthreads();
        for (int j = cx.tid; j < 4096; j += NTHR) shsc[j] = mod[(size_t)b * 12288 + j];
        __syncthreads();
        for (int rr = cx.wave; rr < 64; rr += 2 * NWAVES) {
            const int rowa = rb * 64 + rr, rowb = rowa + NWAVES;
            const f32x4* xa = (const f32x4*)(p.x + (size_t)rowa * ND) + cx.lane; const f32x4* xb = (const f32x4*)(p.x + (size_t)rowb * ND) + cx.lane;
            f32x4 va[8], vb[8]; float sa = 0.f, sb = 0.f;
#pragma unroll
            for (int j = 0; j < 8; ++j) { va[j] = __builtin_nontemporal_load(xa + 64 * j); vb[j] = __builtin_nontemporal_load(xb + 64 * j); }
#pragma unroll
            for (int j = 0; j < 8; ++j) { sa += (va[j].x * va[j].x + va[j].y * va[j].y) + (va[j].z * va[j].z + va[j].w * va[j].w); sb += (vb[j].x * vb[j].x + vb[j].y * vb[j].y) + (vb[j].z * vb[j].z + vb[j].w * vb[j].w); }
            const float ra = 1.f / sqrtf(wave_sum(sa) * (1.f / ND) + RMS_EPS), rbv = 1.f / sqrtf(wave_sum(sb) * (1.f / ND) + RMS_EPS);
            u32x2* oa = (u32x2*)(H + (size_t)rowa * ND) + cx.lane; u32x2* ob = (u32x2*)(H + (size_t)rowb * ND) + cx.lane;
#pragma unroll
            for (int j = 0; j < 8; ++j) {
                const int col = 4 * cx.lane + 256 * j;
                const f32x4 sh = *(const LAS f32x4*)(shsc + col), gs = gmix[j] * (*(const LAS f32x4*)(shsc + 2048 + col) + 1.f);
                const f32x4 ya = va[j] * ra * gs + sh, yb = vb[j] * rbv * gs + sh;
                u32x2 w; w.x = pk2(ya.x, ya.y); w.y = pk2(ya.z, ya.w); oa[64 * j] = w;
                w.x = pk2(yb.x, yb.y); w.y = pk2(yb.z, yb.w); ob[64 * j] = w;
            }
        }
    }
}

template <class AF, class BF, class MF, class EF>
__device__ __forceinline__ void ngemm_tile(LAS unsigned char* lds, int K, int midk, const AF& af, const BF& bf, const MF& mf, const EF& ef, int tid) {
    LAS float* As = (LAS float*)lds; LAS float* Bs = As + 32 * 68;
    const int ty = tid >> 4, tx = tid & 15, lr = tid >> 3, lk = (tid & 7) * 4;
    f32x4 acc0 = (f32x4){0.f, 0.f, 0.f, 0.f}, acc1 = acc0;
    for (int k0 = 0; k0 < K; k0 += 32) {
        if (k0 == midk) { mf(2 * ty, 4 * tx, acc0); mf(2 * ty + 1, 4 * tx, acc1); }
        const bf16_t* pa = af(lr, k0); const bf16_t* pb = bf(lr, k0);
        u32x2 ra = (u32x2){0u, 0u}, rb = ra;
        if (pa) ra = *(const u32x2*)(pa + lk);
        if (pb) rb = *(const u32x2*)(pb + lk);
        __syncthreads();
        As[(lk + 0) * 68 + lr] = bf2f(ra.x & 0xffffu); As[(lk + 1) * 68 + lr] = bf2f(ra.x >> 16); As[(lk + 2) * 68 + lr] = bf2f(ra.y & 0xffffu); As[(lk + 3) * 68 + lr] = bf2f(ra.y >> 16);
        Bs[(lk + 0) * 68 + lr] = bf2f(rb.x & 0xffffu); Bs[(lk + 1) * 68 + lr] = bf2f(rb.x >> 16); Bs[(lk + 2) * 68 + lr] = bf2f(rb.y & 0xffffu); Bs[(lk + 3) * 68 + lr] = bf2f(rb.y >> 16);
        __syncthreads();
#pragma unroll 8
        for (int kk = 0; kk < 32; ++kk) {
            const f32x2 a = *(const LAS f32x2*)(As + kk * 68 + 2 * ty);
            const f32x4 b = *(const LAS f32x4*)(Bs + kk * 68 + 4 * tx);
            acc0 += a.x * b; acc1 += a.y * b;
        }
    }
    ef(2 * ty, 4 * tx, acc0); ef(2 * ty + 1, 4 * tx, acc1);
    __syncthreads();
}
struct NoMid { __device__ __forceinline__ void operator()(int, int, f32x4&) const {} };

struct InA { const bf16_t* H; int row0; __device__ __forceinline__ const bf16_t* operator()(int r, int k0) const { return H + (size_t)(row0 + r) * ND + k0; } };
struct InB { const bf16_t* W; int col0; __device__ __forceinline__ const bf16_t* operator()(int n, int k0) const { return W + (size_t)(col0 + n) * ND + k0; } };
struct InEpi {
    unsigned char* ws; int row0, col0;
    __device__ __forceinline__ void operator()(int r, int c, f32x4& v) const {
        const int row = row0 + r, col = col0 + c;
        const bool rope = (col < C_VA) || (col >= C_QD && col < C_VD);
        if (rope) {
            const int i0 = (col & 63) >> 1;
            const float* cosT = (const float*)(ws + WS_COS) + (size_t)row * 32 + i0; const float* sinT = (const float*)(ws + WS_SIN) + (size_t)row * 32 + i0;
            const float c0 = cosT[0], c1 = cosT[1], s0 = sinT[0], s1 = sinT[1];
            float o0 = v.x * c0 - v.y * s0, o1 = v.y * c0 + v.x * s0, o2 = v.z * c1 - v.w * s1, o3 = v.w * c1 + v.z * s1;
            const bool isq = (col < C_KA) || (col >= C_QD && col < C_KD);
            if (isq) { o0 *= C2; o1 *= C2; o2 *= C2; o3 *= C2; }
            bf16_t* dst;
            if (col < C_KA) dst = (bf16_t*)(ws + WS_QA) + (size_t)row * 1024 + col;
            else if (col < C_VA) dst = (bf16_t*)(ws + WS_KA) + (size_t)row * 128 + (col - C_KA);
            else if (col < C_KD) dst = (bf16_t*)(ws + WS_QD) + (size_t)row * 1024 + (col - C_QD);
            else dst = (bf16_t*)(ws + WS_KD) + (size_t)row * 1024 + (col - C_KD);
            u32x2 w; w.x = pk2(o0, o1); w.y = pk2(o2, o3); *(u32x2*)dst = w;
        } else if (col < C_GA) {
            bf16_t* dst = (col < C_QD) ? (bf16_t*)(ws + WS_VA) + (size_t)row * 128 + (col - C_VA) : (bf16_t*)(ws + WS_VD) + (size_t)row * 1024 + (col - C_VD);
            u32x2 w; w.x = pk2(v.x, v.y); w.y = pk2(v.z, v.w); *(u32x2*)dst = w;
        } else {
            bf16_t* dst = (bf16_t*)(ws + WS_G) + (size_t)row * 4096 + (col - C_GA);
            u32x2 w; w.x = pk2(1.f / (1.f + __expf(-v.x)), 1.f / (1.f + __expf(-v.y))); w.y = pk2(1.f / (1.f + __expf(-v.z)), 1.f / (1.f + __expf(-v.w))); *(u32x2*)dst = w;
        }
    }
};
__device__ __forceinline__ void phase_inproj_naive(const Params& p, LAS unsigned char* lds, const Ctx& cx) {
    constexpr int NTN = IN_COLS / 64, NT = (NM / 64) * NTN;
    for (int t = blockIdx.x; t < NT; t += gridDim.x) {
        const int tm = t / NTN, tn = t % NTN;
        InA af{(const bf16_t*)(p.ws + WS_H), tm * 64}; InB bf{(const bf16_t*)(p.ws + WS_WINT), tn * 64}; InEpi ef{p.ws, tm * 64, tn * 64};
        ngemm_tile(lds, ND, -1, af, bf, NoMid(), ef, cx.tid);
    }
}

__device__ __forceinline__ void load8(const bf16_t* p, float* d) {
    const u32x4 w = *(const u32x4*)p;
    d[0] = bf2f(w.x & 0xffffu); d[1] = bf2f(w.x >> 16); d[2] = bf2f(w.y & 0xffffu); d[3] = bf2f(w.y >> 16);
    d[4] = bf2f(w.z & 0xffffu); d[5] = bf2f(w.z >> 16); d[6] = bf2f(w.w & 0xffffu); d[7] = bf2f(w.w >> 16);
}
__device__ __forceinline__ void phase_swa_naive(const Params& p, const Ctx& cx) {
    const bf16_t* QA = (const bf16_t*)(p.ws + WS_QA); const bf16_t* KA = (const bf16_t*)(p.ws + WS_KA); const bf16_t* VA = (const bf16_t*)(p.ws + WS_VA);
    bf16_t* OA = (bf16_t*)(p.ws + WS_OA);
    for (int it = cx.gtid; it < NB * 16 * NS; it += cx.ngt) {
        const int s = it & (NS - 1), qh = (it >> 11) & 15, b = it >> 15, kvh = qh >> 3;
        const int row = b * NS + s, s0 = s - cx.lane;
        float q[64], acc[64];
#pragma unroll
        for (int d = 0; d < 64; d += 8) load8(QA + (size_t)row * 1024 + qh * 64 + d, q + d);
#pragma unroll
        for (int d = 0; d < 64; ++d) acc[d] = 0.f;
        float m = p.sinks[qh] * LOG2E, l = 1.f;
        const int klo = (s0 - 127 < 0) ? 0 : s0 - 127, khi = s0 + 63;
        for (int kp = klo; kp <= khi; ++kp) {
            const bf16_t* kr = KA + (size_t)(b * NS + kp) * 128 + kvh * 64;
            float sc = 0.f;
#pragma unroll
            for (int d = 0; d < 64; d += 8) { float kk[8]; load8(kr + d, kk);
#pragma unroll
                for (int j = 0; j < 8; ++j) sc += q[d + j] * kk[j]; }
            const bool valid = (kp <= s) && (s - kp < 128);
            if (valid) {
                const float mn = fmaxf(m, sc), alpha = exp2f(m - mn), pe = exp2f(sc - mn);
                l = l * alpha + pe; m = mn;
                const bf16_t* vr = VA + (size_t)(b * NS + kp) * 128 + kvh * 64;
#pragma unroll
                for (int d = 0; d < 64; d += 8) { float vv[8]; load8(vr + d, vv);
#pragma unroll
                    for (int j = 0; j < 8; ++j) acc[d + j] = acc[d + j] * alpha + pe * vv[j]; }
            }
        }
        const float il = 1.f / l;
        bf16_t* o = OA + (size_t)row * 1024 + qh * 64;
#pragma unroll
        for (int d = 0; d < 64; d += 8) { u32x4 w; w.x = pk2(acc[d] * il, acc[d + 1] * il); w.y = pk2(acc[d + 2] * il, acc[d + 3] * il); w.z = pk2(acc[d + 4] * il, acc[d + 5] * il); w.w = pk2(acc[d + 6] * il, acc[d + 7] * il); *(u32x4*)(o + d) = w; }
    }
}
__device__ __forceinline__ float diff_lambda(const Params& p) {
    float s1 = 0.f, s2 = 0.f;
    for (int i = 0; i < 64; ++i) { s1 += p.lq1[i] * p.lk1[i]; s2 += p.lq2[i] * p.lk2[i]; }
    return expf(s1) - expf(s2) + 0.2f;
}
__device__ __forceinline__ void phase_diff_naive(const Params& p, const Ctx& cx) {
    const bf16_t* QD = (const bf16_t*)(p.ws + WS_QD); const bf16_t* KD = (const bf16_t*)(p.ws + WS_KD); const bf16_t* VD = (const bf16_t*)(p.ws + WS_VD);
    bf16_t* OB = (bf16_t*)(p.ws + WS_OB); float* TMP = (float*)(p.ws + WS_TMP);
    const float lam = diff_lambda(p);
    for (int it = cx.gtid; it < NB * 8 * NS; it += cx.ngt) {
        const int s = it & (NS - 1), h = (it >> 11) & 7, b = it >> 14;
        const int row = b * NS + s, smax = s - cx.lane + 63;
        float* tr = TMP + (size_t)row * 1024 + h * 128;
        float ssq = 0.f;
        for (int vh = 0; vh < 2; ++vh) {
            for (int c = 0; c < 2; ++c) {
                float q[64], acc[64];
#pragma unroll
                for (int d = 0; d < 64; d += 8) load8(QD + (size_t)row * 1024 + (2 * h + c) * 64 + d, q + d);
#pragma unroll
                for (int d = 0; d < 64; ++d) acc[d] = 0.f;
                float m = -1e30f, l = 0.f;
                for (int kp = 0; kp <= smax; ++kp) {
                    const bf16_t* kr = KD + (size_t)(b * NS + kp) * 1024 + (2 * h + c) * 64;
                    float sc = 0.f;
#pragma unroll
                    for (int d = 0; d < 64; d += 8) { float kk[8]; load8(kr + d, kk);
#pragma unroll
                        for (int j = 0; j < 8; ++j) sc += q[d + j] * kk[j]; }
                    if (kp <= s) {
                        const float mn = fmaxf(m, sc), alpha = exp2f(m - mn), pe = exp2f(sc - mn);
                        l = l * alpha + pe; m = mn;
                        const bf16_t* vr = VD + (size_t)(b * NS + kp) * 1024 + h * 128 + vh * 64;
#pragma unroll
                        for (int d = 0; d < 64; d += 8) { float vv[8]; load8(vr + d, vv);
#pragma unroll
                            for (int j = 0; j < 8; ++j) acc[d + j] = acc[d + j] * alpha + pe * vv[j]; }
                    }
                }
                const float il = 1.f / l;
                if (c == 0) {
#pragma unroll
                    for (int d = 0; d < 64; d += 4) *(f32x4*)(tr + vh * 64 + d) = (f32x4){acc[d] * il, acc[d + 1] * il, acc[d + 2] * il, acc[d + 3] * il};
                } else {
#pragma unroll
                    for (int d = 0; d < 64; d += 4) { f32x4 t = *(const f32x4*)(tr + vh * 64 + d);
                        t.x -= lam * acc[d] * il; t.y -= lam * acc[d + 1] * il; t.z -= lam * acc[d + 2] * il; t.w -= lam * acc[d + 3] * il;
                        ssq += (t.x * t.x + t.y * t.y) + (t.z * t.z + t.w * t.w); *(f32x4*)(tr + vh * 64 + d) = t; }
                }
            }
        }
        const float rstd = 0.8f / sqrtf(ssq * (1.f / 128.f) + RMS_EPS);
        bf16_t* o = OB + (size_t)row * 1024 + h * 128;
        for (int d = 0; d < 128; d += 4) { const f32x4 t = *(const f32x4*)(tr + d); const f32x4 g = *(const f32x4*)(p.subln + d);
            u32x2 w; w.x = pk2(t.x * rstd * g.x, t.y * rstd * g.y); w.y = pk2(t.z * rstd * g.z, t.w * rstd * g.w); *(u32x2*)(o + d) = w; }
    }
}

namespace att {
using bf16=unsigned short;
using bf16x8=__attribute__((ext_vector_type(8)))short;
using s16x4=__attribute__((ext_vector_type(4)))short;
using f32x16=__attribute__((ext_vector_type(16)))float;
using u32x4=__attribute__((ext_vector_type(4)))unsigned;
constexpr int D=64;
constexpr int NW=8,QBLK=32,QB=QBLK*NW,KVBLK=64;
__device__ __forceinline__ int crow(int r,int hi){return (r&3)+8*(r>>2)+4*hi;}
#define SBAR() __builtin_amdgcn_sched_barrier(0)
__device__ __forceinline__ void cmask(f32x16&p0,f32x16&p1,int jb,int qrel,int hi){
  const float NEG=-INFINITY; int kb=64*jb+4*hi;
  #pragma unroll
  for(int r=0;r<16;++r){int kv=kb+(r&3)+8*(r>>2); if(kv>qrel)p0[r]=NEG; if(kv+32>qrel)p1[r]=NEG;}
}
__device__ __forceinline__ void wmask(f32x16&p0,f32x16&p1,int kv0,int qrel,int hi){
  const float NEG=-1000.f; const int kb=kv0+4*hi;
  #pragma unroll
  for(int r=0;r<16;++r){const int kv=kb+(r&3)+8*(r>>2); if(kv>qrel||qrel-kv>=128)p0[r]=NEG; if(kv+32>qrel||qrel-(kv+32)>=128)p1[r]=NEG;}
}

constexpr int NSLOT=3, SLOTB=8192;
constexpr int LDS_K=0, LDS_V=NSLOT*SLOTB, LDS_WS=2*NSLOT*SLOTB, LDS_OST=LDS_WS+NW*64*4, LDS_BYTES=LDS_OST+NW*4096;
constexpr float C2=0.125f*1.4426950408889634f;
__device__ __forceinline__ void glds16(const void*gsrc,unsigned lds_dst){unsigned keep;
  asm volatile("s_mov_b32 %0, m0\n\ts_mov_b32 m0, %2\n\ts_nop 0\n\tglobal_load_lds_dwordx4 %1, off\n\ts_mov_b32 m0, %0":"=&s"(keep):"v"(gsrc),"s"(lds_dst):"memory");}
__device__ __forceinline__ float max3f(float a,float b,float c){float r;asm("v_max3_f32 %0, %1, %2, %3":"=v"(r):"v"(a),"v"(b),"v"(c));return r;}
__device__ __forceinline__ float max2f(float a,float b){float r;asm("v_max_f32_e32 %0, %1, %2":"=v"(r):"v"(a),"v"(b));return r;}
__device__ __forceinline__ float fadd_s(float a,float b){float r;asm("v_add_f32_e32 %0, %1, %2":"=v"(r):"v"(a),"v"(b));return r;}
__device__ __forceinline__ float fsub_s(float a,float b){float r;asm("v_sub_f32_e32 %0, %1, %2":"=v"(r):"v"(a),"v"(b));return r;}
typedef float f32x2_t __attribute__((ext_vector_type(2))); typedef __bf16 bf16x2_t __attribute__((ext_vector_type(2)));
__device__ __forceinline__ unsigned cvtpk_s(float lo,float hi){f32x2_t v={lo,hi};bf16x2_t b=__builtin_convertvector(v,bf16x2_t);return __builtin_bit_cast(unsigned,b);}
#define WAIT_BAR(N) asm volatile("s_waitcnt vmcnt(" #N ") lgkmcnt(0)\n\ts_barrier":::"memory")

__device__ __forceinline__ void qkt(f32x16&p0,f32x16&p1,const char*Kslot,const bf16x8*qr,const f32x16&negm,int r32,int hi){
  const char*kb=Kslot+hi*1024+r32*16;
  #pragma unroll
  for(int d0=0;d0<4;++d0){
    const bf16x8 b0=*reinterpret_cast<const bf16x8*>(kb+d0*2048);
    const bf16x8 b1=*reinterpret_cast<const bf16x8*>(kb+d0*2048+512);
    if(d0==0){p0=__builtin_amdgcn_mfma_f32_32x32x16_bf16(b0,qr[0],negm,0,0,0);p1=__builtin_amdgcn_mfma_f32_32x32x16_bf16(b1,qr[0],negm,0,0,0);}
    else{p0=__builtin_amdgcn_mfma_f32_32x32x16_bf16(b0,qr[d0],p0,0,0,0);p1=__builtin_amdgcn_mfma_f32_32x32x16_bf16(b1,qr[d0],p1,0,0,0);}}
}
typedef __attribute__((address_space(3))) const char* lds_cptr;
typedef short v4i16_t __attribute__((ext_vector_type(4)));
__device__ __forceinline__ void kload8(bf16x8*kf,lds_cptr kp){
  kf[0]=*(const __attribute__((address_space(3))) bf16x8*)(kp);      kf[1]=*(const __attribute__((address_space(3))) bf16x8*)(kp+512);
  kf[2]=*(const __attribute__((address_space(3))) bf16x8*)(kp+2048); kf[3]=*(const __attribute__((address_space(3))) bf16x8*)(kp+2560);
  kf[4]=*(const __attribute__((address_space(3))) bf16x8*)(kp+4096); kf[5]=*(const __attribute__((address_space(3))) bf16x8*)(kp+4608);
  kf[6]=*(const __attribute__((address_space(3))) bf16x8*)(kp+6144); kf[7]=*(const __attribute__((address_space(3))) bf16x8*)(kp+6656);
}
__device__ __forceinline__ void kload2(bf16x8*kf,lds_cptr kp,int j){ kf[2*j]=*(const __attribute__((address_space(3))) bf16x8*)(kp+j*2048); kf[2*j+1]=*(const __attribute__((address_space(3))) bf16x8*)(kp+j*2048+512); }
__device__ __forceinline__ s16x4 vtr(lds_cptr p){ return __builtin_bit_cast(s16x4,__builtin_amdgcn_ds_read_tr16_b64_v4i16((__attribute__((address_space(3))) v4i16_t*)p)); }
__device__ __forceinline__ float rowmax(const f32x16&p0,const f32x16&p1){
  float a=max3f(p0[0],p0[1],p1[0]),b=max3f(p0[2],p0[3],p1[1]);a=max3f(a,p1[2],p1[3]);
  #pragma unroll
  for(int r=4;r<16;r+=4){a=max3f(a,p0[r],p0[r+1]);b=max3f(b,p0[r+2],p0[r+3]);a=max3f(a,p1[r],p1[r+1]);b=max3f(b,p1[r+2],p1[r+3]);}
  const float m=max2f(a,b);
  auto rr=__builtin_amdgcn_permlane32_swap(__float_as_uint(m),__float_as_uint(m),false,false);
  return max2f(__uint_as_float(rr[0]),__uint_as_float(rr[1]));
}
__device__ __forceinline__ void pv(f32x16*o,int vb,bf16x8 pa0,bf16x8 pa1,bf16x8 pa2,bf16x8 pa3){
  #pragma unroll
  for(int d0=0;d0<2;++d0){s16x4 lo[4],hi[4];
    #pragma unroll
    for(int ks=0;ks<4;++ks){
      asm volatile("ds_read_b64_tr_b16 %0,%1 offset:%c2":"=&v"(lo[ks]):"v"(vb),"i"(d0*4096+ks*1024):"memory");
      asm volatile("ds_read_b64_tr_b16 %0,%1 offset:%c2":"=&v"(hi[ks]):"v"(vb),"i"(d0*4096+ks*1024+512):"memory");}
    asm volatile("s_waitcnt lgkmcnt(0)":::"memory");SBAR();
    #define PK(k) (bf16x8){lo[k][0],lo[k][1],lo[k][2],lo[k][3],hi[k][0],hi[k][1],hi[k][2],hi[k][3]}
    o[d0]=__builtin_amdgcn_mfma_f32_32x32x16_bf16(pa0,PK(0),o[d0],0,0,0);
    o[d0]=__builtin_amdgcn_mfma_f32_32x32x16_bf16(pa1,PK(1),o[d0],0,0,0);
    o[d0]=__builtin_amdgcn_mfma_f32_32x32x16_bf16(pa2,PK(2),o[d0],0,0,0);
    o[d0]=__builtin_amdgcn_mfma_f32_32x32x16_bf16(pa3,PK(3),o[d0],0,0,0);
    #undef PK
  }
}

#ifndef ATTN_STORE16
#define ATTN_STORE16(p,v) (*(u32x4*)(p)=(v))
#endif
struct EpiArgs { int mode; float lam; float sink2; float sink2b; float* stash; const float* subln; bf16* O; };
template<int KIND,int QP,int KP,int THRL> __device__ __forceinline__ void attn_unit(const bf16*Qu,const bf16*__restrict__ Kh,const bf16*__restrict__ Vh,const int NT,const int koff,const EpiArgs ep,char*shm){
  constexpr int DM=KP;
  int tid_=threadIdx.x; asm volatile("":"+v"(tid_));
  const int tid=tid_,lane=tid&63,r32=lane&31,hi=lane>>5; const int wid=__builtin_amdgcn_readfirstlane(tid>>6);
  const int wq=(KIND==1)?(wid&3):wid, wh=(KIND==1)?(wid>>2):0;
  const bf16*Qw=Qu+(long)(wq*QBLK)*QP+wh*64;
  const unsigned lds0=(unsigned)(uintptr_t)shm;
  float*wsf=(float*)(shm+LDS_WS)+wid*64;
  const bf16*ksrc=Kh+(long)lane*DM+wid*8;
  const bf16*vsrc=Vh+(long)(16*(wid&3)+(lane>>2))*DM+(wid>>2)*32+(lane&3)*8;
  const unsigned kdst=lds0+LDS_K+wid*1024, vdst=lds0+LDS_V+wid*1024;
  #define DMA_K(t,slot) glds16(ksrc+(long)(t)*KVBLK*DM,(unsigned)__builtin_amdgcn_readfirstlane(kdst+(slot)))
  #define DMA_V(t,slot) glds16(vsrc+(long)(t)*KVBLK*DM,(unsigned)__builtin_amdgcn_readfirstlane(vdst+(slot)))
  const int vb0=(int)(lds0+LDS_V)+((lane>>4)&1)*32+(lane&3)*8+(4*hi+((lane&15)>>2))*64;
  const char*Kbase=shm+LDS_K; bf16x8 kf[8];
  const lds_cptr shm3=(lds_cptr)shm; const lds_cptr kp0=shm3+LDS_K+hi*1024+r32*16; const lds_cptr vp0=shm3+LDS_V+((lane>>4)&1)*32+(lane&3)*8+(4*hi+((lane&15)>>2))*64;
  DMA_K(0,0);DMA_V(0,0);DMA_K(1,SLOTB);
  bf16x8 qr[4];
  #pragma unroll
  for(int d0=0;d0<4;++d0)qr[d0]=*reinterpret_cast<const bf16x8*>(&Qw[(long)r32*QP+d0*16+hi*8]);
  float mhat=0.f,l_reg=0.f;f32x16 o[2];o[0]=f32x16{};o[1]=f32x16{};f32x16 negm=f32x16{};asm volatile("":"+v"(negm));
  const int qrel=wq*QBLK+r32;
  #define CMASK(P0,P1,t) do{ if(KIND==1){ wmask(P0,P1,64*(t)+koff,qrel,hi); } else { int jb_=(t)-(NT-4); if(jb_>=0)cmask(P0,P1,jb_,qrel,hi); } }while(0)
  bool resc=false;
  #define START(P0,P1) do{ const float rm=rowmax(P0,P1); resc=false; \
    { const float dl=rm; mhat=fadd_s(mhat,dl); \
      _Pragma("unroll") for(int r=0;r<16;++r){P0[r]=fsub_s(P0[r],dl);P1[r]=fsub_s(P1[r],dl);} \
      _Pragma("unroll") for(int r=0;r<16;++r)negm[r]=-mhat; asm volatile("":"+v"(negm)); } \
    _Pragma("unroll") for(int r=0;r<16;++r)P0[r]=__builtin_amdgcn_exp2f(P0[r]); }while(0)
  #define RESC() do{ if(resc){ asm volatile("s_waitcnt lgkmcnt(0)":::"memory"); \
      _Pragma("unroll") for(int d_=0;d_<2;++d_) _Pragma("unroll") for(int r=0;r<16;++r)o[d_][r]*=wsf[crow(r,hi)]; } }while(0)
  f32x16 pA0,pA1,pB0,pB1;
  int sl_prev=0,sl_cur=0,sl_next=SLOTB;
  #define ROT() do{sl_prev=sl_cur;sl_cur=sl_next;sl_next=(sl_next==(NSLOT-1)*SLOTB)?0:sl_next+SLOTB;}while(0)
  DMA_K(2,2*SLOTB);
  WAIT_BAR(3);
  qkt(pA0,pA1,Kbase,qr,negm,r32,hi);asm volatile("s_nop 15\n\ts_nop 7":"+v"(pA0),"+v"(pA1));CMASK(pA0,pA1,0);
  START(pA0,pA1);
  _Pragma("unroll") for(int r=0;r<16;++r)pA1[r]=__builtin_amdgcn_exp2f(pA1[r]);
  WAIT_BAR(0);
  DMA_K(3,0);DMA_V(1,SLOTB);
  ROT();
  kload8(kf,kp0+sl_cur);
  WAIT_BAR(2);
  s16x4 vlo[8],vhi[8]; u32x4 pw0,pw1,pw2,pw3;
  #define PKW(P,B) cvtpk_s(P[B],P[B+1])
  #define PAF(k) __builtin_bit_cast(bf16x8,pw##k)
  #define VFR(i) (bf16x8){vlo[i][0],vlo[i][1],vlo[i][2],vlo[i][3],vhi[i][0],vhi[i][1],vhi[i][2],vhi[i][3]}
  #define PIN(x) asm volatile("":"+v"(x))
  #define MX3(a,b,c) __builtin_fmaxf(__builtin_fmaxf((a),(b)),(c))
  #define GAPA(MF,A0,A1,A2,A3,W0,W1,PW) do{ MF; sacc+=A0; sacc+=A1; sacc+=A2; sacc+=A3; PIN(sacc); W0; W1; PIN(PW); SBAR(); }while(0)
  #define EX(v) __builtin_amdgcn_exp2f(v)
  #define GAPB(MF,X,B) do{ MF; X[B]=EX(X[B]); X[B+1]=EX(X[B+1]); X[B+2]=EX(X[B+2]); X[B+3]=EX(X[B+3]); PIN(X); SBAR(); }while(0)
  #define VRD(i) do{ vlo[i]=vtr(vp_+(((i)>>2)*4096+((i)&3)*1024)); vhi[i]=vtr(vp_+(((i)>>2)*4096+((i)&3)*1024+512)); }while(0)
  #define KRD(G,j) do{ if(G){ kload2(kf,kp0+sl_next,j); SBAR(); } }while(0)
  #define STEP(C0,C1,P0,P1,t,GK,GV,GL) do{ SBAR(); \
    const lds_cptr vp_=vp0+sl_prev; \
    VRD(0); SBAR(); float sacc=(P0[0]+P0[1]); \
    GAPA(C0=__builtin_amdgcn_mfma_f32_32x32x16_bf16(kf[0],qr[0],negm,0,0,0), P0[2],P0[3],P0[4],P0[5],     pw0[0]=PKW(P0,0), pw0[1]=PKW(P0,2), pw0); \
    VRD(4); SBAR(); GAPA(C1=__builtin_amdgcn_mfma_f32_32x32x16_bf16(kf[1],qr[0],negm,0,0,0), P0[6],P0[7],P0[8],P0[9],     pw0[2]=PKW(P0,4), pw0[3]=PKW(P0,6), pw0); \
    VRD(1); SBAR(); GAPA(C0=__builtin_amdgcn_mfma_f32_32x32x16_bf16(kf[2],qr[1],C0,0,0,0),   P0[10],P0[11],P0[12],P0[13], pw1[0]=PKW(P0,8), pw1[1]=PKW(P0,10), pw1); \
    VRD(5); SBAR(); GAPA(C1=__builtin_amdgcn_mfma_f32_32x32x16_bf16(kf[3],qr[1],C1,0,0,0),   P0[14],P0[15],P1[0],P1[1],   pw1[2]=PKW(P0,12),pw1[3]=PKW(P0,14), pw1); \
    VRD(2); SBAR(); GAPA(C0=__builtin_amdgcn_mfma_f32_32x32x16_bf16(kf[4],qr[2],C0,0,0,0),   P1[2],P1[3],P1[4],P1[5],     pw2[0]=PKW(P1,0), pw2[1]=PKW(P1,2), pw2); \
    VRD(6); SBAR(); GAPA(C1=__builtin_amdgcn_mfma_f32_32x32x16_bf16(kf[5],qr[2],C1,0,0,0),   P1[6],P1[7],P1[8],P1[9],     pw2[2]=PKW(P1,4), pw2[3]=PKW(P1,6), pw2); \
    VRD(3); SBAR(); GAPA(C0=__builtin_amdgcn_mfma_f32_32x32x16_bf16(kf[6],qr[3],C0,0,0,0),   P1[10],P1[11],P1[12],P1[13], pw3[0]=PKW(P1,8), pw3[1]=PKW(P1,10), pw3); \
    VRD(7); SBAR(); GAPA(C1=__builtin_amdgcn_mfma_f32_32x32x16_bf16(kf[7],qr[3],C1,0,0,0),   P1[14],P1[15],0.f,0.f,       pw3[2]=PKW(P1,12),pw3[3]=PKW(P1,14), pw3); \
    l_reg+=sacc; \
    if(GK){DMA_K((t)+3,sl_cur);} if(GV){DMA_V((t)+1,sl_next);} \
    CMASK(C0,C1,t); \
    { float a=MX3(C0[0],C0[1],C1[0]),b=MX3(C0[2],C0[3],C1[1]); a=MX3(a,C1[2],C1[3]); \
      _Pragma("unroll") for(int r=4;r<16;r+=4){a=MX3(a,C0[r],C0[r+1]);b=MX3(b,C0[r+2],C0[r+3]);a=MX3(a,C1[r],C1[r+1]);b=MX3(b,C1[r+2],C1[r+3]);} \
      float rm=__builtin_fmaxf(a,b); { auto rr=__builtin_amdgcn_permlane32_swap(__float_as_uint(rm),__float_as_uint(rm),false,false); rm=__builtin_fmaxf(__uint_as_float(rr[0]),__uint_as_float(rr[1])); } \
      resc=false; \
      if(__builtin_expect(__any(rm>(float)THRL),0)){ const float dl=__builtin_fmaxf(rm,0.f); mhat+=dl; \
        _Pragma("unroll") for(int r=0;r<16;++r){C0[r]-=dl;C1[r]-=dl;} \
        _Pragma("unroll") for(int r=0;r<16;++r)negm[r]=-mhat; asm volatile("":"+v"(negm)); \
        const float f=__builtin_amdgcn_exp2f(-dl); l_reg*=f; if(hi==0)wsf[r32]=f; resc=true; } } \
    SBAR(); \
    GAPB(o[0]=__builtin_amdgcn_mfma_f32_32x32x16_bf16(PAF(0),VFR(0),o[0],0,0,0), C0,0); \
    GAPB(o[1]=__builtin_amdgcn_mfma_f32_32x32x16_bf16(PAF(0),VFR(4),o[1],0,0,0), C0,4); \
    KRD(GL,0); GAPB(o[0]=__builtin_amdgcn_mfma_f32_32x32x16_bf16(PAF(1),VFR(1),o[0],0,0,0), C0,8); \
    KRD(GL,1); GAPB(o[1]=__builtin_amdgcn_mfma_f32_32x32x16_bf16(PAF(1),VFR(5),o[1],0,0,0), C0,12); \
    KRD(GL,2); GAPB(o[0]=__builtin_amdgcn_mfma_f32_32x32x16_bf16(PAF(2),VFR(2),o[0],0,0,0), C1,0); \
    KRD(GL,3); GAPB(o[1]=__builtin_amdgcn_mfma_f32_32x32x16_bf16(PAF(2),VFR(6),o[1],0,0,0), C1,4); \
    GAPB(o[0]=__builtin_amdgcn_mfma_f32_32x32x16_bf16(PAF(3),VFR(3),o[0],0,0,0), C1,8); \
    GAPB(o[1]=__builtin_amdgcn_mfma_f32_32x32x16_bf16(PAF(3),VFR(7),o[1],0,0,0), C1,12); \
    }while(0)
  int t=1;
  #undef CMASK
  #define CMASK(P0,P1,t) do{}while(0)
  for(;t+5<NT;t+=2){
    STEP(pB0,pB1,pA0,pA1,t,true,true,true);     WAIT_BAR(2); RESC(); ROT();
    STEP(pA0,pA1,pB0,pB1,t+1,true,true,true);   WAIT_BAR(2); RESC(); ROT();
  }
  #undef CMASK
  #define CMASK(P0,P1,t) do{ if(KIND==1){ wmask(P0,P1,64*(t)+koff,qrel,hi); } else { int jb_=(t)-(NT-4); if(jb_>=0)cmask(P0,P1,jb_,qrel,hi); } }while(0)
  #define ENDW(tt) do{ if((tt)+3<NT){WAIT_BAR(2);} else if((tt)+2<NT){WAIT_BAR(1);} else {WAIT_BAR(0);} }while(0)
  for(;t+1<NT;t+=2){
    STEP(pB0,pB1,pA0,pA1,t,(t+3<NT),(t+1<NT),(t+1<NT));       ENDW(t);   RESC(); ROT();
    STEP(pA0,pA1,pB0,pB1,t+1,(t+4<NT),(t+2<NT),(t+2<NT));     ENDW(t+1); RESC(); ROT();
  }
  STEP(pB0,pB1,pA0,pA1,NT-1,false,false,false); RESC();
  { float sacc=pB0[0]+pB0[1]; _Pragma("unroll") for(int r=2;r<16;++r)sacc+=pB0[r]; _Pragma("unroll") for(int r=0;r<16;++r)sacc+=pB1[r]; l_reg+=sacc;
    pw0=(u32x4){PKW(pB0,0),PKW(pB0,2),PKW(pB0,4),PKW(pB0,6)};pw1=(u32x4){PKW(pB0,8),PKW(pB0,10),PKW(pB0,12),PKW(pB0,14)};pw2=(u32x4){PKW(pB1,0),PKW(pB1,2),PKW(pB1,4),PKW(pB1,6)};pw3=(u32x4){PKW(pB1,8),PKW(pB1,10),PKW(pB1,12),PKW(pB1,14)};
    SBAR(); pv(o,vb0+sl_cur,PAF(0),PAF(1),PAF(2),PAF(3)); }
  #undef PKW
  #undef PAF
  #undef VFR
  #undef PIN
  #undef MX3
  #undef GAPA
  #undef GAPB
  #undef EX
  #undef VRD
  #undef KRD
  #undef STEP
  #undef ENDW
  {auto rr=__builtin_amdgcn_permlane32_swap(__float_as_uint(l_reg),__float_as_uint(l_reg),false,false);l_reg=__uint_as_float(rr[0])+__uint_as_float(rr[1]);}
  if(KIND==1)l_reg+=__builtin_amdgcn_exp2f((wh?ep.sink2b:ep.sink2)-mhat);
  if(hi==0)wsf[32+r32]=l_reg;asm volatile("s_waitcnt lgkmcnt(0)":::"memory");
  float rli[16];
  #pragma unroll
  for(int r=0;r<16;++r)rli[r]=__builtin_amdgcn_rcpf(wsf[32+crow(r,hi)]);
  bf16*stg=(bf16*)(shm+LDS_OST)+wid*2048;
  #define STAGE_OUT(EXPR,OPTR) do{ \
    _Pragma("unroll") for(int r=0;r<16;++r){const int orow=crow(r,hi); _Pragma("unroll") for(int d0=0;d0<2;++d0){ const float val_=(EXPR); stg[orow*64+d0*32+r32]=(bf16)f2bf(val_);} } \
    asm volatile("s_waitcnt lgkmcnt(0)":::"memory"); \
    _Pragma("unroll") for(int i=0;i<4;++i){const int row=i*8+(lane>>3),ch=lane&7; const u32x4 v=*(const u32x4*)(stg+row*64+ch*8); *(u32x4*)((OPTR)+(long)(wq*QBLK+row)*1024+wh*64+ch*8)=v;} \
    asm volatile("s_waitcnt lgkmcnt(0)":::"memory"); }while(0)
  if(KIND==1){
    STAGE_OUT(o[d0][r]*rli[r],ep.O);
  } else {
    float*st=ep.stash+(size_t)(blockIdx.x*NW+wid)*6144+lane;
    const int mode=ep.mode;
    if(mode==0||mode==2){
      #pragma unroll
      for(int d0=0;d0<2;++d0)
        #pragma unroll
        for(int r=0;r<16;++r)st[(d0*16+r)*64]=o[d0][r]*rli[r];
    } else if(mode==1){
      float ssq[16];
      #pragma unroll
      for(int r=0;r<16;++r)ssq[r]=0.f;
      #pragma unroll
      for(int d0=0;d0<2;++d0)
        #pragma unroll
        for(int r=0;r<16;++r){const float rv=st[(d0*16+r)*64]-ep.lam*(o[d0][r]*rli[r]); st[2048+(d0*16+r)*64]=rv; ssq[r]+=rv*rv;}
      #pragma unroll
      for(int r=0;r<16;++r)st[4096+r*64]=ssq[r];
    } else {
      float ssq[16];
      #pragma unroll
      for(int r=0;r<16;++r)ssq[r]=st[4096+r*64];
      #pragma unroll
      for(int d0=0;d0<2;++d0)
        #pragma unroll
        for(int r=0;r<16;++r){const float rv=st[(d0*16+r)*64]-ep.lam*(o[d0][r]*rli[r]); o[d0][r]=rv; ssq[r]+=rv*rv;}
      #pragma unroll
      for(int r=0;r<16;++r){
        #pragma unroll
        for(int k=1;k<32;k<<=1)ssq[r]+=__shfl_xor(ssq[r],k);
        ssq[r]=0.8f/sqrtf(ssq[r]*(1.f/128.f)+1e-6f);
      }
      float g0[2],g1[2];
      #pragma unroll
      for(int d0=0;d0<2;++d0){g0[d0]=ep.subln[d0*32+r32];g1[d0]=ep.subln[64+d0*32+r32];}
      STAGE_OUT(st[2048+(d0*16+r)*64]*ssq[r]*g0[d0],ep.O);
      STAGE_OUT(o[d0][r]*ssq[r]*g1[d0],ep.O+64);
    }
  }
  #undef STAGE_OUT
  asm volatile("s_waitcnt lgkmcnt(0)\n\ts_barrier":::"memory");
  #undef DMA_K
  #undef DMA_V
  #undef CMASK
  #undef START
  #undef RESC
  #undef ROT
}
constexpr int V2SLOT=2*SLOTB, L2_K=0, L2_V=NSLOT*SLOTB, L2_WS=L2_V+NSLOT*V2SLOT, L2_OST=L2_WS+NW*64*4, L2_BYTES=L2_OST+NW*4096;
template<int THRL> __device__ __forceinline__ void attn_unit128(const bf16*Qu,const bf16*__restrict__ Kh,const bf16*__restrict__ Vh,const int NT,const EpiArgs ep,char*shm){
  constexpr int DM=1024, QP=1024;
  int tid_=threadIdx.x; asm volatile("":"+v"(tid_));
  const int tid=tid_,lane=tid&63,r32=lane&31,hi=lane>>5; const int wid=__builtin_amdgcn_readfirstlane(tid>>6);
  const bf16*Qw=Qu+(long)(wid*QBLK)*QP;
  const unsigned lds0=(unsigned)(uintptr_t)shm;
  float*wsf=(float*)(shm+L2_WS)+wid*64;
  const bf16*ksrc=Kh+(long)lane*DM+wid*8;
  const bf16*vsrc=Vh+(long)(16*(wid&3)+(lane>>2))*DM+(wid>>2)*32+(lane&3)*8;
  const unsigned kdst=lds0+L2_K+wid*1024, vdst=lds0+L2_V+wid*1024;
  #define DMA_K(t,slot) glds16(ksrc+(long)(t)*KVBLK*DM,(unsigned)__builtin_amdgcn_readfirstlane(kdst+(slot)))
  #define DMA_V(t,slot) do{ glds16(vsrc+(long)(t)*KVBLK*DM,(unsigned)__builtin_amdgcn_readfirstlane(vdst+2*(slot))); glds16(vsrc+(long)(t)*KVBLK*DM+64,(unsigned)__builtin_amdgcn_readfirstlane(vdst+2*(slot)+8192)); }while(0)
  const int vb0=(int)(lds0+L2_V)+((lane>>4)&1)*32+(lane&3)*8+(4*hi+((lane&15)>>2))*64;
  const char*Kbase=shm+L2_K; bf16x8 kf[8];
  const lds_cptr shm3=(lds_cptr)shm; const lds_cptr kp0=shm3+L2_K+hi*1024+r32*16; const lds_cptr vp0=shm3+L2_V+((lane>>4)&1)*32+(lane&3)*8+(4*hi+((lane&15)>>2))*64;
  DMA_K(0,0);DMA_V(0,0);DMA_K(1,SLOTB);
  bf16x8 qr[4];
  #pragma unroll
  for(int d0=0;d0<4;++d0)qr[d0]=*reinterpret_cast<const bf16x8*>(&Qw[(long)r32*QP+d0*16+hi*8]);
  float mhat=0.f,l_reg=0.f;f32x16 o[4];o[0]=f32x16{};o[1]=f32x16{};o[2]=f32x16{};o[3]=f32x16{};
  const f32x16 zero16=f32x16{};
  const int qrel=wid*QBLK+r32;
  #define CMASK(P0,P1,t) do{ int jb_=(t)-(NT-4); if(jb_>=0)cmask(P0,P1,jb_,qrel,hi); }while(0)
  bool resc=false;
  #define RESC() do{ if(resc){ asm volatile("s_waitcnt lgkmcnt(0)":::"memory"); \
      _Pragma("unroll") for(int d_=0;d_<4;++d_) _Pragma("unroll") for(int r=0;r<16;++r)o[d_][r]*=wsf[crow(r,hi)]; } }while(0)
  f32x16 pA0,pA1,pB0,pB1;
  int sl_prev=0,sl_cur=0,sl_next=SLOTB;
  #define ROT() do{sl_prev=sl_cur;sl_cur=sl_next;sl_next=(sl_next==(NSLOT-1)*SLOTB)?0:sl_next+SLOTB;}while(0)
  DMA_K(2,2*SLOTB);
  WAIT_BAR(4);
  qkt(pA0,pA1,Kbase,qr,zero16,r32,hi);asm volatile("s_nop 15\n\ts_nop 7":"+v"(pA0),"+v"(pA1));CMASK(pA0,pA1,0);
  { const float rm=rowmax(pA0,pA1); mhat=rm;
    _Pragma("unroll") for(int r=0;r<16;++r)pA0[r]=__builtin_amdgcn_exp2f(pA0[r]-mhat);
    _Pragma("unroll") for(int r=0;r<16;++r)pA1[r]=__builtin_amdgcn_exp2f(pA1[r]-mhat); }
  WAIT_BAR(0);
  DMA_K(3,0);DMA_V(1,SLOTB);
  ROT();
  kload8(kf,kp0+sl_cur);
  WAIT_BAR(3);
  s16x4 vlo[8],vhi[8]; u32x4 pw0,pw1,pw2,pw3;
  #define PKW(P,B) cvtpk_s(P[B],P[B+1])
  #define PAF(k) __builtin_bit_cast(bf16x8,pw##k)
  #define VFR(i) (bf16x8){vlo[i][0],vlo[i][1],vlo[i][2],vlo[i][3],vhi[i][0],vhi[i][1],vhi[i][2],vhi[i][3]}
  #define PIN(x) asm volatile("":"+v"(x))
  #define MX3(a,b,c) __builtin_fmaxf(__builtin_fmaxf((a),(b)),(c))
  #define GAPA(MF,A0,A1,A2,A3,W0,W1,PW) do{ MF; sacc+=A0; sacc+=A1; sacc+=A2; sacc+=A3; PIN(sacc); W0; W1; PIN(PW); SBAR(); }while(0)
  #define EX(v) __builtin_amdgcn_exp2f((v)-mh_)
  #define GAPB(MF,X,B) do{ MF; X[B]=EX(X[B]); X[B+1]=EX(X[B+1]); PIN(X); SBAR(); }while(0)
  #define VRD(i) do{ vlo[i]=vtr(vp_+(((i)>>2)*4096+((i)&3)*1024)); vhi[i]=vtr(vp_+(((i)>>2)*4096+((i)&3)*1024+512)); }while(0)
  #define VRD2(i) do{ vlo[i]=vtr(vp_+(8192+((i)>>2)*4096+((i)&3)*1024)); vhi[i]=vtr(vp_+(8192+((i)>>2)*4096+((i)&3)*1024+512)); SBAR(); }while(0)
  #define KRD(G,j) do{ if(G){ kload2(kf,kp0+sl_next,j); SBAR(); } }while(0)
  #define STEP(C0,C1,P0,P1,t,GK,GV,GL) do{ SBAR(); \
    const lds_cptr vp_=vp0+2*sl_prev; \
    VRD(0); SBAR(); float sacc=(P0[0]+P0[1]); \
    GAPA(C0=__builtin_amdgcn_mfma_f32_32x32x16_bf16(kf[0],qr[0],zero16,0,0,0), P0[2],P0[3],P0[4],P0[5],     pw0[0]=PKW(P0,0), pw0[1]=PKW(P0,2), pw0); \
    VRD(4); SBAR(); GAPA(C1=__builtin_amdgcn_mfma_f32_32x32x16_bf16(kf[1],qr[0],zero16,0,0,0), P0[6],P0[7],P0[8],P0[9],     pw0[2]=PKW(P0,4), pw0[3]=PKW(P0,6), pw0); \
    VRD(1); SBAR(); GAPA(C0=__builtin_amdgcn_mfma_f32_32x32x16_bf16(kf[2],qr[1],C0,0,0,0),   P0[10],P0[11],P0[12],P0[13], pw1[0]=PKW(P0,8), pw1[1]=PKW(P0,10), pw1); \
    VRD(5); SBAR(); GAPA(C1=__builtin_amdgcn_mfma_f32_32x32x16_bf16(kf[3],qr[1],C1,0,0,0),   P0[14],P0[15],P1[0],P1[1],   pw1[2]=PKW(P0,12),pw1[3]=PKW(P0,14), pw1); \
    VRD(2); SBAR(); GAPA(C0=__builtin_amdgcn_mfma_f32_32x32x16_bf16(kf[4],qr[2],C0,0,0,0),   P1[2],P1[3],P1[4],P1[5],     pw2[0]=PKW(P1,0), pw2[1]=PKW(P1,2), pw2); \
    VRD(6); SBAR(); GAPA(C1=__builtin_amdgcn_mfma_f32_32x32x16_bf16(kf[5],qr[2],C1,0,0,0),   P1[6],P1[7],P1[8],P1[9],     pw2[2]=PKW(P1,4), pw2[3]=PKW(P1,6), pw2); \
    VRD(3); SBAR(); GAPA(C0=__builtin_amdgcn_mfma_f32_32x32x16_bf16(kf[6],qr[3],C0,0,0,0),   P1[10],P1[11],P1[12],P1[13], pw3[0]=PKW(P1,8), pw3[1]=PKW(P1,10), pw3); \
    VRD(7); SBAR(); GAPA(C1=__builtin_amdgcn_mfma_f32_32x32x16_bf16(kf[7],qr[3],C1,0,0,0),   P1[14],P1[15],0.f,0.f,       pw3[2]=PKW(P1,12),pw3[3]=PKW(P1,14), pw3); \
    l_reg+=sacc; \
    if(GK){DMA_K((t)+3,sl_cur);} if(GV){DMA_V((t)+1,sl_next);} \
    CMASK(C0,C1,t); \
    { float a=MX3(C0[0],C0[1],C1[0]),b=MX3(C0[2],C0[3],C1[1]); a=MX3(a,C1[2],C1[3]); \
      _Pragma("unroll") for(int r=4;r<16;r+=4){a=MX3(a,C0[r],C0[r+1]);b=MX3(b,C0[r+2],C0[r+3]);a=MX3(a,C1[r],C1[r+1]);b=MX3(b,C1[r+2],C1[r+3]);} \
      float rm=__builtin_fmaxf(a,b); { auto rr=__builtin_amdgcn_permlane32_swap(__float_as_uint(rm),__float_as_uint(rm),false,false); rm=__builtin_fmaxf(__uint_as_float(rr[0]),__uint_as_float(rr[1])); } \
      resc=false; \
      if(__builtin_expect(__any(rm-mhat>(float)THRL),0)){ const float dl=__builtin_fmaxf(rm-mhat,0.f); mhat+=dl; \
        const float f=__builtin_amdgcn_exp2f(-dl); l_reg*=f; if(hi==0)wsf[r32]=f; resc=true; } } \
    const float mh_=mhat; \
    SBAR(); \
    GAPB(o[0]=__builtin_amdgcn_mfma_f32_32x32x16_bf16(PAF(0),VFR(0),o[0],0,0,0), C0,0);  VRD2(0); \
    GAPB(o[1]=__builtin_amdgcn_mfma_f32_32x32x16_bf16(PAF(0),VFR(4),o[1],0,0,0), C0,2);  VRD2(4); \
    GAPB(o[0]=__builtin_amdgcn_mfma_f32_32x32x16_bf16(PAF(1),VFR(1),o[0],0,0,0), C0,4);  VRD2(1); \
    GAPB(o[1]=__builtin_amdgcn_mfma_f32_32x32x16_bf16(PAF(1),VFR(5),o[1],0,0,0), C0,6);  VRD2(5); \
    GAPB(o[0]=__builtin_amdgcn_mfma_f32_32x32x16_bf16(PAF(2),VFR(2),o[0],0,0,0), C0,8);  VRD2(2); \
    GAPB(o[1]=__builtin_amdgcn_mfma_f32_32x32x16_bf16(PAF(2),VFR(6),o[1],0,0,0), C0,10); VRD2(6); \
    GAPB(o[0]=__builtin_amdgcn_mfma_f32_32x32x16_bf16(PAF(3),VFR(3),o[0],0,0,0), C0,12); VRD2(3); \
    GAPB(o[1]=__builtin_amdgcn_mfma_f32_32x32x16_bf16(PAF(3),VFR(7),o[1],0,0,0), C0,14); VRD2(7); \
    GAPB(o[2]=__builtin_amdgcn_mfma_f32_32x32x16_bf16(PAF(0),VFR(0),o[2],0,0,0), C1,0); \
    GAPB(o[3]=__builtin_amdgcn_mfma_f32_32x32x16_bf16(PAF(0),VFR(4),o[3],0,0,0), C1,2); \
    KRD(GL,0); GAPB(o[2]=__builtin_amdgcn_mfma_f32_32x32x16_bf16(PAF(1),VFR(1),o[2],0,0,0), C1,4); \
    KRD(GL,1); GAPB(o[3]=__builtin_amdgcn_mfma_f32_32x32x16_bf16(PAF(1),VFR(5),o[3],0,0,0), C1,6); \
    KRD(GL,2); GAPB(o[2]=__builtin_amdgcn_mfma_f32_32x32x16_bf16(PAF(2),VFR(2),o[2],0,0,0), C1,8); \
    KRD(GL,3); GAPB(o[3]=__builtin_amdgcn_mfma_f32_32x32x16_bf16(PAF(2),VFR(6),o[3],0,0,0), C1,10); \
    GAPB(o[2]=__builtin_amdgcn_mfma_f32_32x32x16_bf16(PAF(3),VFR(3),o[2],0,0,0), C1,12); \
    GAPB(o[3]=__builtin_amdgcn_mfma_f32_32x32x16_bf16(PAF(3),VFR(7),o[3],0,0,0), C1,14); \
    }while(0)
  int t=1;
  #undef CMASK
  #define CMASK(P0,P1,t) do{}while(0)
  for(;t+5<NT;t+=2){
    STEP(pB0,pB1,pA0,pA1,t,true,true,true);     WAIT_BAR(3); RESC(); ROT();
    STEP(pA0,pA1,pB0,pB1,t+1,true,true,true);   WAIT_BAR(3); RESC(); ROT();
  }
  #undef CMASK
  #define CMASK(P0,P1,t) do{ int jb_=(t)-(NT-4); if(jb_>=0)cmask(P0,P1,jb_,qrel,hi); }while(0)
  #define ENDW(tt) do{ if((tt)+3<NT){WAIT_BAR(3);} else if((tt)+2<NT){WAIT_BAR(2);} else {WAIT_BAR(0);} }while(0)
  for(;t+1<NT;t+=2){
    STEP(pB0,pB1,pA0,pA1,t,(t+3<NT),(t+1<NT),(t+1<NT));       ENDW(t);   RESC(); ROT();
    STEP(pA0,pA1,pB0,pB1,t+1,(t+4<NT),(t+2<NT),(t+2<NT));     ENDW(t+1); RESC(); ROT();
  }
  STEP(pB0,pB1,pA0,pA1,NT-1,false,false,false); RESC();
  { float sacc=pB0[0]+pB0[1]; _Pragma("unroll") for(int r=2;r<16;++r)sacc+=pB0[r]; _Pragma("unroll") for(int r=0;r<16;++r)sacc+=pB1[r]; l_reg+=sacc;
    pw0=(u32x4){PKW(pB0,0),PKW(pB0,2),PKW(pB0,4),PKW(pB0,6)};pw1=(u32x4){PKW(pB0,8),PKW(pB0,10),PKW(pB0,12),PKW(pB0,14)};pw2=(u32x4){PKW(pB1,0),PKW(pB1,2),PKW(pB1,4),PKW(pB1,6)};pw3=(u32x4){PKW(pB1,8),PKW(pB1,10),PKW(pB1,12),PKW(pB1,14)};
    SBAR(); pv(o,vb0+2*sl_cur,PAF(0),PAF(1),PAF(2),PAF(3)); pv(o+2,vb0+2*sl_cur+8192,PAF(0),PAF(1),PAF(2),PAF(3)); }
  #undef PKW
  #undef PAF
  #undef VFR
  #undef PIN
  #undef MX3
  #undef GAPA
  #undef GAPB
  #undef EX
  #undef VRD
  #undef VRD2
  #undef KRD
  #undef STEP
  #undef ENDW
  {auto rr=__builtin_amdgcn_permlane32_swap(__float_as_uint(l_reg),__float_as_uint(l_reg),false,false);l_reg=__uint_as_float(rr[0])+__uint_as_float(rr[1]);}
  if(hi==0)wsf[32+r32]=l_reg;asm volatile("s_waitcnt lgkmcnt(0)":::"memory");
  float rli[16];
  #pragma unroll
  for(int r=0;r<16;++r)rli[r]=__builtin_amdgcn_rcpf(wsf[32+crow(r,hi)]);
  bf16*stg=(bf16*)(shm+L2_OST)+wid*2048;
  #define STAGE_OUT(EXPR,OPTR) do{ \
    _Pragma("unroll") for(int r=0;r<16;++r){const int orow=crow(r,hi); _Pragma("unroll") for(int d0=0;d0<2;++d0){ const float val_=(EXPR); stg[orow*64+d0*32+r32]=(bf16)f2bf(val_);} } \
    asm volatile("s_waitcnt lgkmcnt(0)":::"memory"); \
    _Pragma("unroll") for(int i=0;i<4;++i){const int row=i*8+(lane>>3),ch=lane&7; const u32x4 v=*(const u32x4*)(stg+row*64+ch*8); *(u32x4*)((OPTR)+(long)(wid*QBLK+row)*1024+ch*8)=v;} \
    asm volatile("s_waitcnt lgkmcnt(0)":::"memory"); }while(0)
  float*st=ep.stash+(size_t)(blockIdx.x*NW+wid)*6144+lane;
  if(ep.mode==0){
    #pragma unroll
    for(int dq=0;dq<4;++dq)
      #pragma unroll
      for(int r=0;r<16;++r)st[(dq*16+r)*64]=o[dq][r]*rli[r];
  } else {
    float ssq[16];
    #pragma unroll
    for(int r=0;r<16;++r)ssq[r]=0.f;
    #pragma unroll
    for(int dq=0;dq<4;++dq)
      #pragma unroll
      for(int r=0;r<16;++r){const float rv=st[(dq*16+r)*64]-ep.lam*(o[dq][r]*rli[r]); o[dq][r]=rv; ssq[r]+=rv*rv;}
    #pragma unroll
    for(int r=0;r<16;++r){
      #pragma unroll
      for(int k=1;k<32;k<<=1)ssq[r]+=__shfl_xor(ssq[r],k);
      ssq[r]=0.8f/sqrtf(ssq[r]*(1.f/128.f)+1e-6f);
    }
    float g0[2],g1[2];
    #pragma unroll
    for(int d0=0;d0<2;++d0){g0[d0]=ep.subln[d0*32+r32];g1[d0]=ep.subln[64+d0*32+r32];}
    STAGE_OUT(o[d0][r]*ssq[r]*g0[d0],ep.O);
    STAGE_OUT(o[2+d0][r]*ssq[r]*g1[d0],ep.O+64);
  }
  #undef STAGE_OUT
  asm volatile("s_waitcnt lgkmcnt(0)\n\ts_barrier":::"memory");
  #undef DMA_K
  #undef DMA_V
  #undef CMASK
  #undef RESC
  #undef ROT
}
constexpr int ATTN_LDS_BYTES=LDS_BYTES;
#undef SBAR
#undef WAIT_BAR
}


__device__ __forceinline__ void phase_attn_fast(const Params& p, char* ldsg) {
    const int G = gridDim.x, bx = blockIdx.x, vcu = (G % 8 == 0) ? (bx % 8) * (G / 8) + bx / 8 : bx;
    const att::bf16* QA = (const att::bf16*)(p.ws + WS_QA); const att::bf16* KA = (const att::bf16*)(p.ws + WS_KA); const att::bf16* VA = (const att::bf16*)(p.ws + WS_VA);
    const att::bf16* QD = (const att::bf16*)(p.ws + WS_QD); const att::bf16* KD = (const att::bf16*)(p.ws + WS_KD); const att::bf16* VD = (const att::bf16*)(p.ws + WS_VD);
    att::bf16* OA = (att::bf16*)(p.ws + WS_OA); att::bf16* OB = (att::bf16*)(p.ws + WS_OB);
    const int UPW = (1024 + G - 1) / G;
    for (int uid = vcu * UPW; uid < (vcu + 1) * UPW && uid < 1024; ++uid) {
        const int grp = uid >> 6, uidx = uid & 63, b = grp >> 1, kvh = grp & 1, qh = kvh * 8 + 2 * (uidx >> 4), qb = uidx & 15;
        const int q0 = 128 * qb, t0 = (2 * qb - 2 < 0) ? 0 : 2 * qb - 2, koff = 64 * t0 - q0;
        att::EpiArgs ep; ep.mode = 0; ep.lam = 0.f; ep.sink2 = p.sinks[qh] * LOG2E; ep.sink2b = p.sinks[qh + 1] * LOG2E; ep.stash = nullptr; ep.subln = nullptr; ep.O = OA + (size_t)(b * NS + q0) * 1024 + qh * 64;
        att::attn_unit<1, 1024, 128, 8>(QA + (size_t)(b * NS + q0) * 1024 + qh * 64, KA + (size_t)(b * NS + 64 * t0) * 128 + kvh * 64, VA + (size_t)(b * NS + 64 * t0) * 128 + kvh * 64, 4, koff, ep, ldsg);
    }
    const float lam = diff_lambda(p);
#ifndef REP_DIFF
#define REP_DIFF 1
#endif
#if DIFF128
    for (int rep_ = 0; rep_ < REP_DIFF; ++rep_)
    for (int slot = vcu; slot < 256; slot += G) {
        const int bh = slot >> 2, s = slot & 3, b = bh >> 3, h = bh & 7;
        for (int i = 0; i < 4; ++i) {
            const int qb = (i < 2) ? 7 - s : s, c = i & 1, q0 = 256 * qb;
            att::EpiArgs ep; ep.mode = c; ep.lam = lam; ep.sink2 = 0.f; ep.sink2b = 0.f; ep.stash = (float*)(p.ws + WS_TMP); ep.subln = p.subln; ep.O = OB + (size_t)(b * NS + q0) * 1024 + h * 128;
            att::attn_unit128<8>(QD + (size_t)(b * NS + q0) * 1024 + (2 * h + c) * 64, KD + (size_t)(b * NS) * 1024 + (2 * h + c) * 64, VD + (size_t)(b * NS) * 1024 + h * 128, 4 * qb + 4, ep, ldsg);
        }
    }
#else
    for (int rep_ = 0; rep_ < REP_DIFF; ++rep_)
    for (int slot = vcu; slot < 256; slot += G) {
        const int bh = slot >> 2, s = slot & 3, b = bh >> 3, h = bh & 7;
        for (int i = 0; i < 8; ++i) {
            const int qb = (i < 4) ? 7 - s : s, piece = i & 3, c = piece & 1, vh = piece >> 1, q0 = 256 * qb;
            att::EpiArgs ep; ep.mode = piece; ep.lam = lam; ep.sink2 = 0.f; ep.sink2b = 0.f; ep.stash = (float*)(p.ws + WS_TMP); ep.subln = p.subln; ep.O = OB + (size_t)(b * NS + q0) * 1024 + h * 128;
            att::attn_unit<0, 1024, 1024, 8>(QD + (size_t)(b * NS + q0) * 1024 + (2 * h + c) * 64, KD + (size_t)(b * NS) * 1024 + (2 * h + c) * 64, VD + (size_t)(b * NS) * 1024 + h * 128 + vh * 64, 4 * qb + 4, -q0, ep, ldsg);
        }
    }
#endif
}

struct BrA { const bf16_t* OA; const bf16_t* OB; int row0; __device__ __forceinline__ const bf16_t* operator()(int r, int k0) const { return (k0 < 1024 ? OA + k0 : OB + (k0 - 1024)) + (size_t)(row0 + r) * 1024; } };
struct BrB { const bf16_t* WA; const bf16_t* WB; int col0; __device__ __forceinline__ const bf16_t* operator()(int n, int k0) const { return (k0 < 1024 ? WA + k0 : WB + (k0 - 1024)) + (size_t)(col0 + n) * 1024; } };
__device__ __forceinline__ void load4bf(const bf16_t* p, f32x4& v) { const u32x2 w = *(const u32x2*)p; v.x = bf2f(w.x & 0xffffu); v.y = bf2f(w.x >> 16); v.z = bf2f(w.y & 0xffffu); v.w = bf2f(w.y >> 16); }
struct BrMid { const bf16_t* G; int row0, col0;
    __device__ __forceinline__ void operator()(int r, int c, f32x4& v) const { f32x4 sa, sb; const bf16_t* g = G + (size_t)(row0 + r) * 4096 + col0 + c; load4bf(g, sa); load4bf(g + 2048, sb);
        v.x *= sa.x / sb.x; v.y *= sa.y / sb.y; v.z *= sa.z / sb.z; v.w *= sa.w / sb.w; } };
struct BrEpi { const bf16_t* G; bf16_t* MG; int row0, col0;
    __device__ __forceinline__ void operator()(int r, int c, f32x4& v) const { f32x4 sb; load4bf(G + (size_t)(row0 + r) * 4096 + 2048 + col0 + c, sb);
        u32x2 w; w.x = pk2(v.x * sb.x, v.y * sb.y); w.y = pk2(v.z * sb.z, v.w * sb.w); *(u32x2*)(MG + (size_t)(row0 + r) * ND + col0 + c) = w; } };
__device__ __forceinline__ void phase_branch_naive(const Params& p, LAS unsigned char* lds, const Ctx& cx) {
    constexpr int NTN = ND / 64, NT = (NM / 64) * NTN;
    for (int t = blockIdx.x; t < NT; t += gridDim.x) {
        const int tm = t / NTN, tn = t % NTN;
        BrA af{(const bf16_t*)(p.ws + WS_OA), (const bf16_t*)(p.ws + WS_OB), tm * 64}; BrB bf{(const bf16_t*)(p.ws + WS_WAT), (const bf16_t*)(p.ws + WS_WBT), tn * 64};
        BrMid mf{(const bf16_t*)(p.ws + WS_G), tm * 64, tn * 64}; BrEpi ef{(const bf16_t*)(p.ws + WS_G), (bf16_t*)(p.ws + WS_MERGED), tm * 64, tn * 64};
        ngemm_tile(lds, 2048, 1024, af, bf, mf, ef, cx.tid);
    }
}
struct OutB { const bf16_t* W; int col0; __device__ __forceinline__ const bf16_t* operator()(int n, int k0) const { return W + (size_t)(col0 + n) * ND + k0; } };
struct OutEpi { const float* x; const float* mod; float* xmid; int row0, col0;
    __device__ __forceinline__ void operator()(int r, int c, f32x4& v) const { const int row = row0 + r, col = col0 + c, b = row / NS;
        const f32x4 xv = *(const f32x4*)(x + (size_t)row * ND + col), gt = *(const f32x4*)(mod + (size_t)b * 12288 + 4096 + col);
        *(f32x4*)(xmid + (size_t)row * ND + col) = xv + gt * v; } };
__device__ __forceinline__ void phase_out_naive(const Params& p, LAS unsigned char* lds, const Ctx& cx) {
    constexpr int NTN = ND / 64, NT = (NM / 64) * NTN;
    for (int t = blockIdx.x; t < NT; t += gridDim.x) {
        const int tm = t / NTN, tn = t % NTN;
        InA af{(const bf16_t*)(p.ws + WS_MERGED), tm * 64}; OutB bf{(const bf16_t*)(p.ws + WS_WOUTT), tn * 64};
        OutEpi ef{p.x, (const float*)(p.ws + WS_MOD), (float*)(p.ws + WS_XMID), tm * 64, tn * 64};
        ngemm_tile(lds, ND, -1, af, bf, NoMid(), ef, cx.tid);
    }
}


namespace pg8 {
typedef short bf16x8 __attribute__((ext_vector_type(8)));
constexpr int BM = 256, BK = 64, HALF = 128, HTB = HALF * BK * 2, STAGE_BYTES = 8 * HTB, NXCD = 8, WGM = 4;
__host__ __device__ __forceinline__ int lds_byte(int r, int c) { const int st = (r >> 4) * 2 + (c >> 5), rr = r & 15, cc = c & 31, ob = rr * 64 + cc * 2; return st * 1024 + (ob ^ (((ob >> 9) & 1) << 5)); }
__host__ __device__ __forceinline__ void stage_rc(int b, int& R, int& C) { const int st = b / 1024, sb = b % 1024, swz = sb ^ (((sb >> 9) & 1) << 5); R = (st >> 1) * 16 + swz / 64; C = (st & 1) * 32 + (swz % 64) / 2; }
__host__ __device__ __forceinline__ int perm32(int rho) { const int n = rho >> 4, i = rho & 15; return 8 * (i >> 2) + 4 * n + (i & 3); }
__device__ __forceinline__ unsigned cvt_pk_bf16(float lo, float hi) { unsigned r; asm volatile("v_cvt_pk_bf16_f32 %0, %1, %2" : "=v"(r) : "v"(lo), "v"(hi)); return r; }

struct Unit { int pm, pn, e, a, b; };

struct GridOrder {
    int nM, nN, nwg, G, c;
    __device__ __forceinline__ void init(int nM_, int nN_, int G_, int c_) { nM = nM_; nN = nN_; nwg = nM * nN; G = G_; c = c_; }
    __device__ __forceinline__ bool tile(int i, int& pm, int& pn) const {
        const long L = (long)i * G + c; if (L >= nwg) return false;
        int wgid = (int)L; { const int q = nwg / NXCD, r = nwg % NXCD, xcd = wgid % NXCD, off = wgid / NXCD; wgid = (xcd < r ? xcd * (q + 1) : r * (q + 1) + (xcd - r) * q) + off; }
        const int nig = WGM * nN, gid = wgid / nig, fm = gid * WGM, gsz = (nM - fm) < WGM ? (nM - fm) : WGM;
        pm = fm + ((wgid % nig) % gsz); pn = (wgid % nig) / gsz; return true;
    }
};

template <class Epi, class Sched, bool ALIGN_EPI>
__device__ __forceinline__ void gemm_phase(LAS unsigned char* lds, const int K, const Sched& S, const Epi& E) {
    int tid_ = threadIdx.x; asm volatile("" : "+v"(tid_));
    const int tid = tid_, wid = __builtin_amdgcn_readfirstlane(tid >> 6), lane = tid & 63, wr = wid >> 2, wc = wid & 3, fr = lane & 15, fq = lane >> 4;
    const int nt = K / BK;
    int sR[2], sC[2]; unsigned voffB[2];
#pragma unroll
    for (int i = 0; i < 2; ++i) { int R, C; stage_rc(tid * 16 + i * 8192, R, C); sR[i] = R; sC[i] = C; const int Rb = Epi::PERM ? ((R & ~31) + perm32(R & 31)) : R; voffB[i] = (unsigned)(Rb * K + C) * 2u; }
    const size_t kstep = (size_t)(BK * 2);
    const size_t hstep = (size_t)HALF * K * 2;
    const unsigned ldsw = (unsigned)wid * 1024u;
    const int aoff = lds_byte(wr * 64 + fr, fq * 8), boff = lds_byte(wc * 32 + fr, fq * 8);
#define PG8_SA(b, h) (((b) * 2 + (h)) * HTB)
#define PG8_SB(b, h) ((4 + (b) * 2 + (h)) * HTB)
#define PG8_STAGE(bufoff, gbase, voff) do { _Pragma("unroll") for (int _i = 0; _i < 2; ++_i) \
        __builtin_amdgcn_global_load_lds((const unsigned*)((const char*)(gbase) + (voff)[_i]), (LAS unsigned*)(lds + (bufoff) + ldsw + _i * 8192), 16, 0, 0); } while (0)
#define PG8_LDA(dst, b, h) do { _Pragma("unroll") for (int m = 0; m < 4; ++m) _Pragma("unroll") for (int k = 0; k < 2; ++k) dst[m][k] = *(const LAS bf16x8*)(lds + PG8_SA(b, h) + aoff + m * 2048 + k * 1024); } while (0)
#define PG8_LDB(dst, b, h) do { _Pragma("unroll") for (int n = 0; n < 2; ++n) _Pragma("unroll") for (int k = 0; k < 2; ++k) dst[n][k] = *(const LAS bf16x8*)(lds + PG8_SB(b, h) + boff + n * 2048 + k * 1024); } while (0)
#define PG8_MMA(ai, bj, At, Bt) do { __builtin_amdgcn_s_setprio(1); _Pragma("unroll") for (int m = 0; m < 4; ++m) _Pragma("unroll") for (int n = 0; n < 2; ++n) _Pragma("unroll") for (int k = 0; k < 2; ++k) \
        acc[ai][bj][m][n] = __builtin_amdgcn_mfma_f32_16x16x32_bf16(Bt[n][k], At[m][k], acc[ai][bj][m][n], 0, 0, 0); __builtin_amdgcn_s_setprio(0); } while (0)
#define PG8_WAIT_V(n) asm volatile("s_waitcnt vmcnt(" #n ")" ::: "memory")
#define PG8_WAIT_L(n) asm volatile("s_waitcnt lgkmcnt(" #n ")" ::: "memory")
#define PG8_BAR __builtin_amdgcn_s_barrier()
#define PG8_SCHED __builtin_amdgcn_sched_barrier(0)
    Unit cur, nxt; int ui = 0;
    if (!S.next(0, cur)) return;
    f32x4 acc[2][2][4][2];
#pragma unroll
    for (int a = 0; a < 2; ++a)
#pragma unroll
        for (int b = 0; b < 2; ++b)
#pragma unroll
            for (int m = 0; m < 4; ++m)
#pragma unroll
                for (int n = 0; n < 2; ++n) acc[a][b][m][n] = (f32x4){0.f, 0.f, 0.f, 0.f};
    bf16x8 At[4][2], B0[2][2], B1[2][2];
    const char* cA; const char* cB; S.ptrs(cur, cA, cB);
    unsigned voffA[2][2], voffX[2][2];
    S.voff(cur, sR, sC, voffA);
#pragma unroll
    for (int h = 0; h < 2; ++h)
#pragma unroll
        for (int i = 0; i < 2; ++i) voffX[h][i] = voffA[h][i];
    PG8_STAGE(PG8_SB(0, 0), cB, voffB); PG8_STAGE(PG8_SB(0, 1), cB + hstep, voffB); PG8_STAGE(PG8_SA(0, 0), cA, voffA[0]); PG8_STAGE(PG8_SA(0, 1), cA, voffA[1]);
    if (wr == 1) PG8_BAR;
    PG8_WAIT_V(2); PG8_BAR;
    PG8_STAGE(PG8_SB(1, 0), cB + kstep, voffB); PG8_STAGE(PG8_SA(1, 0), cA + kstep, voffA[0]); PG8_STAGE(PG8_SB(1, 1), cB + hstep + kstep, voffB);
    PG8_WAIT_V(6); PG8_BAR;
    for (;;) {
        const bool has_next = S.next(ui + 1, nxt);
        const char* nA = cA; const char* nB = cB; if (has_next) S.ptrs(nxt, nA, nB);
        for (int t = 0; t < nt; t += 2) {
            const bool last = (t == nt - 2);
            const char* a1 = cA + (size_t)(t + 1) * kstep;
            const char* a2 = last ? nA : cA + (size_t)(t + 2) * kstep; const char* b2 = last ? nB : cB + (size_t)(t + 2) * kstep;
            const char* a3 = a2 + kstep; const char* b3 = b2 + kstep;
            if (Sched::GATHER) { if (last && has_next) S.voff(nxt, sR, sC, voffX); }
            PG8_LDB(B0, 0, 0); PG8_LDB(B1, 0, 1); PG8_SCHED; PG8_LDA(At, 0, 0); PG8_STAGE(PG8_SA(1, 1), a1, voffA[1]);
            PG8_WAIT_V(8); PG8_WAIT_L(0); PG8_BAR; PG8_MMA(0, 0, At, B0); PG8_MMA(0, 1, At, B1); PG8_BAR; PG8_SCHED;
            PG8_LDA(At, 0, 1); PG8_STAGE(PG8_SB(0, 0), b2, voffB); PG8_STAGE(PG8_SB(0, 1), b2 + hstep, voffB); PG8_STAGE(PG8_SA(0, 0), a2, voffX[0]);
            PG8_WAIT_V(8); PG8_WAIT_L(0); PG8_BAR; PG8_MMA(1, 0, At, B0); PG8_MMA(1, 1, At, B1); PG8_BAR; PG8_SCHED;
            PG8_LDB(B0, 1, 0); PG8_LDB(B1, 1, 1); PG8_SCHED; PG8_LDA(At, 1, 0); PG8_STAGE(PG8_SA(0, 1), a2, voffX[1]);
            PG8_WAIT_V(8); PG8_WAIT_L(0); PG8_BAR; PG8_MMA(0, 0, At, B0); PG8_MMA(0, 1, At, B1); PG8_BAR; PG8_SCHED;
            PG8_LDA(At, 1, 1); PG8_STAGE(PG8_SB(1, 0), b3, voffB); PG8_STAGE(PG8_SB(1, 1), b3 + hstep, voffB); PG8_STAGE(PG8_SA(1, 0), a3, voffX[0]);
            PG8_WAIT_V(8); PG8_WAIT_L(0); PG8_BAR; PG8_MMA(1, 0, At, B0); PG8_MMA(1, 1, At, B1); PG8_BAR; PG8_SCHED;
        }
        if constexpr (ALIGN_EPI) { if (wr == 0) PG8_BAR; }
        E(acc, cur, wr, wc, fr, fq);
        if (!has_next) break;
        if (!E.keep(cur)) {
#pragma unroll
            for (int a = 0; a < 2; ++a)
#pragma unroll
                for (int b = 0; b < 2; ++b)
#pragma unroll
                    for (int m = 0; m < 4; ++m)
#pragma unroll
                        for (int n = 0; n < 2; ++n) acc[a][b][m][n] = (f32x4){0.f, 0.f, 0.f, 0.f};
        }
        cur = nxt; cA = nA; cB = nB; ++ui;
        if (Sched::GATHER) {
#pragma unroll
            for (int h = 0; h < 2; ++h)
#pragma unroll
                for (int i = 0; i < 2; ++i) voffA[h][i] = voffX[h][i];
        }
        if constexpr (ALIGN_EPI) { if (wr == 1) PG8_BAR; }
    }
    PG8_WAIT_V(0);
    if constexpr (!ALIGN_EPI) { if (wr == 0) PG8_BAR; }
    PG8_BAR;
#undef PG8_SA
#undef PG8_SB
#undef PG8_STAGE
#undef PG8_LDA
#undef PG8_LDB
#undef PG8_MMA
#undef PG8_WAIT_V
#undef PG8_WAIT_L
#undef PG8_BAR
#undef PG8_SCHED
}

struct SchedGrid {
    static constexpr bool GATHER = false;
    GridOrder go; const char* A; const char* Bt; int K;
    __device__ __forceinline__ bool next(int i, Unit& u) const { u.e = 0; u.a = 0; u.b = 0; return go.tile(i, u.pm, u.pn); }
    __device__ __forceinline__ void ptrs(const Unit& u, const char*& cA, const char*& cB) const { cA = A + (size_t)u.pm * 256 * K * 2; cB = Bt + (size_t)u.pn * 256 * K * 2; }
    __device__ __forceinline__ void voff(const Unit&, const int (&sR)[2], const int (&sC)[2], unsigned (&vo)[2][2]) const {
#pragma unroll
        for (int h = 0; h < 2; ++h)
#pragma unroll
            for (int i = 0; i < 2; ++i) vo[h][i] = (unsigned)((sR[i] + 128 * h) * K + sC[i]) * 2u;
    }
};
struct SchedBranch {
    static constexpr bool GATHER = false;
    GridOrder go; const char* A0; const char* A1; const char* B0; const char* B1;
    __device__ __forceinline__ bool next(int i, Unit& u) const { u.e = 0; u.b = 0; u.a = i & 1; return go.tile(i >> 1, u.pm, u.pn); }
    __device__ __forceinline__ void ptrs(const Unit& u, const char*& cA, const char*& cB) const { cA = (u.a ? A1 : A0) + (size_t)u.pm * 256 * 1024 * 2; cB = (u.a ? B1 : B0) + (size_t)u.pn * 256 * 1024 * 2; }
    __device__ __forceinline__ void voff(const Unit&, const int (&sR)[2], const int (&sC)[2], unsigned (&vo)[2][2]) const {
#pragma unroll
        for (int h = 0; h < 2; ++h)
#pragma unroll
            for (int i = 0; i < 2; ++i) vo[h][i] = (unsigned)((sR[i] + 128 * h) * 1024 + sC[i]) * 2u;
    }
};
template <bool FIRST> struct SchedMoe {
    static constexpr bool GATHER = FIRST;
    const LAS int* tb; int xcls, rank, nranks; const char* A; const char* W; const int* list;
    __device__ __forceinline__ bool next(int i, Unit& u) const {
        const int L = i * nranks + rank; if (L >= tb[24]) return false;
        int q = 0; while (tb[16 + q + 1] <= L) ++q;
        const int loc = L - tb[16 + q]; u.pm = loc >> 3; u.pn = loc & 7; u.e = xcls + 8 * q; u.a = tb[q]; u.b = tb[8 + q]; return true;
    }
    __device__ __forceinline__ void ptrs(const Unit& u, const char*& cA, const char*& cB) const {
        if (FIRST) { cA = A; cB = W + ((size_t)u.e * 2048 + (size_t)u.pn * 256) * ND * 2; }
        else { cA = A + (size_t)(u.b + u.pm * 256) * DE * 2; cB = W + ((size_t)u.e * 2048 + (size_t)u.pn * 256) * DE * 2; }
    }
    __device__ __forceinline__ void voff(const Unit& u, const int (&sR)[2], const int (&sC)[2], unsigned (&vo)[2][2]) const {
#pragma unroll
        for (int h = 0; h < 2; ++h)
#pragma unroll
            for (int i = 0; i < 2; ++i) {
                if (FIRST) { const int lr = u.pm * 256 + 128 * h + sR[i]; const int tok = (lr < u.a) ? list[(size_t)u.e * ECAP + lr] : 0; vo[h][i] = (unsigned)(tok * ND + sC[i]) * 2u; }
                else vo[h][i] = (unsigned)((sR[i] + 128 * h) * DE + sC[i]) * 2u;
            }
    }
};

__device__ __forceinline__ float sigm(float v) { return __builtin_amdgcn_rcpf(1.f + __builtin_amdgcn_exp2f(-LOG2E * v)); }
__device__ __forceinline__ void unpack8(const u32x4 w, float (&f)[8]) { f[0] = bf2f(w.x & 0xffffu); f[1] = bf2f(w.x >> 16); f[2] = bf2f(w.y & 0xffffu); f[3] = bf2f(w.y >> 16); f[4] = bf2f(w.z & 0xffffu); f[5] = bf2f(w.z >> 16); f[6] = bf2f(w.w & 0xffffu); f[7] = bf2f(w.w >> 16); }

struct EpiIn {
    static constexpr bool PERM = true;
    unsigned char* ws;
    __device__ __forceinline__ bool keep(const Unit&) const { return false; }
    __device__ __forceinline__ void operator()(f32x4 (&acc)[2][2][4][2], const Unit& u, int wr, int wc, int fr, int fq) const {
        const int rowb = u.pm * BM + wr * 64 + fr, lc = wc * 32 + 8 * fq, i0 = (lc & 63) >> 1;
        const float* cosT = (const float*)(ws + WS_COS); const float* sinT = (const float*)(ws + WS_SIN);
        bf16_t* dst[2]; int ldd[2], kind[2];
#pragma unroll
        for (int bj = 0; bj < 2; ++bj) {
            const int cb = u.pn * BM + bj * HALF;
            if (cb < C_KA) { dst[bj] = (bf16_t*)(ws + WS_QA) + cb; ldd[bj] = 1024; kind[bj] = 2; }
            else if (cb < C_VA) { dst[bj] = (bf16_t*)(ws + WS_KA) + (cb - C_KA); ldd[bj] = 128; kind[bj] = 1; }
            else if (cb < C_QD) { dst[bj] = (bf16_t*)(ws + WS_VA) + (cb - C_VA); ldd[bj] = 128; kind[bj] = 0; }
            else if (cb < C_KD) { dst[bj] = (bf16_t*)(ws + WS_QD) + (cb - C_QD); ldd[bj] = 1024; kind[bj] = 2; }
            else if (cb < C_VD) { dst[bj] = (bf16_t*)(ws + WS_KD) + (cb - C_KD); ldd[bj] = 1024; kind[bj] = 1; }
            else if (cb < C_GA) { dst[bj] = (bf16_t*)(ws + WS_VD) + (cb - C_VD); ldd[bj] = 1024; kind[bj] = 0; }
            else { dst[bj] = (bf16_t*)(ws + WS_G) + (cb - C_GA); ldd[bj] = 4096; kind[bj] = 3; }
            dst[bj] += lc;
        }
        const bool any_rope = (kind[0] == 1 || kind[0] == 2 || kind[1] == 1 || kind[1] == 2);
#pragma unroll
        for (int ai = 0; ai < 2; ++ai) {
            f32x4 cs[4], sn[4];
#pragma unroll
            for (int m = 0; m < 4; ++m) { cs[m] = (f32x4){1.f, 1.f, 1.f, 1.f}; sn[m] = (f32x4){0.f, 0.f, 0.f, 0.f}; }
            if (any_rope) {
#pragma unroll
                for (int m = 0; m < 4; ++m) { const size_t ro = (size_t)(rowb + ai * HALF + m * 16) * 32 + i0; cs[m] = *(const f32x4*)(cosT + ro); sn[m] = *(const f32x4*)(sinT + ro); }
            }
            __builtin_amdgcn_sched_barrier(0);
#pragma unroll
            for (int m = 0; m < 4; ++m) {
                const int row = rowb + ai * HALF + m * 16;
#pragma unroll
                for (int bj = 0; bj < 2; ++bj) {
                    const f32x4 v0 = acc[ai][bj][m][0], v1 = acc[ai][bj][m][1];
                    float o[8];
                    if (kind[bj] == 1 || kind[bj] == 2) {
                        const f32x4 c = cs[m], s = sn[m];
                        o[0] = v0[0] * c[0] - v0[1] * s[0]; o[1] = v0[1] * c[0] + v0[0] * s[0]; o[2] = v0[2] * c[1] - v0[3] * s[1]; o[3] = v0[3] * c[1] + v0[2] * s[1];
                        o[4] = v1[0] * c[2] - v1[1] * s[2]; o[5] = v1[1] * c[2] + v1[0] * s[2]; o[6] = v1[2] * c[3] - v1[3] * s[3]; o[7] = v1[3] * c[3] + v1[2] * s[3];
                        if (kind[bj] == 2) {
#pragma unroll
                            for (int j = 0; j < 8; ++j) o[j] *= C2;
                        }
                    } else if (kind[bj] == 3) {
#pragma unroll
                        for (int j = 0; j < 4; ++j) { o[j] = sigm(v0[j]); o[4 + j] = sigm(v1[j]); }
                    } else {
#pragma unroll
                        for (int j = 0; j < 4; ++j) { o[j] = v0[j]; o[4 + j] = v1[j]; }
                    }
                    u32x4 w; w.x = cvt_pk_bf16(o[0], o[1]); w.y = cvt_pk_bf16(o[2], o[3]); w.z = cvt_pk_bf16(o[4], o[5]); w.w = cvt_pk_bf16(o[6], o[7]);
                    *(u32x4*)(dst[bj] + (size_t)row * ldd[bj]) = w;
                }
            }
            __builtin_amdgcn_sched_barrier(0);
        }
    }
};
struct EpiBranch {
    static constexpr bool PERM = true;
    const bf16_t* G; bf16_t* MG;
    __device__ __forceinline__ bool keep(const Unit& u) const { return u.a == 0; }
    __device__ __forceinline__ void operator()(f32x4 (&acc)[2][2][4][2], const Unit& u, int wr, int wc, int fr, int fq) const {
        const int rowb = u.pm * BM + wr * 64 + fr, colb = u.pn * BM + wc * 32 + 8 * fq;
#pragma unroll
        for (int ai = 0; ai < 2; ++ai)
#pragma unroll
            for (int mp = 0; mp < 2; ++mp) {
                u32x4 gb_[2][2], ga_[2][2];
#pragma unroll
                for (int mm = 0; mm < 2; ++mm)
#pragma unroll
                    for (int bj = 0; bj < 2; ++bj) {
                        const bf16_t* gp = G + (size_t)(rowb + ai * HALF + (2 * mp + mm) * 16) * 4096 + colb + bj * HALF;
                        gb_[mm][bj] = *(const u32x4*)(gp + 2048);
                        ga_[mm][bj] = (u.a == 0) ? *(const u32x4*)gp : (u32x4){0u, 0u, 0u, 0u};
                    }
                __builtin_amdgcn_sched_barrier(0);
#pragma unroll
                for (int mm = 0; mm < 2; ++mm) {
                    const int m = 2 * mp + mm, row = rowb + ai * HALF + m * 16;
#pragma unroll
                    for (int bj = 0; bj < 2; ++bj) {
                        float sb[8]; unpack8(gb_[mm][bj], sb);
                        if (u.a == 0) {
                            float sa[8]; unpack8(ga_[mm][bj], sa);
#pragma unroll
                            for (int j = 0; j < 4; ++j) { acc[ai][bj][m][0][j] *= sa[j] * __builtin_amdgcn_rcpf(sb[j]); acc[ai][bj][m][1][j] *= sa[4 + j] * __builtin_amdgcn_rcpf(sb[4 + j]); }
                        } else {
                            const f32x4 v0 = acc[ai][bj][m][0], v1 = acc[ai][bj][m][1];
                            u32x4 w; w.x = cvt_pk_bf16(v0[0] * sb[0], v0[1] * sb[1]); w.y = cvt_pk_bf16(v0[2] * sb[2], v0[3] * sb[3]); w.z = cvt_pk_bf16(v1[0] * sb[4], v1[1] * sb[5]); w.w = cvt_pk_bf16(v1[2] * sb[6], v1[3] * sb[7]);
                            *(u32x4*)(MG + (size_t)row * ND + colb + bj * HALF) = w;
                        }
                    }
                }
                __builtin_amdgcn_sched_barrier(0);
            }
    }
};
struct EpiOut {
    static constexpr bool PERM = false;
    const float* x; const float* mod; float* xmid; float* ssq;
    __device__ __forceinline__ bool keep(const Unit&) const { return false; }
    __device__ __forceinline__ void operator()(f32x4 (&acc)[2][2][4][2], const Unit& u, int wr, int wc, int fr, int fq) const {
        const int rowb = u.pm * BM + wr * 64 + fr, colb = u.pn * BM + wc * 32 + 4 * fq, b = (u.pm * BM) / NS;
        f32x4 gt[2][2];
#pragma unroll
        for (int bj = 0; bj < 2; ++bj)
#pragma unroll
            for (int n = 0; n < 2; ++n) gt[bj][n] = *(const f32x4*)(mod + (size_t)b * 12288 + 4096 + colb + bj * HALF + n * 16);
#pragma unroll
        for (int ai = 0; ai < 2; ++ai)
#pragma unroll
            for (int mp = 0; mp < 2; ++mp) {
                float sq[2] = {0.f, 0.f};
                f32x4 xv[2][2][2];
#pragma unroll
                for (int mm = 0; mm < 2; ++mm)
#pragma unroll
                    for (int bj = 0; bj < 2; ++bj)
#pragma unroll
                        for (int n = 0; n < 2; ++n) xv[mm][bj][n] = *(const f32x4*)(x + (size_t)(rowb + ai * HALF + (2 * mp + mm) * 16) * ND + colb + bj * HALF + n * 16);
                __builtin_amdgcn_sched_barrier(0);
#pragma unroll
                for (int mm = 0; mm < 2; ++mm)
#pragma unroll
                    for (int bj = 0; bj < 2; ++bj)
#pragma unroll
                        for (int n = 0; n < 2; ++n) { const f32x4 o = xv[mm][bj][n] + gt[bj][n] * acc[ai][bj][2 * mp + mm][n];
                            *(f32x4*)(xmid + (size_t)(rowb + ai * HALF + (2 * mp + mm) * 16) * ND + colb + bj * HALF + n * 16) = o; sq[mm] += (o[0] * o[0] + o[1] * o[1]) + (o[2] * o[2] + o[3] * o[3]); }
#pragma unroll
                for (int mm = 0; mm < 2; ++mm) { float s = sq[mm]; s += __shfl_xor(s, 16); s += __shfl_xor(s, 32);
                    if (fq == 0) ssq[(size_t)(rowb + ai * HALF + (2 * mp + mm) * 16) * 32 + 4 * u.pn + wc] = s; }
                __builtin_amdgcn_sched_barrier(0);
            }
    }
};
struct EpiMoe1 {
    static constexpr bool PERM = true;
    bf16_t* ACT;
    __device__ __forceinline__ bool keep(const Unit&) const { return false; }
    __device__ __forceinline__ void operator()(f32x4 (&acc)[2][2][4][2], const Unit& u, int wr, int wc, int fr, int fq) const {
        const int rowb = u.b + u.pm * BM + wr * 64 + fr, j0 = u.pn * HALF + wc * 32 + 8 * fq;
#pragma unroll
        for (int ai = 0; ai < 2; ++ai)
#pragma unroll
            for (int m = 0; m < 4; ++m) {
                float o[8];
#pragma unroll
                for (int n = 0; n < 2; ++n)
#pragma unroll
                    for (int j = 0; j < 4; ++j) { const float g = acc[ai][0][m][n][j], up = acc[ai][1][m][n][j]; o[4 * n + j] = g * sigm(g) * up; }
                u32x4 w; w.x = cvt_pk_bf16(o[0], o[1]); w.y = cvt_pk_bf16(o[2], o[3]); w.z = cvt_pk_bf16(o[4], o[5]); w.w = cvt_pk_bf16(o[6], o[7]);
                *(u32x4*)(ACT + (size_t)(rowb + ai * HALF + m * 16) * DE + j0) = w;
            }
    }
};
struct EpiMoe2 {
    static constexpr bool PERM = true;
    bf16_t* Y; const float* slw;
    __device__ __forceinline__ bool keep(const Unit&) const { return false; }
    __device__ __forceinline__ void operator()(f32x4 (&acc)[2][2][4][2], const Unit& u, int wr, int wc, int fr, int fq) const {
        const int lrb = u.pm * BM + wr * 64 + fr, colb = u.pn * BM + wc * 32 + 8 * fq;
#pragma unroll
        for (int ai = 0; ai < 2; ++ai)
#pragma unroll
            for (int m = 0; m < 4; ++m) {
                const int lr = lrb + ai * HALF + m * 16;
                const float w8 = (lr < u.a) ? slw[(size_t)u.e * ECAP + lr] : 0.f;
#pragma unroll
                for (int bj = 0; bj < 2; ++bj) {
                    const f32x4 v0 = acc[ai][bj][m][0] * w8, v1 = acc[ai][bj][m][1] * w8;
                    u32x4 w; w.x = cvt_pk_bf16(v0[0], v0[1]); w.y = cvt_pk_bf16(v0[2], v0[3]); w.z = cvt_pk_bf16(v1[0], v1[1]); w.w = cvt_pk_bf16(v1[2], v1[3]);
                    *(u32x4*)(Y + (size_t)(u.b + lr) * ND + colb + bj * HALF) = w;
                }
            }
    }
};
}

constexpr int RING_BYTES = 131072, TBL_OFF = 159744 + 1024;
__device__ __forceinline__ void phase_inproj_fast(const Params& p, LAS unsigned char* lds) {
    pg8::SchedGrid S; S.go.init(NM / 256, IN_COLS / 256, gridDim.x, blockIdx.x); S.A = (const char*)(p.ws + WS_H); S.Bt = (const char*)(p.ws + WS_WINT); S.K = ND;
    pg8::EpiIn E{p.ws};
    pg8::gemm_phase<pg8::EpiIn, pg8::SchedGrid, true>(lds, ND, S, E);
#if LATE_COPIES
    {
        const int nun = (NM / 256) * (IN_COLS / 256), rem = nun % (int)gridDim.x, first = rem, nhelp = (int)gridDim.x - rem;
        if ((int)blockIdx.x >= first) late_weight_copies(p, lds, make_ctx(), first, nhelp);
    }
#endif
}
__device__ __forceinline__ void phase_branch_fast(const Params& p, LAS unsigned char* lds) {
    pg8::SchedBranch S; S.go.init(NM / 256, ND / 256, gridDim.x, blockIdx.x);
    S.A0 = (const char*)(p.ws + WS_OA); S.A1 = (const char*)(p.ws + WS_OB); S.B0 = (const char*)(p.ws + WS_WAT); S.B1 = (const char*)(p.ws + WS_WBT);
    pg8::EpiBranch E{(const bf16_t*)(p.ws + WS_G), (bf16_t*)(p.ws + WS_MERGED)};
    pg8::gemm_phase<pg8::EpiBranch, pg8::SchedBranch, true>(lds, 1024, S, E);
}
__device__ __forceinline__ void phase_out_fast(const Params& p, LAS unsigned char* lds) {
    pg8::SchedGrid S; S.go.init(NM / 256, ND / 256, gridDim.x, blockIdx.x); S.A = (const char*)(p.ws + WS_MERGED); S.Bt = (const char*)(p.ws + WS_WOUTT); S.K = ND;
    pg8::EpiOut E{p.x, (const float*)(p.ws + WS_MOD), (float*)(p.ws + WS_XMID), (float*)(p.ws + WS_SSQ)};
    pg8::gemm_phase<pg8::EpiOut, pg8::SchedGrid, true>(lds, ND, S, E);
}
__device__ __forceinline__ void moe_tables(const Params& p, LAS int* tb, int tid) {
    __syncthreads();
    if (tid == 0) {
        const unsigned* cnt = (const unsigned*)(p.ws + WS_CTL) + CW_CNT;
        const int x = blockIdx.x & 7; int ps = 0, up = 0;
        for (int e = 0; e < NE; ++e) { const int n = (int)__hip_atomic_load(cnt + e, __ATOMIC_RELAXED, __HIP_MEMORY_SCOPE_AGENT);
            if ((e & 7) == x) { const int q = e >> 3; tb[q] = n; tb[8 + q] = ps; tb[16 + q] = up; up += ((n + 255) / 256) * 8; }
            ps += (n + PADR - 1) / PADR * PADR; }
        tb[24] = up;
    }
    __syncthreads();
}
__device__ __forceinline__ void phase_moe1_fast(const Params& p, LAS unsigned char* lds, const Ctx& cx) {
    LAS int* tb = (LAS int*)(lds + TBL_OFF);
    moe_tables(p, tb, cx.tid);
    pg8::SchedMoe<true> S{tb, (int)(blockIdx.x & 7), (int)(blockIdx.x >> 3), (int)(gridDim.x >> 3), (const char*)(p.ws + WS_H), (const char*)(p.ws + WS_WGUT), (const int*)(p.ws + WS_LIST)};
    pg8::EpiMoe1 E{(bf16_t*)(p.ws + WS_ACT)};
    pg8::gemm_phase<pg8::EpiMoe1, pg8::SchedMoe<true>, true>(lds, ND, S, E);
}
__device__ __forceinline__ void phase_moe2_fast(const Params& p, LAS unsigned char* lds, const Ctx& cx) {
    LAS int* tb = (LAS int*)(lds + TBL_OFF);
    moe_tables(p, tb, cx.tid);
    pg8::SchedMoe<false> S{tb, (int)(blockIdx.x & 7), (int)(blockIdx.x >> 3), (int)(gridDim.x >> 3), (const char*)(p.ws + WS_ACT), (const char*)(p.ws + WS_WDNT), nullptr};
    pg8::EpiMoe2 E{(bf16_t*)(p.ws + WS_Y), (const float*)(p.ws + WS_SLW)};
    pg8::gemm_phase<pg8::EpiMoe2, pg8::SchedMoe<false>, true>(lds, DE, S, E);
}

__device__ __forceinline__ void phase_router(const Params& p, LAS unsigned char* lds, const Ctx& cx) {
    const float* xmid = (const float*)(p.ws + WS_XMID); const float* mod = (const float*)(p.ws + WS_MOD);
    bf16_t* H2 = (bf16_t*)(p.ws + WS_H);
    unsigned* cnt = (unsigned*)(p.ws + WS_CTL) + CW_CNT;
    int* toke = (int*)(p.ws + WS_TOKE); int* tokr = (int*)(p.ws + WS_TOKR); int* list = (int*)(p.ws + WS_LIST); float* slw = (float*)(p.ws + WS_SLW);
    LAS float* hrow = (LAS float*)(lds + cx.wave * 8192);
    for (int row = cx.gw; row < NM; row += cx.ngw) {
        const int b = row / NS;
        const f32x4* xr = (const f32x4*)(xmid + (size_t)row * ND) + cx.lane;
        f32x4 v[8]; float ss = 0.f;
#pragma unroll
        for (int j = 0; j < 8; ++j) { v[j] = xr[64 * j]; ss += (v[j].x * v[j].x + v[j].y * v[j].y) + (v[j].z * v[j].z + v[j].w * v[j].w); }
        const float rstd = 1.f / sqrtf(wave_sum(ss) * (1.f / ND) + RMS_EPS);
        u32x2* o8 = (u32x2*)(H2 + (size_t)row * ND) + cx.lane;
#pragma unroll
        for (int j = 0; j < 8; ++j) {
            const int col = 4 * cx.lane + 256 * j;
            const f32x4 g = *(const f32x4*)(p.g_ffn + col);
            const f32x4 sh = *(const f32x4*)(mod + (size_t)b * 12288 + 6144 + col), sc = *(const f32x4*)(mod + (size_t)b * 12288 + 8192 + col);
            const f32x4 y = v[j] * rstd * g * (sc + 1.f) + sh;
            u32x2 w; w.x = pk2(y.x, y.y); w.y = pk2(y.z, y.w); o8[64 * j] = w;
            *(LAS f32x4*)(hrow + col) = y;
        }
        LDS_WAIT(); asm volatile("" ::: "memory");
        float eacc = 0.f, gacc = 0.f;
        const float* wre = p.w_re + cx.lane; const float* wrg = p.w_rg + (cx.lane & 7);
#pragma unroll 2
        for (int k = 0; k < ND; k += 4) {
            const f32x4 hv = *(const LAS f32x4*)(hrow + k);
            eacc += hv.x * wre[(size_t)(k + 0) * 64]; eacc += hv.y * wre[(size_t)(k + 1) * 64]; eacc += hv.z * wre[(size_t)(k + 2) * 64]; eacc += hv.w * wre[(size_t)(k + 3) * 64];
            gacc += hv.x * wrg[(size_t)(k + 0) * 8]; gacc += hv.y * wrg[(size_t)(k + 1) * 8]; gacc += hv.z * wrg[(size_t)(k + 2) * 8]; gacc += hv.w * wrg[(size_t)(k + 3) * 8];
        }
        eacc += p.b_re[cx.lane]; gacc += p.b_rg[cx.lane & 7];
        float gl[8];
#pragma unroll
        for (int j = 0; j < 8; ++j) gl[j] = __shfl(gacc, j);
        int gsel = 0; float gmax = gl[0];
#pragma unroll
        for (int j = 1; j < 8; ++j) if (gl[j] > gmax) { gmax = gl[j]; gsel = j; }
        float gsum = 0.f;
#pragma unroll
        for (int j = 0; j < 8; ++j) gsum += expf(gl[j] - gmax);
        const float gweight = 1.f / gsum;
        float el[8];
#pragma unroll
        for (int j = 0; j < 8; ++j) el[j] = __shfl(eacc, gsel * 8 + j);
        int i0 = 0;
#pragma unroll
        for (int j = 1; j < 8; ++j) if (el[j] > el[i0]) i0 = j;
        int i1 = (i0 == 0) ? 1 : 0;
#pragma unroll
        for (int j = 0; j < 8; ++j) if (j != i0 && j != i1 && el[j] > el[i1]) i1 = j;
        const float t = expf(el[i1] - el[i0]);
        const float w0 = gweight / (1.f + t), w1 = gweight * t / (1.f + t);
        if (cx.lane == 0) {
            const int e0 = gsel * 8 + i0, e1 = gsel * 8 + i1;
            const unsigned r0 = atomicAdd(cnt + e0, 1u), r1 = atomicAdd(cnt + e1, 1u);
            toke[row * 2] = e0; toke[row * 2 + 1] = e1; tokr[row * 2] = (int)r0; tokr[row * 2 + 1] = (int)r1;
            list[(size_t)e0 * ECAP + r0] = row; list[(size_t)e1 * ECAP + r1] = row;
            slw[(size_t)e0 * ECAP + r0] = w0; slw[(size_t)e1 * ECAP + r1] = w1;
        }
        LDS_WAIT(); asm volatile("" ::: "memory");
    }
}


__device__ __forceinline__ void phase_router_fast(const Params& p, LAS unsigned char* lds, const Ctx& cx) {
    constexpr int TP = 516;
    LAS float* T = (LAS float*)lds;
    LAS float* LG = (LAS float*)(lds + 132096);
    const float* xmid = (const float*)(p.ws + WS_XMID); const float* mod = (const float*)(p.ws + WS_MOD); const float* wrt = (const float*)(p.ws + WS_WRT);
    bf16_t* H2 = (bf16_t*)(p.ws + WS_H);
    unsigned* cnt = (unsigned*)(p.ws + WS_CTL) + CW_CNT;
    int* toke = (int*)(p.ws + WS_TOKE); int* tokr = (int*)(p.ws + WS_TOKR); int* list = (int*)(p.ws + WS_LIST); float* slw = (float*)(p.ws + WS_SLW);
    const int w = cx.wave, lane = cx.lane, fr = lane & 15, kq = lane >> 4;
    for (int rb = blockIdx.x; rb < NM / 64; rb += gridDim.x) {
        const int row0 = rb * 64, b = row0 / NS;
        LAS float* RS = LG + 64 * 80;
        {
            const f32x4 v = *(const f32x4*)((const float*)(p.ws + WS_SSQ) + (size_t)(row0 + 8 * w + (lane >> 3)) * 32 + 4 * (lane & 7));
            float ss = (v.x + v.y) + (v.z + v.w);
            ss += __shfl_xor(ss, 1); ss += __shfl_xor(ss, 2); ss += __shfl_xor(ss, 4);
            if ((lane & 7) == 0) RS[8 * w + (lane >> 3)] = 1.f / sqrtf(ss * (1.f / ND) + RMS_EPS);
        }
        LDS_WAIT(); asm volatile("" ::: "memory");
        f32x4 acc[4][5];
#pragma unroll
        for (int m = 0; m < 4; ++m)
#pragma unroll
            for (int t = 0; t < 5; ++t) acc[m][t] = (f32x4){0.f, 0.f, 0.f, 0.f};
        for (int c = 0; c < 4; ++c) {
#pragma unroll
            for (int j = 0; j < 2; ++j) {
                const int col = 512 * c + 256 * j + 4 * lane;
                const f32x4 g = *(const f32x4*)(p.g_ffn + col);
                const f32x4 sh = *(const f32x4*)(mod + (size_t)b * 12288 + 6144 + col), sc = *(const f32x4*)(mod + (size_t)b * 12288 + 8192 + col);
                const f32x4 gs = g * (sc + 1.f);
#pragma unroll 4
                for (int rr = 0; rr < 8; ++rr) {
                    const int r = 8 * w + rr;
                    const f32x4 xv = *(const f32x4*)(xmid + (size_t)(row0 + r) * ND + col);
                    const f32x4 y = xv * RS[r] * gs + sh;
                    *(LAS f32x4*)(T + r * TP + 256 * j + 4 * lane) = y;
                    u32x2 o; o.x = pk2(y.x, y.y); o.y = pk2(y.z, y.w); *(u32x2*)(H2 + (size_t)(row0 + r) * ND + col) = o;
                }
            }
            __syncthreads();
            const LAS float* ta = T + fr * TP + 64 * w + 4 * kq;
            const float* wb = wrt + (size_t)fr * ND + 512 * c + 64 * w + 4 * kq;
#pragma unroll
            for (int s = 0; s < 4; ++s) {
                f32x4 b4[5];
#pragma unroll
                for (int t = 0; t < 5; ++t) b4[t] = *(const f32x4*)(wb + (size_t)(16 * t) * ND + 16 * s);
#pragma unroll
                for (int m = 0; m < 4; ++m) {
                    const f32x4 a4 = *(const LAS f32x4*)(ta + (16 * m) * TP + 16 * s);
#pragma unroll
                    for (int t = 0; t < 5; ++t) {
                        acc[m][t] = __builtin_amdgcn_mfma_f32_16x16x4f32(a4.x, b4[t].x, acc[m][t], 0, 0, 0);
                        acc[m][t] = __builtin_amdgcn_mfma_f32_16x16x4f32(a4.y, b4[t].y, acc[m][t], 0, 0, 0);
                        acc[m][t] = __builtin_amdgcn_mfma_f32_16x16x4f32(a4.z, b4[t].z, acc[m][t], 0, 0, 0);
                        acc[m][t] = __builtin_amdgcn_mfma_f32_16x16x4f32(a4.w, b4[t].w, acc[m][t], 0, 0, 0);
                    }
                }
            }
            __syncthreads();
        }
        LAS float* PB = T;
#pragma unroll
        for (int step = 4; step >= 1; step >>= 1) {
            if (w >= step && w < 2 * step) {
                LAS float* dstp = PB + (w - step) * (64 * 80);
#pragma unroll
                for (int m = 0; m < 4; ++m)
#pragma unroll
                    for (int t = 0; t < 5; ++t)
#pragma unroll
                        for (int r = 0; r < 4; ++r) dstp[(16 * m + 4 * kq + r) * 80 + 16 * t + fr] = acc[m][t][r];
            }
            __syncthreads();
            if (w < step) {
                const LAS float* srcp = PB + w * (64 * 80);
#pragma unroll
                for (int m = 0; m < 4; ++m)
#pragma unroll
                    for (int t = 0; t < 5; ++t)
#pragma unroll
                        for (int r = 0; r < 4; ++r) acc[m][t][r] += srcp[(16 * m + 4 * kq + r) * 80 + 16 * t + fr];
            }
            __syncthreads();
        }
        if (w == 0) {
#pragma unroll
            for (int t = 0; t < 5; ++t) { const int colj = 16 * t + fr; const float bias = (colj < 64) ? p.b_re[colj] : (colj < 72) ? p.b_rg[colj - 64] : 0.f;
#pragma unroll
                for (int m = 0; m < 4; ++m)
#pragma unroll
                    for (int r = 0; r < 4; ++r) LG[(16 * m + 4 * kq + r) * 80 + colj] = acc[m][t][r] + bias; }
        }
        __syncthreads();
        if (cx.tid < 64) {
            const LAS float* lg = LG + cx.tid * 80; const int row = row0 + cx.tid;
            int gsel = 0; float gmax = lg[64];
            for (int j = 1; j < 8; ++j) { const float v = lg[64 + j]; if (v > gmax) { gmax = v; gsel = j; } }
            float gsum = 0.f;
            for (int j = 0; j < 8; ++j) gsum += expf(lg[64 + j] - gmax);
            const float gweight = 1.f / gsum;
            const LAS float* el = lg + gsel * 8;
            int i0 = 0; float v0 = el[0];
            for (int j = 1; j < 8; ++j) { const float v = el[j]; if (v > v0) { v0 = v; i0 = j; } }
            int i1 = (i0 == 0) ? 1 : 0; float v1 = el[i1];
            for (int j = 0; j < 8; ++j) { const float v = el[j]; if (j != i0 && j != i1 && v > v1) { v1 = v; i1 = j; } }
            const float tt = expf(v1 - v0);
            const float w0 = gweight / (1.f + tt), w1 = gweight * tt / (1.f + tt);
            const int e0 = gsel * 8 + i0, e1 = gsel * 8 + i1;
            const unsigned r0 = atomicAdd(cnt + e0, 1u), r1 = atomicAdd(cnt + e1, 1u);
            toke[row * 2] = e0; toke[row * 2 + 1] = e1; tokr[row * 2] = (int)r0; tokr[row * 2 + 1] = (int)r1;
            list[(size_t)e0 * ECAP + r0] = row; list[(size_t)e1 * ECAP + r1] = row;
            slw[(size_t)e0 * ECAP + r0] = w0; slw[(size_t)e1 * ECAP + r1] = w1;
        }
        __syncthreads();
    }
}

__device__ __forceinline__ void expert_tables(const Params& p, LAS int* tb, int tid) {
    __syncthreads();
    if (tid < 64) {
        const unsigned* cnt = (const unsigned*)(p.ws + WS_CTL) + CW_CNT;
        const int n = (int)__hip_atomic_load(cnt + tid, __ATOMIC_RELAXED, __HIP_MEMORY_SCOPE_AGENT);
        const int pad = (n + PADR - 1) / PADR * PADR, t64 = (n + 63) / 64;
        int ps = pad, tp = t64;
#pragma unroll
        for (int o = 1; o < 64; o <<= 1) { const int a = __shfl_up(ps, o), b = __shfl_up(tp, o); if (tid >= o) { ps += a; tp += b; } }
        tb[tid] = n; tb[64 + tid] = ps - pad; tb[192 + tid] = tp - t64;
        if (tid == 63) { tb[64 + NE] = ps; tb[192 + NE] = tp; }
    }
    __syncthreads();
}

namespace moe {
typedef short bf16x8 __attribute__((ext_vector_type(8)));
typedef short v4i16_t __attribute__((ext_vector_type(4)));
constexpr int NBMAX = 3, A_SLOT = NBMAX * 8 * 2048, NAS = 2, B_OFF = NAS * A_SLOT, B_PITCH = 288, B_SLOT = 32 * B_PITCH, RING_END = B_OFF + 3 * B_SLOT;
constexpr int UROWS = NBMAX * 128;
__host__ __device__ constexpr int rho(int k) { return (k & 3) | (((k >> 3) & 1) << 2) | (((k >> 2) & 1) << 3) | (k & 16); }
#define MOE_WAITV(n) asm volatile("s_waitcnt vmcnt(%0)" :: "n"(n) : "memory")
__device__ __forceinline__ void dma16(unsigned voff, const char* sbase, unsigned lds_dst) {
    unsigned keep; asm volatile("s_mov_b32 %0, m0\n\ts_mov_b32 m0, %3\n\ts_nop 0\n\tglobal_load_lds_dwordx4 %1, %2\n\ts_mov_b32 m0, %0" : "=&s"(keep) : "v"(voff), "s"(sbase), "s"(lds_dst) : "memory"); }
__device__ __forceinline__ void ldw16(f32x4& d, unsigned voff, const char* sbase) { asm volatile("global_load_dwordx4 %0, %1, %2 nt" : "=v"(d) : "v"(voff), "s"(sbase) : "memory"); }

template <bool FIRST, int NBC>
__device__ __forceinline__ void unit_lc(LAS unsigned char* lds, const Params& p, const int e, const int u, const int ps, const int r0, const int r1) {
    constexpr int K = FIRST ? 2048 : 1024, NT = K / 32, KSTART = FIRST ? -8 : -10, NP = 2 * NBC;
    static_assert((NT - KSTART) % 6 == 0 && KSTART <= -8 && (KSTART & 1) == 0, "six register sets rotate over the unrolled iterations; weight tile 0 is issued at iteration -7; iterations pair up");
    int tid_ = threadIdx.x; asm volatile("" : "+v"(tid_));
    const int tid = tid_, lane = tid & 63, w = __builtin_amdgcn_readfirstlane(tid >> 6), fr = lane & 15, fq = lane >> 4;
    const int rot = u * (NT / 16);
#define MOE_BAR() do { asm volatile("s_waitcnt lgkmcnt(0)" ::: "memory"); __builtin_amdgcn_s_barrier(); asm volatile("" ::: "memory"); } while (0)
    if (w < 4) {
        const char* Abase = (const char*)(p.ws + (FIRST ? WS_H : WS_ACT));
        unsigned aoff[NP];
#pragma unroll
        for (int i = 0; i < NP; ++i) {
            const int mt = (w * NP + i) >> 1, h = i & 1, rt = 8 * h + (lane >> 3);
            int lr = r0 + 16 * mt + rt; lr = lr < r1 ? lr : r1 - 1;
            const unsigned cb = (unsigned)(((lane & 7) ^ ((rt >> 1) & 7)) * 16);
            if (FIRST) aoff[i] = (unsigned)((const int*)(p.ws + WS_LIST))[(size_t)e * ECAP + lr] * (unsigned)(ND * 2) + cb;
            else aoff[i] = (unsigned)(ps + lr) * (unsigned)(DE * 2) + cb;
        }
#pragma unroll
        for (int i = 0; i < NP; ++i) asm volatile("" : "+v"(aoff[i]));
        const int t = 64 * w + lane, krow = t >> 5, c4 = t & 31, gi = c4 >> 3, cg = c4 & 7;
        const int gcol = FIRST ? ((c4 < 16 ? 0 : 1024) + 64 * u + 4 * (c4 & 15)) : (128 * u + 4 * c4);
        const char* wbase = (const char*)(FIRST ? p.w_gu + (size_t)e * 2048 * 2048 : p.w_dn + (size_t)e * 1024 * 2048);
        const unsigned woff = (unsigned)(krow * 2048 + gcol) * 4u;
        const int npos = 32 * gi + 4 * (4 * (cg & 1) + (cg >> 1));
        const unsigned bw = (unsigned)(rho(krow) * B_PITCH + 2 * npos);
        const unsigned lds0 = (unsigned)(uintptr_t)lds;
        f32x4 breg[6][4];
#pragma unroll
        for (int s = 0; s < 6; ++s)
#pragma unroll
            for (int i = 0; i < 4; ++i) breg[s][i] = (f32x4){0.f, 0.f, 0.f, 0.f};
        asm volatile("s_waitcnt vmcnt(0)" ::: "memory");
        int kt = KSTART; asm volatile("" : "+s"(kt));
#define MOE_LD_ITER(SET, ODD) do { \
            if (kt >= 0) MOE_BAR(); \
            if ((ODD) && kt >= -1) MOE_WAITV(4);        \
            if (kt + 1 >= 0) { \
                asm volatile("" : "+v"(breg[SET][0]), "+v"(breg[SET][1]), "+v"(breg[SET][2]), "+v"(breg[SET][3]) :: "memory"); \
                if (kt + 1 < NT) { LAS unsigned char* bs = lds + B_OFF + ((kt + 1) % 3) * B_SLOT + bw; \
                    _Pragma("unroll") for (int i = 0; i < 4; ++i) { u32x2 wv; wv.x = pg8::cvt_pk_bf16(breg[SET][i].x, breg[SET][i].y); wv.y = pg8::cvt_pk_bf16(breg[SET][i].z, breg[SET][i].w); \
                        *(LAS u32x2*)(bs + ((i & 1) * 4 + (i >> 1) * 16) * B_PITCH) = wv; } } \
            } \
            if (!(ODD)) { int tt = (kt >> 1) + 1; tt = tt < 0 ? 0 : (tt < NT / 2 ? tt : NT / 2 - 1); const int ta = (2 * tt + rot) & (NT - 1); \
                const unsigned dst = lds0 + (unsigned)((((kt >> 1) + 1) & 1) * A_SLOT + w * NP * 1024); \
                _Pragma("unroll") for (int i = 0; i < NP; ++i) dma16(aoff[i], Abase + ta * 64, dst + i * 1024); } \
            { const int tb_ = (((kt + 7 < 0) ? 0 : (kt + 7 < NT) ? kt + 7 : NT - 1) + rot) & (NT - 1); const char* wb = wbase + (size_t)tb_ * (32 * 2048 * 4); \
                _Pragma("unroll") for (int i = 0; i < 4; ++i) ldw16(breg[SET][i], woff, wb + i * (8 * 2048 * 4)); } \
            ++kt; } while (0)
        for (; kt < NT;) { MOE_LD_ITER(0, 0); MOE_LD_ITER(1, 1); MOE_LD_ITER(2, 0); MOE_LD_ITER(3, 1); MOE_LD_ITER(4, 0); MOE_LD_ITER(5, 1); }
#undef MOE_LD_ITER
        MOE_BAR();
        asm volatile("s_waitcnt vmcnt(0)" : "+v"(breg[0][0]), "+v"(breg[0][1]), "+v"(breg[0][2]), "+v"(breg[0][3]), "+v"(breg[1][0]), "+v"(breg[1][1]), "+v"(breg[1][2]), "+v"(breg[1][3]),
                     "+v"(breg[2][0]), "+v"(breg[2][1]), "+v"(breg[2][2]), "+v"(breg[2][3]) :: "memory");
        asm volatile("" : "+v"(breg[3][0]), "+v"(breg[3][1]), "+v"(breg[3][2]), "+v"(breg[3][3]), "+v"(breg[4][0]), "+v"(breg[4][1]), "+v"(breg[4][2]), "+v"(breg[4][3]),
                     "+v"(breg[5][0]), "+v"(breg[5][1]), "+v"(breg[5][2]), "+v"(breg[5][3]) :: "memory");
    } else {
        const int c = w - 4;
        const int q = (lane & 15) >> 2, pp = lane & 3;
        const unsigned br0 = (unsigned)(rho(8 * fq + q) * B_PITCH + 8 * pp);
        const unsigned ar0 = (unsigned)(c * 2048 + fr * 128 + ((fq ^ ((fr >> 1) & 7)) << 4));
        f32x4 acc[NBC][8];
#pragma unroll
        for (int mi = 0; mi < NBC; ++mi)
#pragma unroll
            for (int j = 0; j < 8; ++j) acc[mi][j] = (f32x4){0.f, 0.f, 0.f, 0.f};
#define MOE_CS_ITER(KT, ODD) do { \
            MOE_BAR(); \
            const LAS unsigned char* as = lds + (((KT) >> 1) & 1) * A_SLOT + ((ODD) ? (ar0 ^ 64u) : ar0); const LAS unsigned char* bs = lds + B_OFF + ((KT) % 3) * B_SLOT + br0; \
            bf16x8 af[NBC]; \
            _Pragma("unroll") for (int mi = 0; mi < NBC; ++mi) af[mi] = *(const LAS bf16x8*)(as + mi * 8192); \
            v4i16_t t0 = __builtin_amdgcn_ds_read_tr16_b64_v4i16((LAS v4i16_t*)(bs)), t1 = __builtin_amdgcn_ds_read_tr16_b64_v4i16((LAS v4i16_t*)(bs + 8 * B_PITCH)); \
            _Pragma("unroll") for (int j = 0; j < 8; ++j) { \
                const bf16x8 wf = (bf16x8){t0[0], t0[1], t0[2], t0[3], t1[0], t1[1], t1[2], t1[3]}; \
                if (j < 7) { t0 = __builtin_amdgcn_ds_read_tr16_b64_v4i16((LAS v4i16_t*)(bs + 32 * (j + 1))); t1 = __builtin_amdgcn_ds_read_tr16_b64_v4i16((LAS v4i16_t*)(bs + 32 * (j + 1) + 8 * B_PITCH)); } \
                __builtin_amdgcn_sched_barrier(0); \
                _Pragma("unroll") for (int mi = 0; mi < NBC; ++mi) acc[mi][j] = __builtin_amdgcn_mfma_f32_16x16x32_bf16(wf, af[mi], acc[mi][j], 0, 0, 0); \
                __builtin_amdgcn_sched_barrier(0); } \
        } while (0)
        for (int kt = 0; kt < NT; kt += 2) { MOE_CS_ITER(kt, 0); MOE_CS_ITER(kt + 1, 1); }
#undef MOE_CS_ITER
        MOE_BAR();
#pragma unroll
        for (int mi = 0; mi < NBC; ++mi) {
            const int lr = r0 + 16 * (4 * mi + c) + fr;
            if (lr < r1) {
                if (FIRST) {
                    bf16_t* dst = (bf16_t*)(p.ws + WS_ACT) + (size_t)(ps + lr) * DE + 64 * u + 8 * fq;
#pragma unroll
                    for (int t = 0; t < 2; ++t) { float o[8];
#pragma unroll
                        for (int jj = 0; jj < 2; ++jj)
#pragma unroll
                            for (int r = 0; r < 4; ++r) { const float g = acc[mi][2 * t + jj][r], up = acc[mi][4 + 2 * t + jj][r]; o[4 * jj + r] = g * pg8::sigm(g) * up; }
                        u32x4 wv; wv.x = pg8::cvt_pk_bf16(o[0], o[1]); wv.y = pg8::cvt_pk_bf16(o[2], o[3]); wv.z = pg8::cvt_pk_bf16(o[4], o[5]); wv.w = pg8::cvt_pk_bf16(o[6], o[7]);
                        *(u32x4*)(dst + 32 * t) = wv; }
                } else {
                    const float rw = ((const float*)(p.ws + WS_SLW))[(size_t)e * ECAP + lr];
                    bf16_t* dst = (bf16_t*)(p.ws + WS_Y) + (size_t)(ps + lr) * ND + 128 * u + 8 * fq;
#pragma unroll
                    for (int t = 0; t < 4; ++t) { const f32x4 v0 = acc[mi][2 * t] * rw, v1 = acc[mi][2 * t + 1] * rw;
                        u32x4 wv; wv.x = pg8::cvt_pk_bf16(v0[0], v0[1]); wv.y = pg8::cvt_pk_bf16(v0[2], v0[3]); wv.z = pg8::cvt_pk_bf16(v1[0], v1[1]); wv.w = pg8::cvt_pk_bf16(v1[2], v1[3]);
                        *(u32x4*)(dst + 32 * t) = wv; }
                }
            }
        }
    }
#undef MOE_BAR
}
struct Pass { int e, u, ps, r0, r1; };
struct PassIt { int i, r0, re, e, u, ps; };
__device__ __forceinline__ bool pass_next(PassIt& it, const LAS int* tb, Pass& P) {
    for (;;) {
        if (it.r0 < it.re) { P.e = it.e; P.u = it.u; P.ps = it.ps; P.r0 = it.r0; P.r1 = (it.re - it.r0 > UROWS) ? it.r0 + UROWS : it.re; it.r0 += UROWS; return true; }
        const int L = it.i * (int)gridDim.x + (int)blockIdx.x; if (L >= NE * 32) return false; ++it.i;
        const int rr = L >> 3; it.e = (L & 7) + 8 * (rr >> 5); it.u = (rr >> 1) & 15; const int half = rr & 1;
        const int n_e = __builtin_amdgcn_readfirstlane(tb[it.e]); it.ps = __builtin_amdgcn_readfirstlane(tb[64 + it.e]);
        const int hr = (n_e + 1) >> 1; it.r0 = half ? hr : 0; it.re = half ? n_e : hr;
    }
}
__device__ __forceinline__ void dma4(unsigned voff, const char* sbase, unsigned lds_dst) {
    unsigned keep; asm volatile("s_mov_b32 %0, m0\n\ts_mov_b32 m0, %3\n\ts_nop 0\n\tglobal_load_lds_dword %1, %2\n\ts_mov_b32 m0, %0" : "=&s"(keep) : "v"(voff), "s"(sbase), "s"(lds_dst) : "memory"); }
constexpr int TOK_OFF = 135168;

template <bool FIRST>
__device__ __forceinline__ void stream_loader(LAS unsigned char* lds, const Params& p, const LAS int* tb) {
    constexpr int K = FIRST ? 2048 : 1024, NT = K / 32, NP = 12;
    static_assert(NT % 8 == 0, "eight register sets");
    int tid_ = threadIdx.x; asm volatile("" : "+v"(tid_));
    const int tid = tid_, lane = tid & 63, w = __builtin_amdgcn_readfirstlane(tid >> 6);
    PassIt it{0, 0, 0, 0, 0, 0}; Pass cur, nxt;
    if (!pass_next(it, tb, cur)) return;
    bool has_nxt = pass_next(it, tb, nxt);
    const char* Abase = (const char*)(p.ws + (FIRST ? WS_H : WS_ACT));
    const char* listb = (const char*)(p.ws + WS_LIST);
    const int t = 64 * w + lane, krow = t >> 5, c4 = t & 31, gi = c4 >> 3, cg = c4 & 7;
    const int npos = 32 * gi + 4 * (4 * (cg & 1) + (cg >> 1));
    const unsigned bw = (unsigned)(rho(krow) * B_PITCH + 2 * npos);
    const unsigned lds0 = (unsigned)(uintptr_t)lds;
    const unsigned wrow = (unsigned)(krow * 2048) * 4u;
#define MOE_GCOL(U) (FIRST ? ((c4 < 16 ? 0 : 1024) + 64 * (U) + 4 * (c4 & 15)) : (128 * (U) + 4 * c4))
#define MOE_WBASE(E) ((const char*)(FIRST ? p.w_gu + (size_t)(E) * 2048 * 2048 : p.w_dn + (size_t)(E) * 1024 * 2048))
    unsigned aoff[NP];
#pragma unroll
    for (int i = 0; i < NP; ++i) {
        const int q_ = 4 * i + w, mt = q_ >> 1, rt = 8 * (q_ & 1) + (lane >> 3);
        int lr = cur.r0 + 16 * mt + rt; lr = lr < cur.r1 ? lr : cur.r1 - 1;
        const unsigned cb = (unsigned)(((lane & 7) ^ ((rt >> 1) & 7)) * 16);
        if (FIRST) aoff[i] = (unsigned)((const int*)listb)[(size_t)cur.e * ECAP + lr] * (unsigned)(ND * 2) + cb;
        else aoff[i] = (unsigned)(cur.ps + lr) * (unsigned)(DE * 2) + cb;
    }
#pragma unroll
    for (int i = 0; i < NP; ++i) asm volatile("" : "+v"(aoff[i]));
    int npieces = (((cur.r1 - cur.r0 + 15) >> 4) * 2 - w + 3) >> 2;
    const char* wbase = MOE_WBASE(cur.e); unsigned woff = wrow + (unsigned)MOE_GCOL(cur.u) * 4u;
    const char* wbaseN = wbase; unsigned woffN = woff; int npiecesN = 0;
    f32x4 breg[8][4];
#pragma unroll
    for (int s = 0; s < 8; ++s)
#pragma unroll
        for (int i = 0; i < 4; ++i) breg[s][i] = (f32x4){0.f, 0.f, 0.f, 0.f};
    asm volatile("s_waitcnt vmcnt(0)" ::: "memory");
    int g0 = 0;
    int kstart = -16;
#define MOE_BAR() do { asm volatile("s_waitcnt lgkmcnt(0)" ::: "memory"); __builtin_amdgcn_s_barrier(); asm volatile("" ::: "memory"); } while (0)
#define MOE_SL_ITER(SET, ODD) do {        \
      if (!(ODD)) { \
          \
        if (kt >= 0) { if (FIRST && kt == 0 && kstart == 0) MOE_WAITV(20); else MOE_WAITV(8); } \
        else if (kt >= -8) MOE_WAITV(24);        \
        if (kt >= 0) MOE_BAR(); \
        if (kt + 3 >= 0) {        \
            _Pragma("unroll") for (int h_ = 0; h_ < 2; ++h_) { \
                asm volatile("" : "+v"(breg[((SET) + 1 + h_) & 7][0]), "+v"(breg[((SET) + 1 + h_) & 7][1]), "+v"(breg[((SET) + 1 + h_) & 7][2]), "+v"(breg[((SET) + 1 + h_) & 7][3]) :: "memory"); \
                if (kt + 2 + h_ >= 0 && (kt + 2 + h_ < NT || has_nxt)) { LAS unsigned char* bs = lds + B_OFF + ((kt + 2 + h_) & 3) * B_SLOT + bw; \
                    _Pragma("unroll") for (int i = 0; i < 4; ++i) { u32x2 wv; wv.x = pg8::cvt_pk_bf16(breg[((SET) + 1 + h_) & 7][i].x, breg[((SET) + 1 + h_) & 7][i].y); wv.y = pg8::cvt_pk_bf16(breg[((SET) + 1 + h_) & 7][i].z, breg[((SET) + 1 + h_) & 7][i].w); \
                        *(LAS u32x2*)(bs + ((i & 1) * 4 + (i >> 1) * 16) * B_PITCH) = wv; } } } \
        } \
        { \
            const int T1 = (kt >> 1) + 1; const unsigned dst = lds0 + (unsigned)((((g0 >> 1) + T1) & 1) * A_SLOT + w * 1024); \
            if (T1 < NT / 2) { if (T1 >= 0) { _Pragma("unroll") for (int i = 0; i < NP; ++i) if (i < npieces) dma16(aoff[i], Abase + T1 * 128, dst + i * 4096); } } \
            else if (has_nxt) { \
                _Pragma("unroll") for (int i = 0; i < NP; ++i) { const int q_ = 4 * i + w, rt = 8 * (q_ & 1) + (lane >> 3); const unsigned cb = (unsigned)(((lane & 7) ^ ((rt >> 1) & 7)) * 16); \
                    if (FIRST) aoff[i] = *(const LAS unsigned*)(lds + TOK_OFF + q_ * 256 + lane * 4) * (unsigned)(ND * 2) + cb; \
                    else { const int mt = q_ >> 1; int lr = nxt.r0 + 16 * mt + rt; lr = lr < nxt.r1 ? lr : nxt.r1 - 1; aoff[i] = (unsigned)(nxt.ps + lr) * (unsigned)(DE * 2) + cb; } } \
                _Pragma("unroll") for (int i = 0; i < NP; ++i) if (i < npiecesN) dma16(aoff[i], Abase, dst + i * 4096); }        \
        } \
        _Pragma("unroll") for (int h_ = 0; h_ < 2; ++h_) { \
            const int tb_ = kt + 10 + h_; const bool nx_ = (tb_ >= NT) && has_nxt;        \
            const int tile_ = nx_ ? tb_ - NT : (tb_ < 0 ? 0 : (tb_ < NT ? tb_ : NT - 1)); \
            const char* wb = (nx_ ? wbaseN : wbase) + (size_t)tile_ * (32 * 2048 * 4); const unsigned wo = nx_ ? woffN : woff; \
            _Pragma("unroll") for (int i = 0; i < 4; ++i) ldw16(breg[((SET) + 1 + h_) & 7][i], wo, wb + i * (8 * 2048 * 4)); } \
      } \
        ++kt; } while (0)
    for (;;) {
        if (has_nxt) { wbaseN = MOE_WBASE(nxt.e); woffN = wrow + (unsigned)MOE_GCOL(nxt.u) * 4u; npiecesN = (((nxt.r1 - nxt.r0 + 15) >> 4) * 2 - w + 3) >> 2; }
        if (FIRST) {
            const int qe = __builtin_amdgcn_readfirstlane(has_nxt ? nxt.e : cur.e), qr0 = __builtin_amdgcn_readfirstlane(has_nxt ? nxt.r0 : cur.r0), qr1 = __builtin_amdgcn_readfirstlane(has_nxt ? nxt.r1 : cur.r1);
            const char* lb = listb + (size_t)qe * ECAP * 4;
#pragma unroll
            for (int i = 0; i < NP; ++i) { const int q_ = 4 * i + w, mt = q_ >> 1, rt = 8 * (q_ & 1) + (lane >> 3); int lr = qr0 + 16 * mt + rt; lr = lr < qr1 ? lr : qr1 - 1;
                dma4((unsigned)lr * 4u, lb, lds0 + (unsigned)(TOK_OFF + q_ * 256)); }
        }
        int kt = kstart; asm volatile("" : "+s"(kt));
        for (; kt < NT;) { MOE_SL_ITER(0, 0); MOE_SL_ITER(1, 1); MOE_SL_ITER(2, 0); MOE_SL_ITER(3, 1); MOE_SL_ITER(4, 0); MOE_SL_ITER(5, 1); MOE_SL_ITER(6, 0); MOE_SL_ITER(7, 1); }
        if (!has_nxt) break;
        cur = nxt; wbase = wbaseN; woff = woffN; npieces = npiecesN; g0 += NT; kstart = 0;
        has_nxt = pass_next(it, tb, nxt);
    }
#undef MOE_SL_ITER
#undef MOE_GCOL
#undef MOE_WBASE
    asm volatile("s_waitcnt vmcnt(0)" : "+v"(breg[0][0]), "+v"(breg[0][1]), "+v"(breg[0][2]), "+v"(breg[0][3]), "+v"(breg[1][0]), "+v"(breg[1][1]), "+v"(breg[1][2]), "+v"(breg[1][3]),
                 "+v"(breg[2][0]), "+v"(breg[2][1]), "+v"(breg[2][2]), "+v"(breg[2][3]) :: "memory");
    asm volatile("" : "+v"(breg[3][0]), "+v"(breg[3][1]), "+v"(breg[3][2]), "+v"(breg[3][3]), "+v"(breg[4][0]), "+v"(breg[4][1]), "+v"(breg[4][2]), "+v"(breg[4][3]),
                 "+v"(breg[5][0]), "+v"(breg[5][1]), "+v"(breg[5][2]), "+v"(breg[5][3]) :: "memory");
    asm volatile("" : "+v"(breg[6][0]), "+v"(breg[6][1]), "+v"(breg[6][2]), "+v"(breg[6][3]), "+v"(breg[7][0]), "+v"(breg[7][1]), "+v"(breg[7][2]), "+v"(breg[7][3]) :: "memory");
}

template <bool FIRST, int NBC>
__device__ __forceinline__ void consumer_pass(LAS unsigned char* lds, const Params& p, const Pass& P, const int g0) {
    constexpr int K = FIRST ? 2048 : 1024, NT = K / 32;
    int tid_ = threadIdx.x; asm volatile("" : "+v"(tid_));
    const int tid = tid_, lane = tid & 63, w = __builtin_amdgcn_readfirstlane(tid >> 6), fr = lane & 15, fq = lane >> 4, c = w - 4;
    const int q = (lane & 15) >> 2, pp = lane & 3;
    const unsigned br0 = (unsigned)(rho(8 * fq + q) * B_PITCH + 8 * pp);
    const unsigned ar0 = (unsigned)(c * 2048 + fr * 128 + ((fq ^ ((fr >> 1) & 7)) << 4));
    f32x4 acc[NBC][8];
#pragma unroll
    for (int mi = 0; mi < NBC; ++mi)
#pragma unroll
        for (int j = 0; j < 8; ++j) acc[mi][j] = (f32x4){0.f, 0.f, 0.f, 0.f};
    int sl = g0 & 3;
    bf16x8 af[NBC]; v4i16_t pt0, pt1, pu0, pu1;
#define MOE_CS_ITER(KT, ODD) do {        \
        asm volatile("" : "+s"(sl));        \
        const int sn = (sl + 1) & 3; \
        const LAS unsigned char* as = lds + (((g0 + (KT)) >> 1) & 1) * A_SLOT + ((ODD) ? (ar0 ^ 64u) : ar0); const LAS unsigned char* bs = lds + B_OFF + sl * B_SLOT + br0; \
        if (!(ODD) || NBC > 6) { _Pragma("unroll") for (int mi = 0; mi < NBC; ++mi) af[mi] = *(const LAS bf16x8*)(as + mi * 8192); }        \
        v4i16_t t0 = pt0, t1 = pt1; const LAS unsigned char* bn = lds + B_OFF + sn * B_SLOT + br0; \
        _Pragma("unroll") for (int j = 0; j < 8; ++j) { \
            const bf16x8 wf = (bf16x8){t0[0], t0[1], t0[2], t0[3], t1[0], t1[1], t1[2], t1[3]}; \
            if (j == 0) { t0 = pu0; t1 = pu1; } \
            else if (j < 7) { t0 = __builtin_amdgcn_ds_read_tr16_b64_v4i16((LAS v4i16_t*)(bs + 32 * (j + 1))); t1 = __builtin_amdgcn_ds_read_tr16_b64_v4i16((LAS v4i16_t*)(bs + 32 * (j + 1) + 8 * B_PITCH)); } \
            if (j == 3 && !(ODD)) { pt0 = __builtin_amdgcn_ds_read_tr16_b64_v4i16((LAS v4i16_t*)(bn)); pt1 = __builtin_amdgcn_ds_read_tr16_b64_v4i16((LAS v4i16_t*)(bn + 8 * B_PITCH)); } \
            if (j == 5 && !(ODD)) { pu0 = __builtin_amdgcn_ds_read_tr16_b64_v4i16((LAS v4i16_t*)(bn + 32)); pu1 = __builtin_amdgcn_ds_read_tr16_b64_v4i16((LAS v4i16_t*)(bn + 32 + 8 * B_PITCH)); }        \
            __builtin_amdgcn_sched_barrier(0); \
            _Pragma("unroll") for (int mi = 0; mi < NBC; ++mi) acc[mi][j] = __builtin_amdgcn_mfma_f32_16x16x32_bf16(wf, af[mi], acc[mi][j], 0, 0, 0); \
            __builtin_amdgcn_sched_barrier(0); } \
        {        \
          if (!(ODD) && NBC <= 6) { const LAS unsigned char* an = lds + (((g0 + (KT)) >> 1) & 1) * A_SLOT + (ar0 ^ 64u); _Pragma("unroll") for (int mi = 0; mi < NBC; ++mi) af[mi] = *(const LAS bf16x8*)(an + mi * 8192); } } \
        sl = sn; \
        __builtin_amdgcn_sched_barrier(0); \
    } while (0)
    for (int kt = 0; kt < NT; kt += 2) {
        MOE_BAR();
        { asm volatile("" : "+s"(sl)); const LAS unsigned char* b0_ = lds + B_OFF + sl * B_SLOT + br0; pt0 = __builtin_amdgcn_ds_read_tr16_b64_v4i16((LAS v4i16_t*)(b0_)); pt1 = __builtin_amdgcn_ds_read_tr16_b64_v4i16((LAS v4i16_t*)(b0_ + 8 * B_PITCH));
          pu0 = __builtin_amdgcn_ds_read_tr16_b64_v4i16((LAS v4i16_t*)(b0_ + 32)); pu1 = __builtin_amdgcn_ds_read_tr16_b64_v4i16((LAS v4i16_t*)(b0_ + 32 + 8 * B_PITCH)); }
        MOE_CS_ITER(kt, 0); MOE_CS_ITER(kt + 1, 1);
    }
#undef MOE_CS_ITER
#undef MOE_BAR
    const int e = P.e, u = P.u, ps = P.ps, r0 = P.r0, r1 = P.r1;
#pragma unroll
    for (int mi = 0; mi < NBC; ++mi) {
        const int lr = r0 + 16 * (4 * mi + c) + fr;
        if (lr < r1) {
            if (FIRST) {
                bf16_t* dst = (bf16_t*)(p.ws + WS_ACT) + (size_t)(ps + lr) * DE + 64 * u + 8 * fq;
#pragma unroll
                for (int t = 0; t < 2; ++t) { float o[8];
#pragma unroll
                    for (int jj = 0; jj < 2; ++jj)
#pragma unroll
                        for (int r = 0; r < 4; ++r) { const float g = acc[mi][2 * t + jj][r], up = acc[mi][4 + 2 * t + jj][r]; o[4 * jj + r] = g * pg8::sigm(g) * up; }
                    u32x4 wv; wv.x = pg8::cvt_pk_bf16(o[0], o[1]); wv.y = pg8::cvt_pk_bf16(o[2], o[3]); wv.z = pg8::cvt_pk_bf16(o[4], o[5]); wv.w = pg8::cvt_pk_bf16(o[6], o[7]);
                    *(u32x4*)(dst + 32 * t) = wv; }
            } else {
                const float rw = ((const float*)(p.ws + WS_SLW))[(size_t)e * ECAP + lr];
                bf16_t* dst = (bf16_t*)(p.ws + WS_Y) + (size_t)(ps + lr) * ND + 128 * u + 8 * fq;
#pragma unroll
                for (int t = 0; t < 4; ++t) { const f32x4 v0 = acc[mi][2 * t] * rw, v1 = acc[mi][2 * t + 1] * rw;
                    u32x4 wv; wv.x = pg8::cvt_pk_bf16(v0[0], v0[1]); wv.y = pg8::cvt_pk_bf16(v0[2], v0[3]); wv.z = pg8::cvt_pk_bf16(v1[0], v1[1]); wv.w = pg8::cvt_pk_bf16(v1[2], v1[3]);
                    *(u32x4*)(dst + 32 * t) = wv; }
            }
        }
    }
}
#undef MOE_WAITV
static_assert(B_OFF + 4 * B_SLOT <= TOK_OFF && TOK_OFF + 12288 <= 159744, "expert engine ring (four weight-image slots) vs LDS map");
}

#ifndef MOE_CONT
#define MOE_CONT 3
#endif
template <bool FIRST>
__device__ __forceinline__ void phase_moe_stream(const Params& p, LAS unsigned char* lds, int tid) {
    LAS int* tb = (LAS int*)(lds + TBL_OFF);
    expert_tables(p, tb, tid);
#if MOE_CONT
  if (MOE_CONT == 3 || (MOE_CONT == 1 && FIRST) || (MOE_CONT == 2 && !FIRST)) {
    if (__builtin_amdgcn_readfirstlane(tid >> 6) < 4) moe::stream_loader<FIRST>(lds, p, tb);
    else {
        constexpr int NT = (FIRST ? 2048 : 1024) / 32;
        moe::PassIt it{0, 0, 0, 0, 0, 0}; moe::Pass P; int g0 = 0;
        while (moe::pass_next(it, tb, P)) {
            const int n = P.r1 - P.r0;
            if (n > 320) moe::consumer_pass<FIRST, 6>(lds, p, P, g0);
            else if (n > 256) moe::consumer_pass<FIRST, 5>(lds, p, P, g0);
            else if (n > 192) moe::consumer_pass<FIRST, 4>(lds, p, P, g0);
            else if (n > 128) moe::consumer_pass<FIRST, 3>(lds, p, P, g0);
            else moe::consumer_pass<FIRST, 2>(lds, p, P, g0);
            g0 += NT;
        }
    }
    return;
  }
#endif
    const int G = gridDim.x;
    for (int i = 0;; ++i) {
        const int L = i * G + (int)blockIdx.x; if (L >= NE * 32) break;
        const int rr = L >> 3, e = (L & 7) + 8 * (rr >> 5), u = (rr >> 1) & 15, half = rr & 1;
        const int n_e = __builtin_amdgcn_readfirstlane(tb[e]), ps = __builtin_amdgcn_readfirstlane(tb[64 + e]);
        const int hr = (n_e + 1) >> 1, rb = half ? hr : 0, re = half ? n_e : hr;
        for (int r0 = rb; r0 < re; r0 += moe::UROWS) {
            const int r1 = (re - r0 > moe::UROWS) ? r0 + moe::UROWS : re, n = r1 - r0;
            if (n > 256) moe::unit_lc<FIRST, 6>(lds, p, e, u, ps, r0, r1);
            else if (n > 128) moe::unit_lc<FIRST, 4>(lds, p, e, u, ps, r0, r1);
            else moe::unit_lc<FIRST, 2>(lds, p, e, u, ps, r0, r1);
        }
    }
}

struct Mo1A { const bf16_t* H2; const int* list; int n_e, r0; __device__ __forceinline__ const bf16_t* operator()(int r, int k0) const { const int lr = r0 + r; if (lr >= n_e) return nullptr; return H2 + (size_t)list[lr] * ND + k0; } };
struct Mo1B { const bf16_t* W; int v0; __device__ __forceinline__ const bf16_t* operator()(int n, int k0) const { const int v = v0 + n, j = v >> 1, isu = v & 1; return W + (size_t)((j >> 7) * 256 + isu * 128 + (j & 127)) * ND + k0; } };
struct Mo1Epi { bf16_t* ACT; int prow0, v0;
    __device__ __forceinline__ void operator()(int r, int c, f32x4& v) const { const int j = (v0 + c) >> 1;
        const float a0 = v.x / (1.f + __expf(-v.x)) * v.y, a1 = v.z / (1.f + __expf(-v.z)) * v.w;
        *(unsigned*)(ACT + (size_t)(prow0 + r) * DE + j) = pk2(a0, a1); } };
__device__ __forceinline__ void phase_moe1_naive(const Params& p, LAS unsigned char* lds, const Ctx& cx) {
    LAS int* tb = (LAS int*)(lds + 32768);
    expert_tables(p, tb, cx.tid);
    const int ntile = tb[192 + NE] * 32;
    for (int t = blockIdx.x; t < ntile; t += gridDim.x) {
        const int ct = t & 31, rtg = t >> 5;
        int e = 0; while (tb[192 + e + 1] <= rtg) ++e;
        const int rt = rtg - tb[192 + e], n_e = tb[e], ps = tb[64 + e];
        Mo1A af{(const bf16_t*)(p.ws + WS_H), (const int*)(p.ws + WS_LIST) + (size_t)e * ECAP, n_e, rt * 64};
        Mo1B bf{(const bf16_t*)(p.ws + WS_WGUT) + (size_t)e * 2048 * ND, ct * 64};
        Mo1Epi ef{(bf16_t*)(p.ws + WS_ACT), ps + rt * 64, ct * 64};
        ngemm_tile(lds, ND, -1, af, bf, NoMid(), ef, cx.tid);
    }
}
struct Mo2A { const bf16_t* ACT; int prow0; __device__ __forceinline__ const bf16_t* operator()(int r, int k0) const { return ACT + (size_t)(prow0 + r) * DE + k0; } };
struct Mo2B { const bf16_t* W; int col0; __device__ __forceinline__ const bf16_t* operator()(int n, int k0) const { return W + (size_t)(col0 + n) * DE + k0; } };
struct Mo2Epi { bf16_t* Y; const float* slw; int prow0, r0, n_e, col0;
    __device__ __forceinline__ void operator()(int r, int c, f32x4& v) const { const int lr = r0 + r; if (lr >= n_e) return; const float w = slw[lr];
        u32x2 o; o.x = pk2(v.x * w, v.y * w); o.y = pk2(v.z * w, v.w * w); *(u32x2*)(Y + (size_t)(prow0 + lr) * ND + col0 + c) = o; } };
__device__ __forceinline__ void phase_moe2_naive(const Params& p, LAS unsigned char* lds, const Ctx& cx) {
    LAS int* tb = (LAS int*)(lds + 32768);
    expert_tables(p, tb, cx.tid);
    const int ntile = tb[192 + NE] * 32;
    for (int t = blockIdx.x; t < ntile; t += gridDim.x) {
        const int ct = t & 31, rtg = t >> 5;
        int e = 0; while (tb[192 + e + 1] <= rtg) ++e;
        const int rt = rtg - tb[192 + e], n_e = tb[e], ps = tb[64 + e];
        Mo2A af{(const bf16_t*)(p.ws + WS_ACT), ps + rt * 64};
        Mo2B bf{(const bf16_t*)(p.ws + WS_WDNT) + (size_t)e * ND * DE, ct * 64};
        Mo2Epi ef{(bf16_t*)(p.ws + WS_Y), (const float*)(p.ws + WS_SLW) + (size_t)e * ECAP, ps, rt * 64, n_e, ct * 64};
        ngemm_tile(lds, DE, -1, af, bf, NoMid(), ef, cx.tid);
    }
}

__device__ __forceinline__ void phase_final(const Params& p, LAS unsigned char* lds, const Ctx& cx) {
    LAS int* tb = (LAS int*)(lds + 32768);
    expert_tables(p, tb, cx.tid);
    const float* xmid = (const float*)(p.ws + WS_XMID); const float* mod = (const float*)(p.ws + WS_MOD);
    const int* toke = (const int*)(p.ws + WS_TOKE); const int* tokr = (const int*)(p.ws + WS_TOKR); const bf16_t* Y = (const bf16_t*)(p.ws + WS_Y);
    f32x4 gfin[8];
#pragma unroll
    for (int j = 0; j < 8; ++j) gfin[j] = *(const f32x4*)(p.g_final + 4 * cx.lane + 256 * j);
    for (int row = cx.gw; row + cx.ngw < NM + cx.ngw; row += 2 * cx.ngw) {
        const int rowa = row, rowb = (row + cx.ngw < NM) ? row + cx.ngw : row; const bool hasb = row + cx.ngw < NM;
        const int ba = rowa / NS, bb = rowb / NS;
        const int sa0 = tb[64 + toke[rowa * 2]] + tokr[rowa * 2], sa1 = tb[64 + toke[rowa * 2 + 1]] + tokr[rowa * 2 + 1];
        const int sb0 = tb[64 + toke[rowb * 2]] + tokr[rowb * 2], sb1 = tb[64 + toke[rowb * 2 + 1]] + tokr[rowb * 2 + 1];
        const f32x4* xa = (const f32x4*)(xmid + (size_t)rowa * ND) + cx.lane; const f32x4* xb = (const f32x4*)(xmid + (size_t)rowb * ND) + cx.lane;
        const u32x2* ya0 = (const u32x2*)(Y + (size_t)sa0 * ND) + cx.lane; const u32x2* ya1 = (const u32x2*)(Y + (size_t)sa1 * ND) + cx.lane;
        const u32x2* yb0 = (const u32x2*)(Y + (size_t)sb0 * ND) + cx.lane; const u32x2* yb1 = (const u32x2*)(Y + (size_t)sb1 * ND) + cx.lane;
        f32x4 va[8], vb[8]; float ssa = 0.f, ssb = 0.f;
#pragma unroll
        for (int j = 0; j < 8; ++j) {
            const int col = 4 * cx.lane + 256 * j;
            const f32x4 gta = *(const f32x4*)(mod + (size_t)ba * 12288 + 10240 + col), gtb = *(const f32x4*)(mod + (size_t)bb * 12288 + 10240 + col);
            const u32x2 a0 = __builtin_nontemporal_load(ya0 + 64 * j), a1 = __builtin_nontemporal_load(ya1 + 64 * j), b0 = __builtin_nontemporal_load(yb0 + 64 * j), b1 = __builtin_nontemporal_load(yb1 + 64 * j);
            f32x4 fa, fb;
            fa.x = bf2f(a0.x & 0xffffu) + bf2f(a1.x & 0xffffu); fa.y = bf2f(a0.x >> 16) + bf2f(a1.x >> 16); fa.z = bf2f(a0.y & 0xffffu) + bf2f(a1.y & 0xffffu); fa.w = bf2f(a0.y >> 16) + bf2f(a1.y >> 16);
            fb.x = bf2f(b0.x & 0xffffu) + bf2f(b1.x & 0xffffu); fb.y = bf2f(b0.x >> 16) + bf2f(b1.x >> 16); fb.z = bf2f(b0.y & 0xffffu) + bf2f(b1.y & 0xffffu); fb.w = bf2f(b0.y >> 16) + bf2f(b1.y >> 16);
            va[j] = __builtin_nontemporal_load(xa + 64 * j) + gta * fa; vb[j] = __builtin_nontemporal_load(xb + 64 * j) + gtb * fb;
            ssa += (va[j].x * va[j].x + va[j].y * va[j].y) + (va[j].z * va[j].z + va[j].w * va[j].w);
            ssb += (vb[j].x * vb[j].x + vb[j].y * vb[j].y) + (vb[j].z * vb[j].z + vb[j].w * vb[j].w);
        }
        const float ra = 1.f / sqrtf(wave_sum(ssa) * (1.f / ND) + RMS_EPS), rbv = 1.f / sqrtf(wave_sum(ssb) * (1.f / ND) + RMS_EPS);
        f32x4* oa = (f32x4*)(p.out + (size_t)rowa * ND) + cx.lane; f32x4* ob = (f32x4*)(p.out + (size_t)rowb * ND) + cx.lane;
#pragma unroll
        for (int j = 0; j < 8; ++j) __builtin_nontemporal_store(va[j] * ra * gfin[j], oa + 64 * j);
        if (hasb) {
#pragma unroll
            for (int j = 0; j < 8; ++j) __builtin_nontemporal_store(vb[j] * rbv * gfin[j], ob + 64 * j);
        }
    }
}

#ifndef FAST_ATTN
#define FAST_ATTN 1
#endif
#ifndef FAST_ROUTER
#define FAST_ROUTER 1
#endif
#ifndef FAST_INPROJ
#define FAST_INPROJ 1
#endif
#ifndef FAST_BRANCH
#define FAST_BRANCH 1
#endif
#ifndef FAST_OUT
#define FAST_OUT 1
#endif
#ifndef FAST_MOE1
#define FAST_MOE1 1
#endif
#ifndef FAST_MOE2
#define FAST_MOE2 1
#endif
__global__ void __launch_bounds__(NTHR, 2) fwd(Params p) {
    extern __shared__ __attribute__((aligned(16))) unsigned char lds_raw[];
    LAS unsigned char* lds = (LAS unsigned char*)lds_raw;
    volatile LAS unsigned* MISC = (volatile LAS unsigned*)(lds + MISC_OFF);
    if (threadIdx.x < 32) MISC[threadIdx.x] = 0u;
    __syncthreads();
    XcdBarrier bar = xcd_barrier_post((unsigned*)(p.ws + WS_CTL) + CW_BAR, MISC + 8);

#ifndef REP_MASK
#define REP_MASK 0
#endif
#define REPS(k) (((REP_MASK >> (k)) & 1) ? 2 : 1)
    for (int rep = 0; rep < REPS(0); ++rep) { phase_prologue(p, lds, make_ctx());        xcd_barrier(bar); }
    for (int rep = 0; rep < REPS(1); ++rep) { phase_h(p, lds, make_ctx());               xcd_barrier(bar); }
    for (int rep = 0; rep < REPS(2); ++rep) {
#if FAST_INPROJ
    phase_inproj_fast(p, lds);         xcd_barrier(bar);
#else
    phase_inproj_naive(p, lds, make_ctx());    xcd_barrier(bar);
#endif
    }
    for (int rep = 0; rep < REPS(3); ++rep) {
#if FAST_ATTN
    phase_attn_fast(p, (char*)lds_raw);        xcd_barrier(bar);
#else
    phase_swa_naive(p, make_ctx());
    phase_diff_naive(p, make_ctx());           xcd_barrier(bar);
#endif
    }
    for (int rep = 0; rep < REPS(4); ++rep) {
#if FAST_BRANCH
    phase_branch_fast(p, lds);         xcd_barrier(bar);
#else
    phase_branch_naive(p, lds, make_ctx());    xcd_barrier(bar);
#endif
    }
    for (int rep = 0; rep < REPS(5); ++rep) {
#if FAST_OUT
    phase_out_fast(p, lds);            xcd_barrier(bar);
#else
    phase_out_naive(p, lds, make_ctx());       xcd_barrier(bar);
#endif
    }
#if FAST_ROUTER
    phase_router_fast(p, lds, make_ctx());     xcd_barrier(bar);
#else
    phase_router(p, lds, make_ctx());          xcd_barrier(bar);
#endif
    for (int rep = 0; rep < REPS(7); ++rep) {
#if MOE_STREAM
    phase_moe_stream<true>(p, lds, threadIdx.x);   xcd_barrier(bar);
#elif FAST_MOE1
    phase_moe1_fast(p, lds, make_ctx());       xcd_barrier(bar);
#else
    phase_moe1_naive(p, lds, make_ctx());      xcd_barrier(bar);
#endif
    }
    for (int rep = 0; rep < REPS(8); ++rep) {
#if MOE_STREAM
    phase_moe_stream<false>(p, lds, threadIdx.x);  xcd_barrier(bar);
#elif FAST_MOE2
    phase_moe2_fast(p, lds, make_ctx());       xcd_barrier(bar);
#else
    phase_moe2_naive(p, lds, make_ctx());      xcd_barrier(bar);
#endif
    }
    for (int rep = 0; rep < REPS(9); ++rep) { if (rep) xcd_barrier(bar); phase_final(p, lds, make_ctx()); }
}

extern "C" void kernel_launch(void* const* d_in, const int* in_sizes, int n_in, void* d_out, int out_size, void* d_ws, size_t ws_size, hipStream_t stream) {
    static int grid = 0;
    if (grid == 0) {
        if (n_in != 24 || in_sizes[0] != NM * ND || out_size != NM * ND || ws_size < WS_END) { fprintf(stderr, "kernel_launch: unexpected shapes (n_in %d, in0 %d, out %d, ws %zu)\n", n_in, n_in > 0 ? in_sizes[0] : -1, out_size, ws_size); grid = -1; return; }
        int dev = 0, cus = 0, per_cu = 0;
        if (hipGetDevice(&dev) != hipSuccess || hipDeviceGetAttribute(&cus, hipDeviceAttributeMultiprocessorCount, dev) != hipSuccess) { grid = -1; return; }
        if (hipFuncSetAttribute((const void*)fwd, hipFuncAttributeMaxDynamicSharedMemorySize, LDS_BYTES) != hipSuccess) { fprintf(stderr, "kernel_launch: hipFuncSetAttribute failed\n"); grid = -1; return; }
        if (hipOccupancyMaxActiveBlocksPerMultiprocessor(&per_cu, (const void*)fwd, NTHR, LDS_BYTES) != hipSuccess || per_cu < 1) fprintf(stderr, "kernel_launch: occupancy query says %d\n", per_cu);
        (void)hipGetLastError();
        grid = cus;
    }
    if (grid < 0) return;
    (void)hipMemsetAsync((char*)d_ws + WS_CTL, 0, CTL_ZERO_BYTES, stream);
    Params p{};
    p.x = (const float*)d_in[0]; p.c = (const float*)d_in[1]; p.pos = (const int*)d_in[2]; p.w_ada = (const float*)d_in[3]; p.b_ada = (const float*)d_in[4];
    p.g_mix = (const float*)d_in[5]; p.w_in = (const float*)d_in[6]; p.sinks = (const float*)d_in[7]; p.lq1 = (const float*)d_in[8]; p.lk1 = (const float*)d_in[9];
    p.lq2 = (const float*)d_in[10]; p.lk2 = (const float*)d_in[11]; p.subln = (const float*)d_in[12]; p.w_a = (const float*)d_in[13]; p.w_b = (const float*)d_in[14];
    p.w_out = (const float*)d_in[15]; p.g_ffn = (const float*)d_in[16]; p.w_rg = (const float*)d_in[17]; p.b_rg = (const float*)d_in[18]; p.w_re = (const float*)d_in[19];
    p.b_re = (const float*)d_in[20]; p.w_gu = (const float*)d_in[21]; p.w_dn = (const float*)d_in[22]; p.g_final = (const float*)d_in[23];
    p.out = (float*)d_out; p.ws = (unsigned char*)d_ws;
    hipLaunchKernelGGL(fwd, dim3(grid), dim3(NTHR), LDS_BYTES, stream, p);
}
```
